# Optimizing an MI355X kernel written in HIP

```python
import math
import numpy as np
import jax, jax.numpy as jnp
from jax import lax

D_MODEL = 2048
BATCH = 2
SEQ = 4096
DEPTH = 2

HEAD_DIM = 128
ROPE_THETA = 500000.0
ROPE_FRACTION_DIV = 4
Q_BLK = 128
NEG = -1e30
FORCE = 1e6

A_HEADS = 8
A_LATENT = 512
IDX_HEADS = 16
IDX_DIM = 64
DSA_TOPK = 256

B_HEADS = 8
B_KV_GROUPS = 2
B_HPG = B_HEADS // B_KV_GROUPS
CMP_LEN = 32
CMP_STRIDE = 16
SLC_LEN = 64
SLC_TOPN = 16
WIN_LEN = 512

C_HEADS = 4
C_DIM = 128

BRANCH_W = A_HEADS * HEAD_DIM
N_BRANCH = 3

D_FF = int(math.ceil(8 * D_MODEL / 3 / 256)) * 256

ALPHA = (2 * DEPTH) ** 0.25
BETA = (8 * DEPTH) ** -0.25

A_Q_W = A_HEADS * HEAD_DIM
IDX_Q_W = IDX_HEADS * IDX_DIM
B_Q_W = B_HEADS * HEAD_DIM
B_KV_W = 3 * 2 * B_KV_GROUPS * HEAD_DIM
B_GATE_W = 3 * B_HEADS
C_QK_W = C_HEADS * 2 * C_DIM
C_V_W = C_HEADS * 2 * C_DIM
MERGE_GATE_W = N_BRANCH * D_MODEL
IN_SPLITS = (A_Q_W, A_LATENT, IDX_Q_W, IDX_DIM, IDX_HEADS,
             B_Q_W, B_KV_W, B_GATE_W,
             C_QK_W, C_QK_W, C_V_W,
             MERGE_GATE_W)
N_IN = sum(IN_SPLITS)
IN_OFFSETS = tuple(int(o) for o in np.cumsum(IN_SPLITS)[:-1])

kernel_name = 'hybrid_dsa_nsa_diffattn_deepnorm_adaln'

f32 = jnp.float32


def layer_norm(x, g=None, b=None, eps=1e-5):
    xf = x.astype(f32)
    mu = xf.mean(-1, keepdims=True)
    var = jnp.mean(jnp.square(xf - mu), -1, keepdims=True)
    y = (xf - mu) * lax.rsqrt(var + eps)
    if g is not None:
        y = y * g.astype(f32) + b.astype(f32)
    return y.astype(x.dtype)


def rms_norm(x, g, eps=1e-6):
    xf = x.astype(f32)
    y = xf * lax.rsqrt(jnp.mean(jnp.square(xf), -1, keepdims=True) + eps)
    return (y * g.astype(f32)).astype(x.dtype)


def partial_rope(x, pos):
    d = x.shape[-1]
    r = d // ROPE_FRACTION_DIV
    half = r // 2
    inv = ROPE_THETA ** (-(jnp.arange(half, dtype=f32) * 2.0) / r)
    ang = pos.astype(f32)[:, None] * inv[None, :]
    cos = jnp.cos(ang)[:, None, :]
    sin = jnp.sin(ang)[:, None, :]
    x1 = x[..., :half].astype(f32)
    x2 = x[..., half:r].astype(f32)
    rot = jnp.concatenate([x1 * cos - x2 * sin, x2 * cos + x1 * sin], -1).astype(x.dtype)
    return jnp.concatenate([rot, x[..., r:]], -1)


def masked_softmax(s, mask):
    s = jnp.where(mask, s.astype(f32), NEG)
    s = s - s.max(-1, keepdims=True)
    p = jnp.exp(s) * mask
    return p / jnp.maximum(p.sum(-1, keepdims=True), 1e-30)


def sweep_query_blocks(block_fn, L):
    out = lax.map(block_fn, jnp.arange(L // Q_BLK))
    n, B, q, w = out.shape
    return out.transpose(1, 0, 2, 3).reshape(B, n * q, w)


def dsa_attention(q, k, v, iq, ik, iw):
    B, L = q.shape[:2]
    k_sel = min(DSA_TOPK, L // 4)
    scale = HEAD_DIM ** -0.5
    idx_scale = IDX_DIM ** -0.5
    key_pos = jnp.arange(L)
    gather = jax.vmap(lambda arr, ii: arr[ii])

    def block(j):
        t = j * Q_BLK + jnp.arange(Q_BLK)
        qb = lax.dynamic_slice_in_dim(q, j * Q_BLK, Q_BLK, 1)
        iqb = lax.dynamic_slice_in_dim(iq, j * Q_BLK, Q_BLK, 1)
        iwb = lax.dynamic_slice_in_dim(iw, j * Q_BLK, Q_BLK, 1)
        rel = jax.nn.relu(jnp.einsum('bqhd,bsd->bqhs', iqb, ik) * idx_scale)
        score = jnp.einsum('bqh,bqhs->bqs', iwb, rel).astype(f32)
        causal = key_pos[None, :] <= t[:, None]
        score = jnp.where(causal, score, NEG)
        _, idx = lax.top_k(score, k_sel)
        valid = idx <= t[None, :, None]
        kg = gather(k, idx)
        vg = gather(v, idx)
        s = jnp.einsum('bqhd,bqkhd->bhqk', qb, kg) * scale
        p = masked_softmax(s, valid[:, None])
        o = jnp.einsum('bhqk,bqkhd->bqhd', p, vg)
        return o.reshape(B, Q_BLK, A_HEADS * HEAD_DIM)

    return sweep_query_blocks(block, L)


def nsa_attention(q, k, v, gate_logits, cmp_w1, cmp_w2, cmp_pe):
    B, L = q.shape[:2]
    G, D = B_KV_GROUPS, HEAD_DIM
    scale = D ** -0.5
    n_cmp = (L - CMP_LEN) // CMP_STRIDE + 1
    starts = np.arange(n_cmp) * CMP_STRIDE
    tok = starts[:, None] + np.arange(CMP_LEN)[None, :]
    cmp_end = jnp.asarray(starts + CMP_LEN - 1)

    def compress(xs, w1, w2, pe):
        blk = xs[:, tok] + pe[None, None, :, None, :]
        blk = blk.transpose(0, 1, 3, 2, 4).reshape(B, n_cmp, G, CMP_LEN * D)
        return jax.nn.silu(blk @ w1) @ w2

    kc = compress(k[:, :, 0], cmp_w1[0], cmp_w2[0], cmp_pe[0])
    vc = compress(v[:, :, 0], cmp_w1[1], cmp_w2[1], cmp_pe[1])
    n_slc = L // SLC_LEN
    n_sel = min(SLC_TOPN, n_slc)
    slc_start = np.arange(n_slc) * SLC_LEN
    cover = jnp.asarray(((starts[:, None] < slc_start[None, :] + SLC_LEN)
                         & (starts[:, None] + CMP_LEN > slc_start[None, :])).astype(np.float32))
    ks_blk = k[:, :, 1].reshape(B, n_slc, SLC_LEN, G, D).transpose(0, 3, 1, 2, 4)
    vs_blk = v[:, :, 1].reshape(B, n_slc, SLC_LEN, G, D).transpose(0, 3, 1, 2, 4)
    gather2 = jax.vmap(jax.vmap(lambda blocks, ii: blocks[ii]))
    blk_id = jnp.arange(n_slc)
    pad = ((0, 0), (WIN_LEN, 0), (0, 0), (0, 0))
    kw_pad = jnp.pad(k[:, :, 2], pad)
    vw_pad = jnp.pad(v[:, :, 2], pad)
    gates = jax.nn.sigmoid(gate_logits.astype(f32))

    def block(j):
        t = j * Q_BLK + jnp.arange(Q_BLK)
        qb = lax.dynamic_slice_in_dim(q, j * Q_BLK, Q_BLK, 1).reshape(B, Q_BLK, G, B_HPG, D)
        gb = lax.dynamic_slice_in_dim(gates, j * Q_BLK, Q_BLK, 1).reshape(B, Q_BLK, G, B_HPG, 3)
        s = jnp.einsum('bqghd,bngd->bghqn', qb, kc) * scale
        p_cmp = masked_softmax(s, cmp_end[None, :] <= t[:, None])
        o_cmp = jnp.einsum('bghqn,bngd->bqghd', p_cmp, vc)
        imp = jnp.einsum('bghqn,nm->bgqm', p_cmp, cover)
        cur = t // SLC_LEN
        forced = ((blk_id[None, :] == 0) | (blk_id[None, :] == cur[:, None])
                  | (blk_id[None, :] == cur[:, None] - 1))
        admissible = blk_id[None, :] <= cur[:, None]
        imp = jnp.where(forced, FORCE, jnp.where(admissible, imp, NEG))
        _, sel = lax.top_k(imp, n_sel)
        kg = gather2(ks_blk, sel).reshape(B, G, Q_BLK, n_sel * SLC_LEN, D)
        vg = gather2(vs_blk, sel).reshape(B, G, Q_BLK, n_sel * SLC_LEN, D)
        tok_pos = sel[..., None] * SLC_LEN + jnp.arange(SLC_LEN)
        m_slc = (tok_pos <= t[None, None, :, None, None]).reshape(B, G, 1, Q_BLK, n_sel * SLC_LEN)
        s = jnp.einsum('bqghd,bgqxd->bghqx', qb, kg) * scale
        p = masked_softmax(s, m_slc)
        o_slc = jnp.einsum('bghqx,bgqxd->bqghd', p, vg)
        kw = lax.dynamic_slice_in_dim(kw_pad, j * Q_BLK, WIN_LEN + Q_BLK, 1)
        vw = lax.dynamic_slice_in_dim(vw_pad, j * Q_BLK, WIN_LEN + Q_BLK, 1)
        s_pos = j * Q_BLK - WIN_LEN + jnp.arange(WIN_LEN + Q_BLK)
        diff = t[:, None] - s_pos[None, :]
        m_win = (s_pos[None, :] >= 0) & (diff >= 0) & (diff < WIN_LEN)
        s = jnp.einsum('bqghd,bkgd->bghqk', qb, kw) * scale
        p = masked_softmax(s, m_win)
        o_win = jnp.einsum('bghqk,bkgd->bqghd', p, vw)
        o = gb[..., 0:1] * o_cmp + gb[..., 1:2] * o_slc + gb[..., 2:3] * o_win
        return o.reshape(B, Q_BLK, B_HEADS * D)

    return sweep_query_blocks(block, L)


def diff_attention(q, k, v, lam, subln_g, lam_init):
    B, L = q.shape[:2]
    scale = C_DIM ** -0.5
    lamf = lam.astype(f32)
    lam_val = (jnp.exp(jnp.sum(lamf[0] * lamf[1])) - jnp.exp(jnp.sum(lamf[2] * lamf[3])) + lam_init)
    key_pos = jnp.arange(L)

    def block(j):
        t = j * Q_BLK + jnp.arange(Q_BLK)
        qb = lax.dynamic_slice_in_dim(q, j * Q_BLK, Q_BLK, 1)
        s = jnp.einsum('bqhmd,bkhmd->bmhqk', qb, k) * scale
        p = masked_softmax(s, key_pos[None, :] <= t[:, None])
        attn = p[:, 0] - lam_val * p[:, 1]
        o = jnp.einsum('bhqk,bkhe->bqhe', attn, v)
        o = rms_norm(o, subln_g) * (1.0 - lam_init)
        return o.reshape(B, Q_BLK, C_HEADS * 2 * C_DIM)

    return sweep_query_blocks(block, L)


def token_mixing(u, w_in, a_lat_g, a_up, cmp_w1, cmp_w2, cmp_pe, lam, c_subln_g, w_br, w_o, lam_init):
    B, L, _ = u.shape
    pos = jnp.arange(L)
    h = u @ w_in
    aq, alat, iq, ik, iw, bq, bkv, bg, cq, ck, cv, gl = jnp.split(h, list(IN_OFFSETS), axis=-1)
    aq = partial_rope(aq.reshape(B, L, A_HEADS, HEAD_DIM), pos)
    akv = (rms_norm(alat, a_lat_g) @ a_up).reshape(B, L, 2, A_HEADS, HEAD_DIM)
    ak = partial_rope(akv[:, :, 0], pos)
    av = akv[:, :, 1]
    iq = partial_rope(iq.reshape(B, L, IDX_HEADS, IDX_DIM), pos)
    ik = partial_rope(layer_norm(ik)[:, :, None, :], pos)[:, :, 0]
    iw = iw * (IDX_HEADS ** -0.5)
    ya = dsa_attention(aq, ak, av, iq, ik, iw)
    bq = partial_rope(bq.reshape(B, L, B_HEADS, HEAD_DIM), pos)
    bkv = bkv.reshape(B, L, 3, 2, B_KV_GROUPS, HEAD_DIM)
    bk = partial_rope(bkv[:, :, :, 0].reshape(B, L, 3 * B_KV_GROUPS, HEAD_DIM), pos)
    bk = bk.reshape(B, L, 3, B_KV_GROUPS, HEAD_DIM)
    bv = bkv[:, :, :, 1]
    yb = nsa_attention(bq, bk, bv, bg.reshape(B, L, B_HEADS, 3), cmp_w1, cmp_w2, cmp_pe)
    cq = partial_rope(cq.reshape(B, L, C_HEADS * 2, C_DIM), pos).reshape(B, L, C_HEADS, 2, C_DIM)
    ck = partial_rope(ck.reshape(B, L, C_HEADS * 2, C_DIM), pos).reshape(B, L, C_HEADS, 2, C_DIM)
    cv = cv.reshape(B, L, C_HEADS, 2 * C_DIM)
    yc = diff_attention(cq, ck, cv, lam, c_subln_g, lam_init)
    y = jnp.stack([ya, yb, yc])
    br = jnp.einsum('rbse,red->rbsd', y, w_br)
    g = jax.nn.sigmoid(gl.astype(f32)).reshape(B, L, N_BRANCH, D_MODEL)
    merged = jnp.einsum('bsrd,rbsd->bsd', g, br)
    return merged @ w_o


def setup_inputs(seed: int = 0) -> dict:
    key = jax.random.key(seed)
    ks = jax.random.split(key, 18)

    def nrm(k, shape, s):
        return jax.random.normal(k, shape, f32) * s

    return {
        'x': nrm(ks[0], (BATCH, SEQ, D_MODEL), 1.0),
        'c': nrm(ks[1], (BATCH, D_MODEL), 1.0),
        'w_ada': nrm(ks[2], (DEPTH, D_MODEL, 6 * D_MODEL), 0.5 * D_MODEL ** -0.5),
        'b_ada': nrm(ks[3], (DEPTH, 6 * D_MODEL), 0.02),
        'w_in': nrm(ks[4], (DEPTH, D_MODEL, N_IN), D_MODEL ** -0.5),
        'a_lat_g': 1.0 + nrm(ks[5], (DEPTH, A_LATENT), 0.02),
        'a_up': nrm(ks[6], (DEPTH, A_LATENT, 2 * A_HEADS * HEAD_DIM), A_LATENT ** -0.5),
        'cmp_w1': nrm(ks[7], (DEPTH, 2, CMP_LEN * HEAD_DIM, HEAD_DIM), (CMP_LEN * HEAD_DIM) ** -0.5),
        'cmp_w2': nrm(ks[8], (DEPTH, 2, HEAD_DIM, HEAD_DIM), HEAD_DIM ** -0.5),
        'cmp_pe': nrm(ks[9], (DEPTH, 2, CMP_LEN, HEAD_DIM), 0.1),
        'lam': nrm(ks[10], (DEPTH, 4, C_DIM), 0.1),
        'c_subln_g': 1.0 + nrm(ks[11], (DEPTH, 2 * C_DIM), 0.02),
        'w_br': nrm(ks[12], (DEPTH, N_BRANCH, BRANCH_W, D_MODEL), BETA * BRANCH_W ** -0.5),
        'w_o': nrm(ks[13], (DEPTH, D_MODEL, D_MODEL), BETA * D_MODEL ** -0.5),
        'w_ffn_in': nrm(ks[14], (DEPTH, D_MODEL, 2 * D_FF), D_MODEL ** -0.5),
        'w_ffn_out': nrm(ks[15], (DEPTH, D_FF, D_MODEL), BETA * D_FF ** -0.5),
        'ln_g': 1.0 + nrm(ks[16], (DEPTH, 2, D_MODEL), 0.02),
        'ln_b': nrm(ks[17], (DEPTH, 2, D_MODEL), 0.02),
    }


def reference(x, c, w_ada, b_ada, w_in, a_lat_g, a_up, cmp_w1, cmp_w2, cmp_pe, lam, c_subln_g,
              w_br, w_o, w_ffn_in, w_ffn_out, ln_g, ln_b):
    cs = jax.nn.silu(c)
    for l in range(DEPTH):
        lam_init = 0.8 - 0.6 * math.exp(-0.3 * l)
        mod = cs @ w_ada[l] + b_ada[l]
        sh_a, sc_a, g_a, sh_f, sc_f, g_f = jnp.split(mod, 6, axis=-1)
        u = layer_norm(x) * (1.0 + sc_a[:, None]) + sh_a[:, None]
        y = token_mixing(u, w_in[l], a_lat_g[l], a_up[l], cmp_w1[l], cmp_w2[l], cmp_pe[l],
                         lam[l], c_subln_g[l], w_br[l], w_o[l], lam_init)
        x = layer_norm(ALPHA * x + g_a[:, None] * y, ln_g[l, 0], ln_b[l, 0])
        u = layer_norm(x) * (1.0 + sc_f[:, None]) + sh_f[:, None]
        gate, up = jnp.split(u @ w_ffn_in[l], 2, axis=-1)
        f = (jax.nn.silu(gate) * up) @ w_ffn_out[l]
        x = layer_norm(ALPHA * x + g_f[:, None] * f, ln_g[l, 1], ln_b[l, 1])
    return x
```

```cpp
#include <hip/hip_runtime.h>
#include <hip/hip_cooperative_groups.h>
#include <cstdio>
#include <cstdint>
namespace cg = cooperative_groups;

#define DI __device__ __forceinline__
#define LAS __attribute__((address_space(3)))
typedef unsigned short bf16_t;
typedef short bf16x8 __attribute__((ext_vector_type(8)));
typedef short s16x4 __attribute__((ext_vector_type(4)));
typedef float f32x4 __attribute__((ext_vector_type(4)));
typedef float f32x16 __attribute__((ext_vector_type(16)));
typedef unsigned u32x4 __attribute__((ext_vector_type(4)));
typedef unsigned u32x2 __attribute__((ext_vector_type(2)));
typedef unsigned long long u64;

constexpr int T = 8192, SL = 4096, DM = 2048, NPHYS = 14336, DFF = 5632, NIN = 14440;
constexpr int H_AQ = 0, H_ALAT = 1024, H_IQ = 1536, H_BQ = 2560, H_BKV = 3584, H_CQ = 5120, H_CK = 6144, H_GL = 8192;
constexpr float ALPHA = 1.4142135623730951f;
constexpr float C2 = 0.08838834764831845f * 1.4426950408889634f;
constexpr int NTHR = 512;
constexpr int LDS_BYTES = 147456, SLOT_OFF = 145408, XST_OFF = 146432, PD_OFF = 73728;

constexpr size_t al256(size_t x) { return (x + 255) & ~(size_t)255; }
constexpr size_t O_WIN = 0;
constexpr size_t O_WAUP = O_WIN + (size_t)NPHYS * 2048 * 2;
constexpr size_t O_WC1 = O_WAUP + (size_t)2048 * 512 * 2;
constexpr size_t O_WBR = O_WC1 + (size_t)256 * 4096 * 2;
constexpr size_t O_WO = O_WBR + (size_t)3 * 2048 * 1024 * 2;
constexpr size_t O_WF1 = O_WO + (size_t)2048 * 2048 * 2;
constexpr size_t O_WF2 = O_WF1 + (size_t)2 * DFF * 2048 * 2;
constexpr size_t O_WMISC = O_WF2 + (size_t)2048 * DFF * 2;
constexpr size_t O_H = O_WMISC + (size_t)256 * 2048 * 2;
constexpr size_t O_HID = O_H;
constexpr size_t O_X1 = O_H + (size_t)T * DFF * 2;
constexpr size_t O_S = O_H + (size_t)T * NPHYS * 2;
constexpr size_t O_MISCP = O_S;
constexpr size_t O_PCMP = O_S;
constexpr size_t O_OC = O_S + (size_t)T * 2048 * 4;
constexpr size_t O_TMP = O_S;
constexpr size_t O_Z = O_OC;
constexpr size_t O_XBUF = O_S + (size_t)T * 4096 * 4;
constexpr size_t O_UBUF = O_XBUF + (size_t)T * DM * 4;
constexpr size_t O_AVT = O_UBUF + (size_t)T * DM * 2;
constexpr size_t O_BVT = O_AVT + (size_t)2 * 8 * 128 * 4096 * 2;
constexpr size_t O_CVT = O_BVT + (size_t)2 * 2 * 2 * 128 * 4096 * 2;
constexpr size_t O_AK = O_CVT + (size_t)2 * 4 * 256 * 4096 * 2;
constexpr size_t O_MISC = O_AK + (size_t)T * 1024 * 2;
constexpr size_t O_IKN = O_MISC + (size_t)T * 128 * 4;
constexpr size_t O_IWF = O_IKN + (size_t)T * 64 * 2;
constexpr size_t O_BG = O_IWF + (size_t)T * 16 * 4;
constexpr size_t O_SROW = O_BG + (size_t)T * 24 * 4;
constexpr size_t O_BLK = O_SROW + (size_t)T * 4;
constexpr size_t O_CPART = O_BLK + (size_t)2048 * 4096 * 2;
constexpr size_t O_KC = O_CPART + (size_t)8 * 2048 * 256 * 4;
constexpr size_t O_VCT = O_KC + (size_t)2 * 2 * 256 * 128 * 2;
constexpr size_t O_BITS = O_VCT + (size_t)2 * 2 * 128 * 256 * 2;
constexpr size_t O_SEL = O_BITS + (size_t)T * 64 * 8;
constexpr size_t O_ML = O_SEL + (size_t)2 * 2 * 4096 * 8;
constexpr size_t O_YA = O_ML + (size_t)2 * 8 * 4096 * 2 * 4;
constexpr size_t O_YB = O_YA + (size_t)T * 1024 * 2;
constexpr size_t O_YC = O_YB + (size_t)T * 1024 * 2;
constexpr size_t O_OCMP = O_YC + (size_t)T * 1024 * 2;
constexpr size_t O_OWIN = O_OCMP + (size_t)T * 1024 * 2;
constexpr size_t O_MERG = O_OWIN + (size_t)T * 1024 * 2;
constexpr size_t O_MODP = O_MERG + (size_t)T * DM * 2;
constexpr size_t O_MOD = O_MODP + (size_t)8 * 2 * 2 * 12288 * 4;
constexpr size_t O_ROPA = O_MOD + (size_t)2 * 2 * 12288 * 4;
constexpr size_t O_ROPI = O_ROPA + (size_t)4096 * 32 * 4;
constexpr size_t O_SCAL = O_ROPI + (size_t)4096 * 16 * 4;
constexpr size_t O_CTR = O_SCAL + 256;
constexpr size_t O_SC = O_CTR + 256;
constexpr size_t O_LNC = O_SC + 512;
constexpr size_t O_LNS = O_LNC + 1024;
constexpr size_t O_BAR = O_LNS + (size_t)2 * 32 * 256 * 16 * 4;
constexpr size_t WS_TOTAL = O_BAR + 3456 * 4;

struct Params {
  const float *x, *c, *w_ada, *b_ada, *w_in, *a_lat_g, *a_up, *cmp_w1, *cmp_w2, *cmp_pe, *lam, *subln_g, *w_br, *w_o, *w_f1, *w_f2, *ln_g, *ln_b;
  float* out;
  unsigned char* ws;
};

DI unsigned cvtpk(float lo, float hi) { unsigned r; asm volatile("v_cvt_pk_bf16_f32 %0, %1, %2" : "=v"(r) : "v"(lo), "v"(hi)); return r; }
DI float bf2f(bf16_t b) { return __uint_as_float(((unsigned)b) << 16); }
DI bf16_t f2bf(float f) { return (bf16_t)(cvtpk(f, 0.f) & 0xffffu); }
DI float wsum(float v) { for (int o = 32; o; o >>= 1) v += __shfl_xor(v, o); return v; }
DI float sigm(float x) { return __builtin_amdgcn_rcpf(1.f + __expf(-x)); }
DI float silu(float x) { return x * __builtin_amdgcn_rcpf(1.f + __expf(-x)); }
DI int crow(int r, int hi) { return (r & 3) + 8 * (r >> 2) + 4 * hi; }
DI float vmin_raw(float a, float b) { float r; asm("v_min_f32_e32 %0, %1, %2" : "=v"(r) : "v"(a), "v"(b)); return r; }
DI int ltid() { int t = threadIdx.x; asm volatile("" : "+v"(t)); return t; }
DI int lbid() { int b = blockIdx.x; asm volatile("" : "+s"(b)); return b; }
#define PHASE_VARS const int tid = ltid(), bid = lbid(), nblk = gridDim.x, gtid = bid * NTHR + tid, gthreads = nblk * NTHR, lane = tid & 63, wid = tid >> 6, gw = bid * 8 + wid, nw = nblk * 8; (void)gtid; (void)gthreads; (void)lane; (void)wid; (void)gw; (void)nw;

struct MapId { int off; DI int operator()(int n) const { return n + off; } };
struct MapIn { DI int operator()(int n) const {
    if (n < 2560) return n;
    if (n < 5120) return n + 80;
    return n + 104; } };
struct MapMisc { DI int operator()(int n) const { return n < 80 ? 2560 + n : (n < 104 ? 5200 + (n - 80) : -1); } };
struct MapF1 { DI int operator()(int n) const { const int q = n >> 5, r = n & 31; return r < 16 ? q * 16 + r : DFF + q * 16 + (r - 16); } };

template <class Map>
DI void conv_T(bf16_t* __restrict__ dst, const float* __restrict__ src, int K, int ldsrc, int nphys, Map map, const float* __restrict__ kscale, float* tile) {
  const int tid = ltid(), ntn = nphys >> 6, ntiles = (K >> 6) * ntn;
  for (int tl = lbid(); tl < ntiles; tl += gridDim.x) {
    const int k0 = (tl / ntn) << 6, n0 = (tl % ntn) << 6;
    const int nn = tid & 63, sc = map(n0 + nn);
#pragma unroll
    for (int i = 0; i < 8; ++i) { const int kk = i * 8 + (tid >> 6);
      float v = sc >= 0 ? src[(size_t)(k0 + kk) * ldsrc + sc] : 0.f;
      if (kscale) v *= kscale[k0 + kk];
      tile[kk * 65 + nn] = v; }
    __syncthreads();
    const int np = tid >> 3, ks = tid & 7;
    float v[8];
#pragma unroll
    for (int j = 0; j < 8; ++j) v[j] = tile[(ks * 8 + j) * 65 + np];
    u32x4 w = {cvtpk(v[0], v[1]), cvtpk(v[2], v[3]), cvtpk(v[4], v[5]), cvtpk(v[6], v[7])};
    *(u32x4*)(dst + (size_t)(n0 + np) * K + k0 + ks * 8) = w;
    __syncthreads();
  }
}

DI void convert_layer(const Params& p, int l, float* tile) {
  unsigned char* ws = p.ws;
  conv_T((bf16_t*)(ws + O_WIN), p.w_in + (size_t)l * 2048 * NIN, 2048, NIN, NPHYS, MapIn{}, nullptr, tile);
  conv_T((bf16_t*)(ws + O_WMISC), p.w_in + (size_t)l * 2048 * NIN, 2048, NIN, 256, MapMisc{}, nullptr, tile);
  conv_T((bf16_t*)(ws + O_WAUP), p.a_up + (size_t)l * 512 * 2048, 512, 2048, 2048, MapId{0}, p.a_lat_g + l * 512, tile);
  conv_T((bf16_t*)(ws + O_WC1), p.cmp_w1 + (size_t)(l * 2 + 0) * 4096 * 128, 4096, 128, 128, MapId{0}, nullptr, tile);
  conv_T((bf16_t*)(ws + O_WC1) + (size_t)128 * 4096, p.cmp_w1 + (size_t)(l * 2 + 1) * 4096 * 128, 4096, 128, 128, MapId{0}, nullptr, tile);
  for (int r = 0; r < 3; ++r)
    conv_T((bf16_t*)(ws + O_WBR) + (size_t)r * 2048 * 1024, p.w_br + (size_t)(l * 3 + r) * 1024 * 2048, 1024, 2048, 2048, MapId{0}, nullptr, tile);
  conv_T((bf16_t*)(ws + O_WO), p.w_o + (size_t)l * 2048 * 2048, 2048, 2048, 2048, MapId{0}, nullptr, tile);
  conv_T((bf16_t*)(ws + O_WF1), p.w_f1 + (size_t)l * 2048 * 2 * DFF, 2048, 2 * DFF, 2 * DFF, MapF1{}, nullptr, tile);
  conv_T((bf16_t*)(ws + O_WF2), p.w_f2 + (size_t)l * DFF * 2048, DFF, 2048, 2048, MapId{0}, nullptr, tile);
}

DI void ln_phase(const float* __restrict__ zin, const float* __restrict__ gam, const float* __restrict__ bet, float* __restrict__ xout,
                 const float* __restrict__ modl  , int sh_idx, int sc_idx, bf16_t* __restrict__ uout) {
  const int tid_ = ltid(), lane = tid_ & 63, gw = lbid() * 8 + (tid_ >> 6), nw = gridDim.x * 8;
  for (int row = gw; row < T; row += nw) {
    f32x4 v[8];
    const float* zr = zin + (size_t)row * DM;
#pragma unroll
    for (int i = 0; i < 8; ++i) v[i] = *(const f32x4*)(zr + i * 256 + lane * 4);
    if (gam) {
      float s = 0; for (int i = 0; i < 8; ++i) s += v[i][0] + v[i][1] + v[i][2] + v[i][3];
      const float mu = wsum(s) * (1.f / DM);
      float q = 0; for (int i = 0; i < 8; ++i) for (int j = 0; j < 4; ++j) { const float d = v[i][j] - mu; q += d * d; }
      const float rstd = rsqrtf(wsum(q) * (1.f / DM) + 1e-5f);
#pragma unroll
      for (int i = 0; i < 8; ++i) { const f32x4 g = *(const f32x4*)(gam + i * 256 + lane * 4), b = *(const f32x4*)(bet + i * 256 + lane * 4);
        for (int j = 0; j < 4; ++j) v[i][j] = (v[i][j] - mu) * rstd * g[j] + b[j];
        *(f32x4*)(xout + (size_t)row * DM + i * 256 + lane * 4) = v[i]; }
    }
    if (uout) {
      const float* mb = modl + (row >> 12) * 12288;
      float s = 0; for (int i = 0; i < 8; ++i) s += v[i][0] + v[i][1] + v[i][2] + v[i][3];
      const float mu = wsum(s) * (1.f / DM);
      float q = 0; for (int i = 0; i < 8; ++i) for (int j = 0; j < 4; ++j) { const float d = v[i][j] - mu; q += d * d; }
      const float rstd = rsqrtf(wsum(q) * (1.f / DM) + 1e-5f);
#pragma unroll
      for (int i = 0; i < 8; ++i) { const int c = i * 256 + lane * 4;
        const f32x4 sc = *(const f32x4*)(mb + sc_idx * 2048 + c), sh = *(const f32x4*)(mb + sh_idx * 2048 + c);
        float o[4]; for (int j = 0; j < 4; ++j) o[j] = (v[i][j] - mu) * rstd * (1.f + sc[j]) + sh[j];
        u32x2 w = {cvtpk(o[0], o[1]), cvtpk(o[2], o[3])};
        *(u32x2*)(uout + (size_t)row * DM + c) = w; }
    }
  }
}

constexpr int BM = 256, BK = 64, HALF = 128, HTB = HALF * BK * 2, NXCD = 8, WGM = 8;
DI int lds_byte(int r, int c) { const int st = (r >> 4) * 2 + (c >> 5), rr = r & 15, cc = c & 31, ob = rr * 64 + cc * 2; return st * 1024 + (ob ^ (((ob >> 9) & 1) << 5)); }
DI void stage_rc(int b, int& R, int& C) { const int st = b / 1024, sb = b % 1024, swz = sb ^ (((sb >> 9) & 1) << 5); R = (st >> 1) * 16 + swz / 64; C = (st & 1) * 32 + (swz % 64) / 2; }
DI int perm32(int rho) { const int n = rho >> 4, i = rho & 15; return 8 * (i >> 2) + 4 * n + (i & 3); }
struct Unit { int pm, pn; };
struct Gemm { const bf16_t* A; const bf16_t* Bt; int M, N, K, lda, ldb; };
struct Sched {
  int nM, nN, nwg, G, c;
  DI void init(int M, int N, int G_, int c_) { nM = M / BM; nN = N / BM; nwg = nM * nN; G = G_; c = c_; }
  DI bool next(int i, Unit& u) const {
    const long L = (long)i * G + c; if (L >= nwg) return false;
    int wgid = (int)L; { const int q = nwg / NXCD, r = nwg % NXCD, xcd = wgid % NXCD, off = wgid / NXCD; wgid = (xcd < r ? xcd * (q + 1) : r * (q + 1) + (xcd - r) * q) + off; }
    const int nig = WGM * nN, gid = wgid / nig, fm = gid * WGM, gsz = (nM - fm) < WGM ? (nM - fm) : WGM;
    u.pm = fm + ((wgid % nig) % gsz); u.pn = (wgid % nig) / gsz; return true;
  }
};

template <class Epi>
DI void gemm_phase(LAS unsigned char* lds, const Gemm g, const Sched& S, const Epi& E) {
  const int tid = ltid(), wid = __builtin_amdgcn_readfirstlane(tid >> 6), lane = tid & 63, wr = wid >> 2, wc = wid & 3, fr = lane & 15, fq = lane >> 4;
  const int K = g.K, nt = K / BK;
  unsigned voffA[2], voffB[2];
#pragma unroll
  for (int i = 0; i < 2; ++i) { int R, C; stage_rc(tid * 16 + i * 8192, R, C); const int Rb = Epi::PERM ? ((R & ~31) + perm32(R & 31)) : R;
    voffA[i] = (unsigned)(R * g.lda + C) * 2u; voffB[i] = (unsigned)(Rb * g.ldb + C) * 2u; }
  const size_t kstep = (size_t)(BK * 2);
  const size_t hstepA = (size_t)HALF * g.lda * 2, hstepB = (size_t)HALF * g.ldb * 2;
  const size_t tstepA = 2 * hstepA, tstepB = 2 * hstepB;
  const unsigned ldsw = (unsigned)wid * 1024u;
  const int aoff = lds_byte(wr * 64 + fr, fq * 8), boff = lds_byte(wc * 32 + fr, fq * 8);
#define PG8_SA(b, h) (((b) * 2 + (h)) * HTB)
#define PG8_SB(b, h) ((4 + (b) * 2 + (h)) * HTB)
#define PG8_STAGE(bufoff, gbase, voff) do { _Pragma("unroll") for (int _i = 0; _i < 2; ++_i) \
        __builtin_amdgcn_global_load_lds((const unsigned*)((const char*)(gbase) + (voff)[_i]), (LAS unsigned*)(lds + (bufoff) + ldsw + _i * 8192), 16, 0, 0); } while (0)
#define PG8_LDA(dst, b, h) do { _Pragma("unroll") for (int m = 0; m < 4; ++m) _Pragma("unroll") for (int k = 0; k < 2; ++k) dst[m][k] = *(const LAS bf16x8*)(lds + PG8_SA(b, h) + aoff + m * 2048 + k * 1024); } while (0)
#define PG8_LDB(dst, b, h) do { _Pragma("unroll") for (int n = 0; n < 2; ++n) _Pragma("unroll") for (int k = 0; k < 2; ++k) dst[n][k] = *(const LAS bf16x8*)(lds + PG8_SB(b, h) + boff + n * 2048 + k * 1024); } while (0)
#define PG8_MMA(ai, bj, At, Bt) do { __builtin_amdgcn_s_setprio(1); _Pragma("unroll") for (int m = 0; m < 4; ++m) _Pragma("unroll") for (int n = 0; n < 2; ++n) _Pragma("unroll") for (int k = 0; k < 2; ++k) \
        acc[ai][bj][m][n] = __builtin_amdgcn_mfma_f32_16x16x32_bf16(Bt[n][k], At[m][k], acc[ai][bj][m][n], 0, 0, 0); __builtin_amdgcn_s_setprio(0); } while (0)
#define PG8_WAIT_V(n) asm volatile("s_waitcnt vmcnt(" #n ")" ::: "memory")
#define PG8_WAIT_L(n) asm volatile("s_waitcnt lgkmcnt(" #n ")" ::: "memory")
#define PG8_BAR __builtin_amdgcn_s_barrier()
#define PG8_SCHED __builtin_amdgcn_sched_barrier(0)
  Unit cur, nxt; int ui = 0;
  if (!S.next(0, cur)) return;
  f32x4 acc[2][2][4][2];
#pragma unroll
  for (int a = 0; a < 2; ++a)
#pragma unroll
    for (int b = 0; b < 2; ++b)
#pragma unroll
      for (int m = 0; m < 4; ++m)
#pragma unroll
        for (int n = 0; n < 2; ++n) acc[a][b][m][n] = (f32x4){0.f, 0.f, 0.f, 0.f};
  bf16x8 At[4][2], B0[2][2], B1[2][2];
  const char* cA = (const char*)g.A + (size_t)cur.pm * tstepA; const char* cB = (const char*)g.Bt + (size_t)cur.pn * tstepB;
  PG8_STAGE(PG8_SB(0, 0), cB, voffB); PG8_STAGE(PG8_SB(0, 1), cB + hstepB, voffB); PG8_STAGE(PG8_SA(0, 0), cA, voffA); PG8_STAGE(PG8_SA(0, 1), cA + hstepA, voffA);
  if (wr == 1) PG8_BAR;
  PG8_WAIT_V(2); PG8_BAR;
  PG8_STAGE(PG8_SB(1, 0), cB + kstep, voffB); PG8_STAGE(PG8_SA(1, 0), cA + kstep, voffA); PG8_STAGE(PG8_SB(1, 1), cB + hstepB + kstep, voffB);
  PG8_WAIT_V(6); PG8_BAR;
  for (;;) {
    const bool has_next = S.next(ui + 1, nxt);
    const char* nA = has_next ? (const char*)g.A + (size_t)nxt.pm * tstepA : cA; const char* nB = has_next ? (const char*)g.Bt + (size_t)nxt.pn * tstepB : cB;
    for (int t = 0; t < nt; t += 2) {
      const bool last = (t == nt - 2);
      const char* a1 = cA + (size_t)(t + 1) * kstep;
      const char* a2 = last ? nA : cA + (size_t)(t + 2) * kstep; const char* b2 = last ? nB : cB + (size_t)(t + 2) * kstep;
      const char* a3 = a2 + kstep; const char* b3 = b2 + kstep;
      PG8_LDB(B0, 0, 0); PG8_LDB(B1, 0, 1); PG8_SCHED; PG8_LDA(At, 0, 0); PG8_STAGE(PG8_SA(1, 1), a1 + hstepA, voffA);
      PG8_WAIT_V(8); PG8_WAIT_L(0); PG8_BAR; PG8_MMA(0, 0, At, B0); PG8_MMA(0, 1, At, B1); PG8_BAR; PG8_SCHED;
      PG8_LDA(At, 0, 1); PG8_STAGE(PG8_SB(0, 0), b2, voffB); PG8_STAGE(PG8_SB(0, 1), b2 + hstepB, voffB); PG8_STAGE(PG8_SA(0, 0), a2, voffA);
      PG8_WAIT_V(8); PG8_WAIT_L(0); PG8_BAR; PG8_MMA(1, 0, At, B0); PG8_MMA(1, 1, At, B1); PG8_BAR; PG8_SCHED;
      PG8_LDB(B0, 1, 0); PG8_LDB(B1, 1, 1); PG8_SCHED; PG8_LDA(At, 1, 0); PG8_STAGE(PG8_SA(0, 1), a2 + hstepA, voffA);
      PG8_WAIT_V(8); PG8_WAIT_L(0); PG8_BAR; PG8_MMA(0, 0, At, B0); PG8_MMA(0, 1, At, B1); PG8_BAR; PG8_SCHED;
      PG8_LDA(At, 1, 1); PG8_STAGE(PG8_SB(1, 0), b3, voffB); PG8_STAGE(PG8_SB(1, 1), b3 + hstepB, voffB); PG8_STAGE(PG8_SA(1, 0), a3, voffA);
      PG8_WAIT_V(8); PG8_WAIT_L(0); PG8_BAR; PG8_MMA(1, 0, At, B0); PG8_MMA(1, 1, At, B1); PG8_BAR; PG8_SCHED;
    }
    if constexpr (!Epi::AFTER_DRAIN) { if (wr == 0) PG8_BAR;
      E(acc, cur, wr, wc, fr, fq); }
    if (!has_next) break;
#pragma unroll
    for (int a = 0; a < 2; ++a)
#pragma unroll
      for (int b = 0; b < 2; ++b)
#pragma unroll
        for (int m = 0; m < 4; ++m)
#pragma unroll
          for (int n = 0; n < 2; ++n) acc[a][b][m][n] = (f32x4){0.f, 0.f, 0.f, 0.f};
    cur = nxt; cA = nA; cB = nB; ++ui;
    if constexpr (!Epi::AFTER_DRAIN) { if (wr == 1) PG8_BAR; }
  }
  PG8_WAIT_V(0);
  if constexpr (Epi::AFTER_DRAIN) { if (wr == 0) PG8_BAR; }
  PG8_BAR;
  if constexpr (Epi::AFTER_DRAIN) E.fused(acc, cur, lds, tid, wr, wc, fr, fq);
#undef PG8_SA
#undef PG8_SB
#undef PG8_STAGE
#undef PG8_LDA
#undef PG8_LDB
#undef PG8_MMA
#undef PG8_WAIT_V
#undef PG8_WAIT_L
#undef PG8_BAR
#undef PG8_SCHED
}

typedef f32x4 AccT[2][2][4][2];

DI void rope128(f32x4& v0, f32x4& v1, const float* ropeA, int pos, int fq) {
  const f32x4 cs = *(const f32x4*)(ropeA + pos * 32 + 4 * fq), sn = *(const f32x4*)(ropeA + pos * 32 + 16 + 4 * fq);
#pragma unroll
  for (int j = 0; j < 4; ++j) { const float x1 = v0[j], x2 = v1[j]; v0[j] = x1 * cs[j] - x2 * sn[j]; v1[j] = x2 * cs[j] + x1 * sn[j]; }
}
DI void store_vt(bf16_t* base  , int d0, int pos, const f32x4& v) {
#pragma unroll
  for (int j = 0; j < 4; ++j) base[(size_t)(d0 + j) * SL + pos] = f2bf(v[j]);
}

struct EpiIn {
  static constexpr bool PERM = false, AFTER_DRAIN = false;
  bf16_t* h; bf16_t* bvT; bf16_t* cvT; const float* ropeA; const float* ropeI;
  DI void operator()(const AccT& acc, const Unit& u, int wr, int wc, int fr, int fq) const {
#pragma unroll
    for (int bj = 0; bj < 2; ++bj) {
      const int cb = u.pn * 2 + bj;
      int type;
      if (cb < 8) type = 1; else if (cb < 12) type = 0; else if (cb < 20) type = 2; else if (cb < 28) type = 1;
      else if (cb < 40) { const int idx = cb - 28, br = idx >> 2, kv = (idx >> 1) & 1; type = kv == 0 ? 1 : (br == 0 ? 0 : 4); }
      else if (cb < 56) type = 1; else if (cb < 64) type = 5; else type = 6;
#pragma unroll
      for (int ai = 0; ai < 2; ++ai)
#pragma unroll
        for (int m = 0; m < 4; ++m) {
          const int row = u.pm * BM + ai * HALF + wr * 64 + m * 16 + fr, pos = row & (SL - 1), b = row >> 12;
          f32x4 v0 = acc[ai][bj][m][0], v1 = acc[ai][bj][m][1];
          const int cin = wc * 32 + 4 * fq;
          if (type == 1) { if (wc == 0) rope128(v0, v1, ropeA, pos, fq); }
          else if (type == 2) { if ((wc & 1) == 0) {
              const f32x4 cs = *(const f32x4*)(ropeI + pos * 16 + 4 * (fq & 1)), sn = *(const f32x4*)(ropeI + pos * 16 + 8 + 4 * (fq & 1));
#pragma unroll
              for (int j = 0; j < 4; ++j) { const float mine = v0[j], oth = __shfl_xor(mine, 32);
                v0[j] = fq < 2 ? mine * cs[j] - oth * sn[j] : mine * cs[j] + oth * sn[j]; } } }
          else if (type == 6) { for (int j = 0; j < 4; ++j) { v0[j] = sigm(v0[j]); v1[j] = sigm(v1[j]); } }
          if (type == 4) { const int idx = cb - 28, br = idx >> 2, gg = idx & 1; bf16_t* base = bvT + (size_t)(((b * 2 + (br - 1)) * 2 + gg) * 128) * SL;
            store_vt(base, cin, pos, v0); store_vt(base, cin + 16, pos, v1); }
          else if (type == 5) { const int idx = cb - 56; bf16_t* base = cvT + (size_t)((b * 4 + (idx >> 1)) * 256 + (idx & 1) * 128) * SL;
            store_vt(base, cin, pos, v0); store_vt(base, cin + 16, pos, v1); }
          else { bf16_t* dp = h + (size_t)row * NPHYS + cb * 128 + cin;
            *(u32x2*)dp = (u32x2){cvtpk(v0[0], v0[1]), cvtpk(v0[2], v0[3])}; *(u32x2*)(dp + 16) = (u32x2){cvtpk(v1[0], v1[1]), cvtpk(v1[2], v1[3])}; }
        }
    }
  }
};

struct EpiAup {
  static constexpr bool PERM = false, AFTER_DRAIN = false;
  bf16_t* ak; bf16_t* avT; const float* srow; const float* ropeA;
  DI void operator()(const AccT& acc, const Unit& u, int wr, int wc, int fr, int fq) const {
#pragma unroll
    for (int bj = 0; bj < 2; ++bj) {
      const int cb = u.pn * 2 + bj;
#pragma unroll
      for (int ai = 0; ai < 2; ++ai)
#pragma unroll
        for (int m = 0; m < 4; ++m) {
          const int row = u.pm * BM + ai * HALF + wr * 64 + m * 16 + fr, pos = row & (SL - 1), b = row >> 12;
          const float s = srow[row];
          f32x4 v0 = acc[ai][bj][m][0] * s, v1 = acc[ai][bj][m][1] * s;
          const int cin = wc * 32 + 4 * fq;
          if (cb < 8) { if (wc == 0) rope128(v0, v1, ropeA, pos, fq);
            bf16_t* dp = ak + (size_t)row * 1024 + cb * 128 + cin;
            *(u32x2*)dp = (u32x2){cvtpk(v0[0], v0[1]), cvtpk(v0[2], v0[3])}; *(u32x2*)(dp + 16) = (u32x2){cvtpk(v1[0], v1[1]), cvtpk(v1[2], v1[3])}; }
          else { bf16_t* base = avT + (size_t)((b * 8 + (cb - 8)) * 128) * SL; store_vt(base, cin, pos, v0); store_vt(base, cin + 16, pos, v1); }
        }
    }
  }
};

struct EpiF32 {
  static constexpr bool PERM = false, AFTER_DRAIN = false;
  float* C; int ldc;
  DI void operator()(const AccT& acc, const Unit& u, int wr, int wc, int fr, int fq) const {
#pragma unroll
    for (int ai = 0; ai < 2; ++ai)
#pragma unroll
      for (int m = 0; m < 4; ++m) { float* rowp = C + (size_t)(u.pm * BM + ai * HALF + wr * 64 + m * 16 + fr) * ldc + u.pn * BM + wc * 32 + 4 * fq;
#pragma unroll
        for (int bj = 0; bj < 2; ++bj)
#pragma unroll
          for (int n = 0; n < 2; ++n) *(f32x4*)(rowp + bj * HALF + n * 16) = acc[ai][bj][m][n]; }
  }
};

struct EpiHalfF32 {
  static constexpr bool PERM = false, AFTER_DRAIN = false;
  float* C;
  DI void operator()(const AccT& acc, const Unit& u, int wr, int wc, int fr, int fq) const {
#pragma unroll
    for (int ai = 0; ai < 2; ++ai)
#pragma unroll
      for (int m = 0; m < 4; ++m) { float* rowp = C + (size_t)(u.pm * BM + ai * HALF + wr * 64 + m * 16 + fr) * 128 + wc * 32 + 4 * fq;
#pragma unroll
        for (int n = 0; n < 2; ++n) *(f32x4*)(rowp + n * 16) = acc[ai][0][m][n]; }
  }
};

struct EpiGate {
  static constexpr bool PERM = true, AFTER_DRAIN = false;
  const bf16_t* h; float* tmp; bf16_t* merged; int r;
  DI void operator()(const AccT& acc, const Unit& u, int wr, int wc, int fr, int fq) const {
#pragma unroll
    for (int ai = 0; ai < 2; ++ai)
#pragma unroll
      for (int m = 0; m < 4; ++m) {
        const int row = u.pm * BM + ai * HALF + wr * 64 + m * 16 + fr;
#pragma unroll
        for (int bj = 0; bj < 2; ++bj) {
          const int c8 = u.pn * BM + bj * HALF + wc * 32 + 8 * fq;
          const bf16x8 gt = *(const bf16x8*)(h + (size_t)row * NPHYS + H_GL + r * 2048 + c8);
          bf16_t* mp = merged + (size_t)row * DM + c8;
          f32x4 a0 = acc[ai][bj][m][0], a1 = acc[ai][bj][m][1];
#pragma unroll
          for (int j = 0; j < 4; ++j) { a0[j] *= bf2f((bf16_t)gt[j]); a1[j] *= bf2f((bf16_t)gt[4 + j]); }
          if (r > 0) { const bf16x8 pv = *(const bf16x8*)mp;
#pragma unroll
            for (int j = 0; j < 4; ++j) { a0[j] += bf2f((bf16_t)pv[j]); a1[j] += bf2f((bf16_t)pv[4 + j]); } }
          { u32x4 w = {cvtpk(a0[0], a0[1]), cvtpk(a0[2], a0[3]), cvtpk(a1[0], a1[1]), cvtpk(a1[2], a1[3])}; *(u32x4*)mp = w; }
        }
      }
  }
};

struct EpiRes {
  static constexpr bool PERM = false, AFTER_DRAIN = false;
  const float* xin; const float* gv  ; float* z;
  DI void operator()(const AccT& acc, const Unit& u, int wr, int wc, int fr, int fq) const {
#pragma unroll
    for (int ai = 0; ai < 2; ++ai)
#pragma unroll
      for (int m = 0; m < 4; ++m) {
        const int row = u.pm * BM + ai * HALF + wr * 64 + m * 16 + fr, b = row >> 12;
#pragma unroll
        for (int bj = 0; bj < 2; ++bj)
#pragma unroll
          for (int n = 0; n < 2; ++n) { const int c = u.pn * BM + bj * HALF + wc * 32 + n * 16 + 4 * fq;
            const f32x4 xv = *(const f32x4*)(xin + (size_t)row * DM + c), g = *(const f32x4*)(gv + b * 12288 + c);
            f32x4 o; for (int j = 0; j < 4; ++j) o[j] = ALPHA * xv[j] + g[j] * acc[ai][bj][m][n][j];
            *(f32x4*)(z + (size_t)row * DM + c) = o; }
      }
  }
};


DI void ln_exchange(const AccT& acc, LAS float* red, float* stats, unsigned* cnt, int pm, int pn, int tid, int wr, int wc, int fr, int fq) {
#pragma unroll
  for (int ai = 0; ai < 2; ++ai)
#pragma unroll
    for (int m = 0; m < 4; ++m) {
      float s1 = 0.f, s2 = 0.f;
#pragma unroll
      for (int bj = 0; bj < 2; ++bj)
#pragma unroll
        for (int n = 0; n < 2; ++n)
#pragma unroll
          for (int j = 0; j < 4; ++j) { const float x = acc[ai][bj][m][n][j]; s1 += x; s2 += x * x; }
      s1 += __shfl_xor(s1, 16); s2 += __shfl_xor(s2, 16); s1 += __shfl_xor(s1, 32); s2 += __shfl_xor(s2, 32);
      if (fq == 0) { const int rl = ai * 128 + wr * 64 + m * 16 + fr; red[(rl * 4 + wc) * 2] = s1; red[(rl * 4 + wc) * 2 + 1] = s2; }
    }
  __syncthreads();
  if (tid < 256) { float a = 0.f, b = 0.f;
#pragma unroll
    for (int w = 0; w < 4; ++w) { a += red[(tid * 4 + w) * 2]; b += red[(tid * 4 + w) * 2 + 1]; }
    float* sp = stats + ((size_t)(pm * 256 + tid) * 8 + pn) * 2;
    __hip_atomic_store(sp, a, __ATOMIC_RELAXED, __HIP_MEMORY_SCOPE_AGENT); __hip_atomic_store(sp + 1, b, __ATOMIC_RELAXED, __HIP_MEMORY_SCOPE_AGENT); }
  asm volatile("s_waitcnt vmcnt(0)" ::: "memory");
  __syncthreads();
  if (tid == 0) {
    __builtin_amdgcn_fence(__ATOMIC_RELEASE, "agent");
    asm volatile("s_waitcnt vmcnt(0)" ::: "memory");
    __hip_atomic_fetch_add(cnt + pm, 1u, __ATOMIC_RELAXED, __HIP_MEMORY_SCOPE_AGENT);
    unsigned sp_ = 0;
    while (__hip_atomic_load(cnt + pm, __ATOMIC_RELAXED, __HIP_MEMORY_SCOPE_AGENT) < 8u) { __builtin_amdgcn_s_sleep(1); if (++sp_ > (1u << 24)) break; }
    __builtin_amdgcn_fence(__ATOMIC_ACQUIRE, "agent");
    asm volatile("s_waitcnt vmcnt(0)" ::: "memory");
  }
  __syncthreads();
  if (tid < 256) { float a = 0.f, b = 0.f; const float* sp = stats + (size_t)(pm * 256 + tid) * 16;
#pragma unroll
    for (int w = 0; w < 8; ++w) { a += __hip_atomic_load(sp + 2 * w, __ATOMIC_RELAXED, __HIP_MEMORY_SCOPE_AGENT); b += __hip_atomic_load(sp + 2 * w + 1, __ATOMIC_RELAXED, __HIP_MEMORY_SCOPE_AGENT); }
    const float mean = a * (1.f / DM), var = fmaxf(b * (1.f / DM) - mean * mean, 0.f);
    red[2048 + tid * 2] = mean; red[2048 + tid * 2 + 1] = rsqrtf(var + 1e-5f); }
  __syncthreads();
}

struct EpiLnFused {
  static constexpr bool PERM = false, AFTER_DRAIN = true;
  const float* xin; const float* gv; const float* gam; const float* bet; float* xout;
  const float* modn; int sh_idx, sc_idx; bf16_t* uout;
  float* stats; unsigned* cnt;
  DI void operator()(const AccT&, const Unit&, int, int, int, int) const {}
  DI void fused(AccT& acc, const Unit& u, LAS unsigned char* lds, int tid, int wr, int wc, int fr, int fq) const {
    LAS float* red = (LAS float*)lds;
    const int row0 = u.pm * BM + wr * 64 + fr, col0 = u.pn * BM + wc * 32 + 4 * fq, b = (u.pm * BM) >> 12;
    { f32x4 g[2][2], xc[2][2], xn[2][2];
#pragma unroll
      for (int bj = 0; bj < 2; ++bj)
#pragma unroll
        for (int n = 0; n < 2; ++n) g[bj][n] = *(const f32x4*)(gv + b * 12288 + col0 + bj * HALF + n * 16);
      { const float* xr = xin + (size_t)row0 * DM + col0;
#pragma unroll
        for (int bj = 0; bj < 2; ++bj)
#pragma unroll
          for (int n = 0; n < 2; ++n) xc[bj][n] = *(const f32x4*)(xr + bj * HALF + n * 16); }
#pragma unroll
      for (int k = 0; k < 8; ++k) { const int ai = k >> 2, m = k & 3;
        if (k < 7) { const int k1 = k + 1; const float* xr = xin + (size_t)(row0 + (k1 >> 2) * HALF + (k1 & 3) * 16) * DM + col0; asm volatile("" : "+v"(xr));
#pragma unroll
          for (int bj = 0; bj < 2; ++bj)
#pragma unroll
            for (int n = 0; n < 2; ++n) xn[bj][n] = *(const f32x4*)(xr + bj * HALF + n * 16); }
#pragma unroll
        for (int bj = 0; bj < 2; ++bj)
#pragma unroll
          for (int n = 0; n < 2; ++n)
#pragma unroll
            for (int j = 0; j < 4; ++j) acc[ai][bj][m][n][j] = ALPHA * xc[bj][n][j] + g[bj][n][j] * acc[ai][bj][m][n][j];
        asm volatile("" :: "v"(acc[ai][0][m][0]), "v"(acc[ai][0][m][1]), "v"(acc[ai][1][m][0]), "v"(acc[ai][1][m][1]));
#pragma unroll
        for (int bj = 0; bj < 2; ++bj)
#pragma unroll
          for (int n = 0; n < 2; ++n) xc[bj][n] = xn[bj][n]; } }
    ln_exchange(acc, red, stats, cnt, u.pm, u.pn, tid, wr, wc, fr, fq);
    { f32x4 g[2][2], bb[2][2];
#pragma unroll
      for (int bj = 0; bj < 2; ++bj)
#pragma unroll
        for (int n = 0; n < 2; ++n) { g[bj][n] = *(const f32x4*)(gam + col0 + bj * HALF + n * 16); bb[bj][n] = *(const f32x4*)(bet + col0 + bj * HALF + n * 16); }
#pragma unroll
      for (int ai = 0; ai < 2; ++ai)
#pragma unroll
        for (int m = 0; m < 4; ++m) { const int rl = ai * 128 + wr * 64 + m * 16 + fr; const float mean = red[2048 + rl * 2], rstd = red[2048 + rl * 2 + 1];
          float* xo = xout + (size_t)(u.pm * BM + rl) * DM + col0;
#pragma unroll
          for (int bj = 0; bj < 2; ++bj)
#pragma unroll
            for (int n = 0; n < 2; ++n) { f32x4 o;
#pragma unroll
              for (int j = 0; j < 4; ++j) { o[j] = (acc[ai][bj][m][n][j] - mean) * rstd * g[bj][n][j] + bb[bj][n][j]; acc[ai][bj][m][n][j] = o[j]; }
              *(f32x4*)(xo + bj * HALF + n * 16) = o; } } }
    if (uout) {
      __syncthreads();
      ln_exchange(acc, red, stats + (size_t)32 * 256 * 16, cnt + 32, u.pm, u.pn, tid, wr, wc, fr, fq);
      f32x4 sc[2][2], sh[2][2];
#pragma unroll
      for (int bj = 0; bj < 2; ++bj)
#pragma unroll
        for (int n = 0; n < 2; ++n) { sc[bj][n] = *(const f32x4*)(modn + b * 12288 + sc_idx * 2048 + col0 + bj * HALF + n * 16); sh[bj][n] = *(const f32x4*)(modn + b * 12288 + sh_idx * 2048 + col0 + bj * HALF + n * 16); }
#pragma unroll
      for (int ai = 0; ai < 2; ++ai)
#pragma unroll
        for (int m = 0; m < 4; ++m) { const int rl = ai * 128 + wr * 64 + m * 16 + fr; const float mean = red[2048 + rl * 2], rstd = red[2048 + rl * 2 + 1];
          bf16_t* uo = uout + (size_t)(u.pm * BM + rl) * DM + col0;
#pragma unroll
          for (int bj = 0; bj < 2; ++bj)
#pragma unroll
            for (int n = 0; n < 2; ++n) { float o[4];
#pragma unroll
              for (int j = 0; j < 4; ++j) o[j] = (acc[ai][bj][m][n][j] - mean) * rstd * (1.f + sc[bj][n][j]) + sh[bj][n][j];
              *(u32x2*)(uo + bj * HALF + n * 16) = (u32x2){cvtpk(o[0], o[1]), cvtpk(o[2], o[3])}; } }
    }
    __syncthreads();
  }
};

struct EpiSwiglu {
  static constexpr bool PERM = false, AFTER_DRAIN = false;
  bf16_t* hid;
  DI void operator()(const AccT& acc, const Unit& u, int wr, int wc, int fr, int fq) const {
#pragma unroll
    for (int ai = 0; ai < 2; ++ai)
#pragma unroll
      for (int m = 0; m < 4; ++m) {
        const int row = u.pm * BM + ai * HALF + wr * 64 + m * 16 + fr;
#pragma unroll
        for (int bj = 0; bj < 2; ++bj) { const int hc = (u.pn * BM + bj * HALF + wc * 32) / 2 + 4 * fq;
          const f32x4 g = acc[ai][bj][m][0], up = acc[ai][bj][m][1];
          float o[4]; for (int j = 0; j < 4; ++j) o[j] = silu(g[j]) * up[j];
          *(u32x2*)(hid + (size_t)row * DFF + hc) = (u32x2){cvtpk(o[0], o[1]), cvtpk(o[2], o[3])}; }
      }
  }
};

DI int fetch_item(unsigned* ctr0, int* slot) {
  __syncthreads();
  unsigned long long ca = (unsigned long long)ctr0; asm volatile("" : "+s"(ca));
  unsigned* ctr = (unsigned*)ca;
  if (ltid() == 0) *slot = (int)atomicAdd(ctr, 1u);
  __syncthreads();
  return *slot;
}

DI void idxsel_phase(unsigned char* lds, const bf16_t* __restrict__ hbuf, const bf16_t* __restrict__ ikn, const float* __restrict__ iwf, u64* __restrict__ bits, unsigned* ctr) {
  const int tid = ltid(), wid = tid >> 6, lane = tid & 63, i32 = lane & 31, kh = lane >> 5;
  int* slot = (int*)(lds + SLOT_OFF);
  LAS float* sc_l = (LAS float*)(LAS unsigned char*)lds;
  const int qi = (i32 >> 2) & 1, hd = (i32 & 3) + 4 * (i32 >> 3);
  for (;;) {
    const int it = fetch_item(ctr, slot);
    if (it >= 1024) break;
    const int b = it & 1, jq = 511 - (it >> 1), t0 = b * SL + 8 * jq, ntile = (8 * jq + 8 + 31) >> 5;
    { bf16x8 a[4][4]; f32x4 w[4][4];
#pragma unroll
      for (int u = 0; u < 4; ++u) {
        const bf16_t* ap = hbuf + (size_t)(t0 + 2 * u + qi) * NPHYS + H_IQ + hd * 64 + kh * 8;
        const float* wp = iwf + (size_t)(t0 + 2 * u + kh) * 16;
#pragma unroll
        for (int ks = 0; ks < 4; ++ks) { a[u][ks] = *(const bf16x8*)(ap + ks * 16); w[u][ks] = *(const f32x4*)(wp + 4 * ks); }
      }
      if (wid < ntile) {
        const bf16_t* kp = ikn + (size_t)(b * SL + 32 * wid + i32) * 64 + kh * 8;
        bf16x8 nb[4];
#pragma unroll
        for (int ks = 0; ks < 4; ++ks) nb[ks] = *(const bf16x8*)(kp + ks * 16);
        for (int kt = wid; kt < ntile; kt += 8) {
          bf16x8 bfr[4];
#pragma unroll
          for (int ks = 0; ks < 4; ++ks) bfr[ks] = nb[ks];
          if (kt + 8 < ntile) { kp += 8 * 32 * 64;
#pragma unroll
            for (int ks = 0; ks < 4; ++ks) nb[ks] = *(const bf16x8*)(kp + ks * 16); }
#pragma unroll
          for (int u = 0; u < 4; ++u) {
            f32x16 acc = {};
#pragma unroll
            for (int ks = 0; ks < 4; ++ks) acc = __builtin_amdgcn_mfma_f32_32x32x16_bf16(a[u][ks], bfr[ks], acc, 0, 0, 0);
            float sc = 0.f;
#pragma unroll
            for (int r4 = 0; r4 < 4; ++r4)
#pragma unroll
              for (int jj = 0; jj < 4; ++jj) sc += fmaxf(acc[4 * r4 + jj], 0.f) * w[u][r4][jj];
            sc_l[(2 * u + kh) * 4096 + 32 * kt + i32] = sc;
          }
        }
      }
    }
    __syncthreads();
    { const int t = 8 * jq + wid, row = t0 + wid;
      const LAS float* sr = sc_l + wid * 4096;
      unsigned key[64];
#pragma unroll
      for (int i = 0; i < 64; ++i) { const int sidx = 64 * i + lane; unsigned k = 0;
        if (sidx <= t) { const unsigned uu = __float_as_uint(sr[sidx]); k = (uu & 0x80000000u) ? ~uu : (uu | 0x80000000u); }
        key[i] = k; }
      unsigned thr = 0;
      if (t + 1 > 256) {
        for (int bit = 31; bit >= 0; --bit) {
          const unsigned cand = thr | (1u << bit);
          int cnt = 0;
#pragma unroll
          for (int i = 0; i < 64; ++i) cnt += __popcll(__ballot(key[i] >= cand));
          if (cnt >= 256) thr = cand;
          if (cnt == 256) break;
        }
      }
      u64 mine = 0;
#pragma unroll
      for (int i = 0; i < 64; ++i) { const int sidx = 64 * i + lane; const u64 wv = __ballot(sidx <= t && key[i] >= thr); if (lane == i) mine = wv; }
      bits[(size_t)row * 64 + lane] = mine;
    }
  }
}

enum { M_CAUSAL = 0, M_WINDOW = 1, M_BITS = 2, M_SLC = 3, M_CMP = 4 };
DI u64 cmask(int n) { return n >= 64 ? ~0ull : (n <= 0 ? 0ull : ((1ull << n) - 1ull)); }

template <int MODE, int DV>
DI void attn_core(LAS unsigned char* lds, const bf16_t* __restrict__ Qp, int ldq, const bf16_t* __restrict__ Kp, int ldk, const bf16_t* __restrict__ Vtp, int ldv,
                  int tq0, int jt_lo, int jt_hi, const u64* __restrict__ mk, float* __restrict__ pdump, f32x16 (&o)[DV / 32], float& m_out, float& l_out) {
  constexpr int ND = DV / 32, VBYTES = DV * 136, KBAT = DV == 256 ? 1 : 4, VBAT = DV == 256 ? 1 : 2;
  const int tid = ltid(), wid = tid >> 6, lane = tid & 63, r32 = lane & 31, hi = lane >> 5;
  const int tq = tq0 + wid * 32 + r32;
  constexpr int NQR = DV == 256 ? 4 : 8;
  const bf16_t* qlane = Qp + (size_t)(wid * 32 + r32) * ldq + hi * 8;
  bf16x8 qr[NQR];
#pragma unroll
  for (int d0 = 0; d0 < NQR; ++d0) qr[d0] = *(const bf16x8*)(qlane + d0 * 16);
  LAS float* wsc = (LAS float*)(lds + 34816 + 2 * VBYTES) + wid * 64;
  const int krow = tid >> 3, kc16 = tid & 7, vrow = tid >> 2, vc = tid & 3;
  bf16x8 sk0, sk1, sv0, sv1;
#define AT_LOAD_K(jt) do { const bf16_t* kp_ = Kp + (size_t)((jt) * 64 + krow) * ldk + kc16 * 8; sk0 = *(const bf16x8*)kp_; sk1 = *(const bf16x8*)(kp_ + 64); } while (0)
#define AT_LOAD_V(jt, half) do { const bf16_t* vp_ = Vtp + (size_t)(vrow + 128 * (half)) * ldv + (jt) * 64 + vc * 8; sv0 = *(const bf16x8*)vp_; sv1 = *(const bf16x8*)(vp_ + 32); } while (0)
#define AT_WRITE_K(buf) do { LAS unsigned char* kb_ = lds + (buf) * 17408 + krow * 272 + kc16 * 16; *(LAS bf16x8*)kb_ = sk0; *(LAS bf16x8*)(kb_ + 128) = sk1; } while (0)
#define AT_WRITE_V(buf, half) do { LAS unsigned char* vb_ = lds + 34816 + (buf) * VBYTES + (vrow + 128 * (half)) * 136 + vc * 16; \
    *(LAS s16x4*)vb_ = __builtin_shufflevector(sv0, sv0, 0, 1, 2, 3); *(LAS s16x4*)(vb_ + 8) = __builtin_shufflevector(sv0, sv0, 4, 5, 6, 7); \
    *(LAS s16x4*)(vb_ + 64) = __builtin_shufflevector(sv1, sv1, 0, 1, 2, 3); *(LAS s16x4*)(vb_ + 72) = __builtin_shufflevector(sv1, sv1, 4, 5, 6, 7); } while (0)
  float m_reg = -1e30f, l_reg = 0.f;
#pragma unroll
  for (int d = 0; d < ND; ++d) o[d] = (f32x16){};
  u64 selw = 0;
  if (MODE == M_SLC) selw = mk[wid * 32 + r32];
  const int tcmp = tq >= 31 ? ((tq - 31) >> 4) : -1;
  const bool trail_ = __builtin_amdgcn_readfirstlane(wid) >= 4;
  if (trail_) __builtin_amdgcn_s_setprio(1);
  AT_LOAD_K(jt_lo); AT_LOAD_V(jt_lo, 0); AT_WRITE_K(0); AT_WRITE_V(0, 0);
  if (DV == 256) { AT_LOAD_V(jt_lo, 1); AT_WRITE_V(0, 1); }
  __syncthreads();
  int cur = 0;
  for (int jt = jt_lo; jt < jt_hi; ++jt) {
    const bool pre = jt + 1 < jt_hi;
    bf16x8 qx[4];
    if (DV == 256) { const bf16_t* q2 = qlane; asm volatile("" : "+v"(q2));
#pragma unroll
      for (int u = 0; u < 4; ++u) qx[u] = *(const bf16x8*)(q2 + (4 + u) * 16); }
    if (pre) { AT_LOAD_K(jt + 1); AT_LOAD_V(jt + 1, 0); }
    const int kb = jt * 64;
    u64 allow;
    if (MODE == M_CAUSAL) allow = cmask(tq - kb + 1);
    else if (MODE == M_WINDOW) allow = cmask(tq - kb + 1) & ~cmask(tq - 512 - kb + 1);
    else if (MODE == M_BITS) allow = mk[(size_t)(wid * 32 + r32) * 64 + jt] & cmask(tq - kb + 1);
    else if (MODE == M_SLC) allow = ((selw >> jt) & 1ull) ? cmask(tq - kb + 1) : 0ull;
    else allow = cmask(tcmp - kb + 1);
    const bool act = MODE == M_CMP || __any(allow != 0ull);
    bf16x8 pa[4];
    if (act) {
      const LAS unsigned char* Kb = lds + cur * 17408 + r32 * 272 + hi * 16;
      f32x16 p0 = {}, p1 = {};
#pragma unroll
      for (int db = 0; db < 8; db += KBAT) { bf16x8 ka[KBAT], kc[KBAT];
#pragma unroll
        for (int u = 0; u < KBAT; ++u) { ka[u] = *(const LAS bf16x8*)(Kb + (db + u) * 32); kc[u] = *(const LAS bf16x8*)(Kb + 32 * 272 + (db + u) * 32); }
        __builtin_amdgcn_sched_barrier(0);
#pragma unroll
        for (int u = 0; u < KBAT; ++u) { const int d0 = db + u; const bf16x8 qf = d0 < NQR ? qr[d0 < NQR ? d0 : 0] : qx[d0 >= NQR ? d0 - NQR : 0];
          p0 = __builtin_amdgcn_mfma_f32_32x32x16_bf16(ka[u], qf, p0, 0, 0, 0);
          p1 = __builtin_amdgcn_mfma_f32_32x32x16_bf16(kc[u], qf, p1, 0, 0, 0); }
        __builtin_amdgcn_sched_barrier(0); }
      if (pre) AT_WRITE_K(cur ^ 1);
      if (!__all(allow == ~0ull)) {
        const u64 a = ~(allow >> (4 * hi)); const int nlo = (int)(unsigned)a, nhw = (int)(unsigned)(a >> 32);
#pragma unroll
        for (int r = 0; r < 16; ++r) { const int cp = (r & 3) + 8 * (r >> 2);
          const unsigned b0 = ((unsigned)((nlo << (31 - cp)) >> 31) & 0x80000000u) | 0x7f800000u, b1 = ((unsigned)((nhw << (31 - cp)) >> 31) & 0x80000000u) | 0x7f800000u;
          p0[r] = vmin_raw(p0[r], __uint_as_float(b0)); p1[r] = vmin_raw(p1[r], __uint_as_float(b1)); }
      }
      if (MODE == M_CMP) {
        float* pr = pdump + (size_t)(wid * 32 + r32) * 256 + kb + 4 * hi;
#pragma unroll
        for (int g4 = 0; g4 < 4; ++g4) { *(f32x4*)(pr + 8 * g4) = (f32x4){p0[4 * g4], p0[4 * g4 + 1], p0[4 * g4 + 2], p0[4 * g4 + 3]};
          *(f32x4*)(pr + 32 + 8 * g4) = (f32x4){p1[4 * g4], p1[4 * g4 + 1], p1[4 * g4 + 2], p1[4 * g4 + 3]}; }
      }
      float mx = p0[0];
#pragma unroll
      for (int r = 1; r < 16; ++r) mx = fmaxf(mx, p0[r]);
#pragma unroll
      for (int r = 0; r < 16; ++r) mx = fmaxf(mx, p1[r]);
      mx = fmaxf(mx, __shfl_xor(mx, 32));
      float mn = m_reg, alpha = 1.f;
      if (!__all((mx - m_reg) * C2 <= 8.f)) { mn = fmaxf(m_reg, mx); alpha = __builtin_amdgcn_exp2f((m_reg - mn) * C2); m_reg = mn; }
      const float nm = -mn * C2;
      float ps = 0.f;
#pragma unroll
      for (int r = 0; r < 16; ++r) { p0[r] = __builtin_amdgcn_exp2f(fmaf(p0[r], C2, nm)); p1[r] = __builtin_amdgcn_exp2f(fmaf(p1[r], C2, nm)); ps += p0[r] + p1[r]; }
      ps += __shfl_xor(ps, 32);
      l_reg = l_reg * alpha + ps;
      if (__any(alpha < 1.f)) {
        if (hi == 0) wsc[r32] = alpha;
        asm volatile("s_waitcnt lgkmcnt(0)" ::: "memory");
#pragma unroll
        for (int r = 0; r < 16; ++r) { const float al = wsc[crow(r, hi)];
#pragma unroll
          for (int d = 0; d < ND; ++d) o[d][r] *= al; }
        asm volatile("s_waitcnt lgkmcnt(0)" ::: "memory");
      }
      { u32x4 w;
        w = (u32x4){cvtpk(p0[0], p0[1]), cvtpk(p0[2], p0[3]), cvtpk(p0[4], p0[5]), cvtpk(p0[6], p0[7])}; pa[0] = *reinterpret_cast<bf16x8*>(&w);
        w = (u32x4){cvtpk(p0[8], p0[9]), cvtpk(p0[10], p0[11]), cvtpk(p0[12], p0[13]), cvtpk(p0[14], p0[15])}; pa[1] = *reinterpret_cast<bf16x8*>(&w);
        w = (u32x4){cvtpk(p1[0], p1[1]), cvtpk(p1[2], p1[3]), cvtpk(p1[4], p1[5]), cvtpk(p1[6], p1[7])}; pa[2] = *reinterpret_cast<bf16x8*>(&w);
        w = (u32x4){cvtpk(p1[8], p1[9]), cvtpk(p1[10], p1[11]), cvtpk(p1[12], p1[13]), cvtpk(p1[14], p1[15])}; pa[3] = *reinterpret_cast<bf16x8*>(&w); }
    }
    if (pre && !act) AT_WRITE_K(cur ^ 1);
    if (DV == 256 && pre) { AT_WRITE_V(cur ^ 1, 0); AT_LOAD_V(jt + 1, 1); }
    if (act) {
      const LAS unsigned char* Vb = lds + 34816 + cur * VBYTES + r32 * 136 + hi * 8;
#pragma unroll
      for (int dbb = 0; dbb < ND; dbb += VBAT) { bf16x8 vf[VBAT * 4];
#pragma unroll
        for (int u = 0; u < VBAT; ++u)
#pragma unroll
          for (int s = 0; s < 4; ++s) { const int d = dbb + u; const s16x4 lo4 = *(const LAS s16x4*)(Vb + d * 32 * 136 + s * 32), hi4 = *(const LAS s16x4*)(Vb + d * 32 * 136 + s * 32 + 16);
            vf[u * 4 + s] = __builtin_shufflevector(lo4, hi4, 0, 1, 2, 3, 4, 5, 6, 7); }
        __builtin_amdgcn_sched_barrier(0);
#pragma unroll
        for (int u = 0; u < VBAT; ++u)
#pragma unroll
          for (int s = 0; s < 4; ++s) o[dbb + u] = __builtin_amdgcn_mfma_f32_32x32x16_bf16(pa[s], vf[u * 4 + s], o[dbb + u], 0, 0, 0);
        __builtin_amdgcn_sched_barrier(0); }
    }
    if (pre) { AT_WRITE_V(cur ^ 1, DV == 256 ? 1 : 0); }
    __syncthreads();
    cur ^= 1;
  }
  if (trail_) __builtin_amdgcn_s_setprio(0);
  if (hi == 0) wsc[r32] = l_reg;
  asm volatile("s_waitcnt lgkmcnt(0)" ::: "memory");
#pragma unroll
  for (int r = 0; r < 16; ++r) { const float lr = wsc[crow(r, hi)]; const float inv = lr > 0.f ? 1.f / lr : 0.f;
#pragma unroll
    for (int d = 0; d < ND; ++d) o[d][r] *= inv; }
  asm volatile("s_waitcnt lgkmcnt(0)" ::: "memory");
  m_out = m_reg; l_out = l_reg;
#undef AT_LOAD_K
#undef AT_LOAD_V
#undef AT_WRITE_K
#undef AT_WRITE_V
}


template <int MODE>
DI void attn_core_skew(LAS unsigned char* lds, const bf16_t* __restrict__ Qp, int ldq, const bf16_t* __restrict__ Kp, int ldk, const bf16_t* __restrict__ Vtp, int ldv,
                       int tq0, int jt_lo, int jt_hi, const u64* __restrict__ mk, float* __restrict__ pdump, f32x16 (&o)[4], float& m_out, float& l_out) {
  const int tid = ltid(), wid = tid >> 6, lane = tid & 63, r32 = lane & 31, hi = lane >> 5;
  const bool lead = __builtin_amdgcn_readfirstlane(wid) < 4;
  if (!lead) __builtin_amdgcn_s_setprio(1);
  const int tq = tq0 + wid * 32 + r32;
  const bf16_t* qlane = Qp + (size_t)(wid * 32 + r32) * ldq + hi * 8;
  bf16x8 qr[8];
#pragma unroll
  for (int d0 = 0; d0 < 8; ++d0) qr[d0] = *(const bf16x8*)(qlane + d0 * 16);
  LAS float* wsc = (LAS float*)(lds + 34816 + 2 * 17408) + wid * 64;
  const int st = tid & 255, krow = st >> 4, kch = st & 15, vrow = st >> 3, vch = st & 7;
  bf16x8 sgc[4], sgn[4];
#define SK_BAR() do { asm volatile("s_waitcnt lgkmcnt(0)" ::: "memory"); __builtin_amdgcn_s_barrier(); asm volatile("" ::: "memory"); } while (0)
#define SK_LOAD(sg, jt) do { if (lead) { const bf16_t* kp_ = Kp + (size_t)((jt) * 64 + krow) * ldk + kch * 8; \
      _Pragma("unroll") for (int i_ = 0; i_ < 4; ++i_) sg[i_] = *(const bf16x8*)(kp_ + (size_t)(16 * i_) * ldk); } \
    else { const bf16_t* vp_ = Vtp + (size_t)vrow * ldv + (jt) * 64 + vch * 8; \
      _Pragma("unroll") for (int i_ = 0; i_ < 4; ++i_) sg[i_] = *(const bf16x8*)(vp_ + (size_t)(32 * i_) * ldv); } } while (0)
#define SK_WRITE(sg, buf) do { if (lead) { LAS unsigned char* kb_ = lds + (buf) * 17408 + krow * 272 + kch * 16; \
      _Pragma("unroll") for (int i_ = 0; i_ < 4; ++i_) *(LAS bf16x8*)(kb_ + i_ * 16 * 272) = sg[i_]; } \
    else { LAS unsigned char* vb_ = lds + 34816 + (buf) * 17408 + vrow * 136 + vch * 16; \
      _Pragma("unroll") for (int i_ = 0; i_ < 4; ++i_) { *(LAS s16x4*)(vb_ + i_ * 32 * 136) = __builtin_shufflevector(sg[i_], sg[i_], 0, 1, 2, 3); \
        *(LAS s16x4*)(vb_ + i_ * 32 * 136 + 8) = __builtin_shufflevector(sg[i_], sg[i_], 4, 5, 6, 7); } } } while (0)
  float m_reg = -1e30f, l_reg = 0.f;
#pragma unroll
  for (int d = 0; d < 4; ++d) o[d] = (f32x16){};
  u64 selw = 0;
  if (MODE == M_SLC) selw = mk[wid * 32 + r32];
  const int tcmp = tq >= 31 ? ((tq - 31) >> 4) : -1;
  const u64* mrow = mk + (size_t)(wid * 32 + r32) * 64;
  u64 bw = 0; if (MODE == M_BITS) bw = mrow[jt_lo];
  SK_LOAD(sgc, jt_lo); SK_WRITE(sgc, 0);
  if (jt_lo + 1 < jt_hi) SK_LOAD(sgc, jt_lo + 1);
  SK_BAR();
  if (!lead) SK_BAR();
  int cur = 0;
  for (int jt = jt_lo; jt < jt_hi; ++jt) {
    const bool pre = jt + 1 < jt_hi;
    if (jt + 2 < jt_hi) SK_LOAD(sgn, jt + 2);
    u64 bwn = 0; if (MODE == M_BITS && pre) bwn = mrow[jt + 1];
    const int kb = jt * 64;
    u64 allow;
    if (MODE == M_CAUSAL) allow = cmask(tq - kb + 1);
    else if (MODE == M_WINDOW) allow = cmask(tq - kb + 1) & ~cmask(tq - 512 - kb + 1);
    else if (MODE == M_BITS) allow = bw & cmask(tq - kb + 1);
    else if (MODE == M_SLC) allow = ((selw >> jt) & 1ull) ? cmask(tq - kb + 1) : 0ull;
    else allow = cmask(tcmp - kb + 1);
    const bool act = MODE == M_CMP || __any(allow != 0ull);
    f32x16 p0, p1;
    float alpha;
    if (act) {
      alpha = 1.f;
      const LAS unsigned char* Kb = lds + cur * 17408 + r32 * 272 + hi * 16;
#pragma unroll
      for (int db = 0; db < 8; db += 4) { bf16x8 ka[4], kc[4];
#pragma unroll
        for (int u = 0; u < 4; ++u) { ka[u] = *(const LAS bf16x8*)(Kb + (db + u) * 32); kc[u] = *(const LAS bf16x8*)(Kb + 32 * 272 + (db + u) * 32); }
        __builtin_amdgcn_sched_barrier(0);
#pragma unroll
        for (int u = 0; u < 4; ++u) { const f32x16 z = {};
          p0 = __builtin_amdgcn_mfma_f32_32x32x16_bf16(ka[u], qr[db + u], (db + u == 0) ? z : p0, 0, 0, 0);
          p1 = __builtin_amdgcn_mfma_f32_32x32x16_bf16(kc[u], qr[db + u], (db + u == 0) ? z : p1, 0, 0, 0); }
        __builtin_amdgcn_sched_barrier(0); }
      if (!__all(allow == ~0ull)) {
        const u64 a = ~(allow >> (4 * hi)); const int nlo = (int)(unsigned)a, nhw = (int)(unsigned)(a >> 32);
#pragma unroll
        for (int r = 0; r < 16; ++r) { const int cp = (r & 3) + 8 * (r >> 2);
          const unsigned b0 = ((unsigned)((nlo << (31 - cp)) >> 31) & 0x80000000u) | 0x7f800000u, b1 = ((unsigned)((nhw << (31 - cp)) >> 31) & 0x80000000u) | 0x7f800000u;
          p0[r] = vmin_raw(p0[r], __uint_as_float(b0)); p1[r] = vmin_raw(p1[r], __uint_as_float(b1)); }
      }
      if (MODE == M_CMP && __any(allow != 0ull)) {
        LAS float* pw = (LAS float*)(lds + PD_OFF + wid * 8704);
#pragma unroll
        for (int g4 = 0; g4 < 4; ++g4) { *(LAS f32x4*)(pw + r32 * 68 + 8 * g4 + 4 * hi) = (f32x4){p0[4 * g4], p0[4 * g4 + 1], p0[4 * g4 + 2], p0[4 * g4 + 3]};
          *(LAS f32x4*)(pw + r32 * 68 + 32 + 8 * g4 + 4 * hi) = (f32x4){p1[4 * g4], p1[4 * g4 + 1], p1[4 * g4 + 2], p1[4 * g4 + 3]}; }
        asm volatile("s_waitcnt lgkmcnt(0)" ::: "memory");
#pragma unroll
        for (int i = 0; i < 8; ++i) { const int c = i * 64 + lane, row = c >> 4, c16 = c & 15;
          *(f32x4*)(pdump + (size_t)(wid * 32 + row) * 256 + kb + c16 * 4) = *(const LAS f32x4*)(pw + row * 68 + c16 * 4);
        }
      }
      float mx = p0[0];
#pragma unroll
      for (int r = 1; r < 16; ++r) mx = fmaxf(mx, p0[r]);
#pragma unroll
      for (int r = 0; r < 16; ++r) mx = fmaxf(mx, p1[r]);
      mx = fmaxf(mx, __shfl_xor(mx, 32));
      float mn = m_reg;
      if (!__all((mx - m_reg) * C2 <= 8.f)) { mn = fmaxf(m_reg, mx); alpha = __builtin_amdgcn_exp2f((m_reg - mn) * C2); m_reg = mn; }
      const float nm = -mn * C2;
#pragma unroll
      for (int r = 0; r < 16; ++r) { p0[r] = __builtin_amdgcn_exp2f(fmaf(p0[r], C2, nm)); p1[r] = __builtin_amdgcn_exp2f(fmaf(p1[r], C2, nm)); }
    }
    SK_BAR();
    if (act) {
      float ps = 0.f;
#pragma unroll
      for (int r = 0; r < 16; ++r) ps += p0[r] + p1[r];
      ps += __shfl_xor(ps, 32);
      l_reg = l_reg * alpha + ps;
      if (__any(alpha < 1.f)) {
        if (hi == 0) wsc[r32] = alpha;
        asm volatile("s_waitcnt lgkmcnt(0)" ::: "memory");
#pragma unroll
        for (int r = 0; r < 16; ++r) { const float al = wsc[crow(r, hi)];
#pragma unroll
          for (int d = 0; d < 4; ++d) o[d][r] *= al; }
        asm volatile("s_waitcnt lgkmcnt(0)" ::: "memory");
      }
      bf16x8 pa[4];
      { u32x4 w;
        w = (u32x4){cvtpk(p0[0], p0[1]), cvtpk(p0[2], p0[3]), cvtpk(p0[4], p0[5]), cvtpk(p0[6], p0[7])}; pa[0] = *reinterpret_cast<bf16x8*>(&w);
        w = (u32x4){cvtpk(p0[8], p0[9]), cvtpk(p0[10], p0[11]), cvtpk(p0[12], p0[13]), cvtpk(p0[14], p0[15])}; pa[1] = *reinterpret_cast<bf16x8*>(&w);
        w = (u32x4){cvtpk(p1[0], p1[1]), cvtpk(p1[2], p1[3]), cvtpk(p1[4], p1[5]), cvtpk(p1[6], p1[7])}; pa[2] = *reinterpret_cast<bf16x8*>(&w);
        w = (u32x4){cvtpk(p1[8], p1[9]), cvtpk(p1[10], p1[11]), cvtpk(p1[12], p1[13]), cvtpk(p1[14], p1[15])}; pa[3] = *reinterpret_cast<bf16x8*>(&w); }
      const LAS unsigned char* Vb = lds + 34816 + cur * 17408 + r32 * 136 + hi * 8;
#pragma unroll
      for (int dbb = 0; dbb < 4; dbb += 2) { bf16x8 vf[8];
#pragma unroll
        for (int u = 0; u < 2; ++u)
#pragma unroll
          for (int s4 = 0; s4 < 4; ++s4) { const int d = dbb + u; const s16x4 lo4 = *(const LAS s16x4*)(Vb + d * 32 * 136 + s4 * 32), hi4 = *(const LAS s16x4*)(Vb + d * 32 * 136 + s4 * 32 + 16);
            vf[u * 4 + s4] = __builtin_shufflevector(lo4, hi4, 0, 1, 2, 3, 4, 5, 6, 7); }
        __builtin_amdgcn_sched_barrier(0);
#pragma unroll
        for (int u = 0; u < 2; ++u)
#pragma unroll
          for (int s4 = 0; s4 < 4; ++s4) o[dbb + u] = __builtin_amdgcn_mfma_f32_32x32x16_bf16(pa[s4], vf[u * 4 + s4], o[dbb + u], 0, 0, 0);
        __builtin_amdgcn_sched_barrier(0); }
    }
    if (pre) SK_WRITE(sgc, cur ^ 1);
    SK_BAR();
    cur ^= 1; bw = bwn;
#pragma unroll
    for (int i_ = 0; i_ < 4; ++i_) sgc[i_] = sgn[i_];
  }
  if (lead) SK_BAR();
  if (!lead) __builtin_amdgcn_s_setprio(0);
  if (hi == 0) wsc[r32] = l_reg;
  asm volatile("s_waitcnt lgkmcnt(0)" ::: "memory");
#pragma unroll
  for (int r = 0; r < 16; ++r) { const float lr = wsc[crow(r, hi)]; const float inv = lr > 0.f ? 1.f / lr : 0.f;
#pragma unroll
    for (int d = 0; d < 4; ++d) o[d][r] *= inv; }
  asm volatile("s_waitcnt lgkmcnt(0)" ::: "memory");
  m_out = m_reg; l_out = l_reg;
#undef SK_BAR
#undef SK_LOAD
#undef SK_WRITE
}

DI void store_o_bf16(LAS unsigned char* lds, bf16_t* dst, int rowg0, int hcol, const f32x16 (&o)[4]) {
  const int tid_ = ltid(), lane = tid_ & 63, wid = tid_ >> 6, r32 = lane & 31, hi = lane >> 5;
  LAS unsigned char* pw = lds + wid * 8704;
#pragma unroll
  for (int r = 0; r < 16; ++r)
#pragma unroll
    for (int d = 0; d < 4; ++d) *(LAS bf16_t*)(pw + crow(r, hi) * 272 + (d * 32 + r32) * 2) = f2bf(o[d][r]);
  asm volatile("s_waitcnt lgkmcnt(0)" ::: "memory");
#pragma unroll
  for (int i = 0; i < 8; ++i) { const int c = i * 64 + lane, row = c >> 4, c16 = c & 15;
    *(u32x4*)(dst + (size_t)(rowg0 + wid * 32 + row) * 1024 + hcol + c16 * 8) = *(const LAS u32x4*)(pw + row * 272 + c16 * 16); }
  asm volatile("s_waitcnt lgkmcnt(0)" ::: "memory");
}

#define XB_TMO      128
#define XB_XCNT(j)  (256  + 64 * (j))
#define XB_XSUB(j)  (1280 + 64 * (j))
#define XB_XGEN(j)  (2304 + 64 * (j))
#define XB_TOP      3328
#define XB_TOPGEN   3392
#define XCD_BAR_WORDS 3456
#define XB_SPIN_CAP (1u << 22)
DI unsigned xb_ld(unsigned* p)              { return __hip_atomic_load(p, __ATOMIC_RELAXED, __HIP_MEMORY_SCOPE_AGENT); }
DI unsigned xb_add(unsigned* p, unsigned v) { return __hip_atomic_fetch_add(p, v, __ATOMIC_RELAXED, __HIP_MEMORY_SCOPE_AGENT); }
DI unsigned xb_xcc_id() { return (unsigned)__builtin_amdgcn_s_getreg((3 << 11) | 20) & 0xFu; }
#define XB_SPIN(cond, bar) do { unsigned _sp = 0; while (cond) { __builtin_amdgcn_s_sleep(1); \
    if ((++_sp & 255u) == 0u) { if (xb_ld(&(bar)[XB_TMO])) break; if (_sp > XB_SPIN_CAP) { atomicAdd(&(bar)[XB_TMO], 1u); break; } } } } while (0)
struct XcdBarrier { unsigned* bar; unsigned x; volatile LAS unsigned* st; };
DI XcdBarrier xcd_barrier_post(unsigned* bar, volatile LAS unsigned* st) {
  XcdBarrier b; b.bar = bar; b.x = xb_xcc_id(); b.st = st;
  if (threadIdx.x == 0) (void)xb_add(&bar[XB_XCNT(b.x)], 1u);
  return b;
}
DI void xcd_barrier_complete(unsigned* bar, unsigned x, unsigned& nloc, unsigned& nx) {
  const unsigned G = gridDim.x * gridDim.y * gridDim.z;
  unsigned sum, cnt, mine, sp = 0u;
  for (;;) {
    sum = 0u; cnt = 0u; mine = 0u;
#pragma unroll
    for (unsigned j = 0; j < 16; ++j) { const unsigned c = xb_ld(&bar[XB_XCNT(j)]); sum += c; cnt += (c > 0u) ? 1u : 0u; mine = (j == x) ? c : mine; }
    if (sum == G) break;
    __builtin_amdgcn_s_sleep(1);
    if ((++sp & 255u) == 0u) { if (xb_ld(&bar[XB_TMO])) break; if (sp > XB_SPIN_CAP) { atomicAdd(&bar[XB_TMO], 1u); break; } }
  }
  nloc = mine > 0u ? mine : 1u; nx = cnt > 0u ? cnt : 1u;
}
DI void xcd_barrier(const XcdBarrier& b) {
  asm volatile("s_waitcnt vmcnt(0)" ::: "memory");
  __syncthreads();
  if (threadIdx.x == 0) {
    unsigned long long ba_ = (unsigned long long)b.bar; unsigned bx = b.x; asm volatile("" : "+v"(bx));
    unsigned* bar = (unsigned*)ba_;
    __builtin_amdgcn_s_waitcnt(0);
    unsigned nloc = b.st[0], nx = b.st[1];
    if (nloc == 0u) { xcd_barrier_complete(bar, bx, nloc, nx); b.st[0] = nloc; b.st[1] = nx; }
    const unsigned old = xb_add(&bar[XB_XSUB(bx)], 1u);
    const unsigned gen = old / nloc;
    if (old + 1u == (gen + 1u) * nloc) {
      __builtin_amdgcn_fence(__ATOMIC_RELEASE, "agent");
      asm volatile("s_waitcnt vmcnt(0)" ::: "memory");
      const unsigned og = xb_add(&bar[XB_TOP], 1u);
      const unsigned tg = og / nx;
      if (og + 1u == (tg + 1u) * nx) xb_add(&bar[XB_TOPGEN], 1u);
      else XB_SPIN(xb_ld(&bar[XB_TOPGEN]) == tg, bar);
      __builtin_amdgcn_fence(__ATOMIC_ACQUIRE, "agent");
      xb_add(&bar[XB_XGEN(bx)], 1u);
      asm volatile("s_waitcnt vmcnt(0)" ::: "memory");
    } else {
      XB_SPIN(xb_ld(&bar[XB_XGEN(bx)]) == gen, bar);
      __builtin_amdgcn_fence(__ATOMIC_ACQUIRE, "agent");
      asm volatile("s_waitcnt vmcnt(0)" ::: "memory");
    }
  }
  __syncthreads();
}

__global__ void __launch_bounds__(NTHR) fwd_megakernel(Params p) {
  extern __shared__ __attribute__((aligned(16))) unsigned char shm[];
  cg::grid_group grid = cg::this_grid();
  LAS unsigned char* ldsl = (LAS unsigned char*)shm;
  unsigned char* lds = shm;
  unsigned char* ws = p.ws;

  bf16_t* hbuf = (bf16_t*)(ws + O_H);
  float* modp = (float*)(ws + O_MODP);
  float* mod = (float*)(ws + O_MOD);
  float* ropeA = (float*)(ws + O_ROPA);
  float* ropeI = (float*)(ws + O_ROPI);
  float* scal = (float*)(ws + O_SCAL);
  unsigned* ctr = (unsigned*)(ws + O_CTR);
  bf16_t* ubuf = (bf16_t*)(ws + O_UBUF);
  float* xbuf = (float*)(ws + O_XBUF);
  int* slot = (int*)(lds + SLOT_OFF);

  { PHASE_VARS
  if (bid == 0) {
    if (tid < 16) ctr[tid] = 0u;
    if (tid < 128) ((unsigned*)(ws + O_SC))[tid] = 0u;
    if (tid < 256) ((unsigned*)(ws + O_LNC))[tid] = 0u;
    for (int i = tid; i < XCD_BAR_WORDS; i += NTHR) ((unsigned*)(ws + O_BAR))[i] = 0u;
    if (tid < 2) { const float* lm = p.lam + tid * 4 * 128; float s0 = 0, s1 = 0; for (int i = 0; i < 128; ++i) { s0 += lm[i] * lm[128 + i]; s1 += lm[256 + i] * lm[384 + i]; }
      const float lam_init = 0.8f - 0.6f * expf(-0.3f * (float)tid);
      scal[tid * 2] = expf(s0) - expf(s1) + lam_init; scal[tid * 2 + 1] = 1.f - lam_init; }
  }
  for (int i = gtid; i < 4096 * 24; i += gthreads) {
    const int pos = i / 24, f = i % 24;
    float inv; if (f < 16) inv = powf(500000.f, -((float)f * 2.f) / 32.f); else inv = powf(500000.f, -((float)(f - 16) * 2.f) / 16.f);
    const float ang = (float)pos * inv;
    const double kk = rint((double)ang * 0.15915494309189535); const float red = (float)((double)ang - kk * 6.283185307179586);
    const float cs = cosf(red), sn = sinf(red);
    if (f < 16) { ropeA[pos * 32 + f] = cs; ropeA[pos * 32 + 16 + f] = sn; } else { ropeI[pos * 16 + (f - 16)] = cs; ropeI[pos * 16 + 8 + (f - 16)] = sn; }
  }
  float* csl = (float*)lds;
  for (int i = tid; i < 4096; i += NTHR) csl[i] = silu(p.c[i]);
  __syncthreads();
  for (int i = gtid; i < 8 * 2 * 12288; i += gthreads) {
    const int col = i % 12288, l = (i / 12288) & 1, kc = i / (2 * 12288);
    const float* w = p.w_ada + (size_t)l * 2048 * 12288 + (size_t)(kc * 256) * 12288 + col;
    float a0 = 0, a1 = 0;
#pragma unroll 8
    for (int k = 0; k < 256; ++k) { const float wv = w[(size_t)k * 12288]; a0 += csl[kc * 256 + k] * wv; a1 += csl[2048 + kc * 256 + k] * wv; }
    modp[((size_t)(kc * 2 + l) * 2 + 0) * 12288 + col] = a0; modp[((size_t)(kc * 2 + l) * 2 + 1) * 12288 + col] = a1;
  }
  __syncthreads();
  }
  convert_layer(p, 0, (float*)lds);
  grid.sync();
  volatile LAS unsigned* xst = (volatile LAS unsigned*)(ldsl + XST_OFF);
  if (threadIdx.x == 0) { xst[0] = 0u; xst[1] = 0u; }
  __syncthreads();
  XcdBarrier xb = xcd_barrier_post((unsigned*)(ws + O_BAR), xst);

  { PHASE_VARS
  for (int i = gtid; i < 2 * 2 * 12288; i += gthreads) {
    const int col = i % 12288, lb = i / 12288, l = lb >> 1;
    float a = p.b_ada[l * 12288 + col];
    for (int kc = 0; kc < 8; ++kc) a += modp[((size_t)kc * 4 + lb) * 12288 + col];
    mod[i] = a;
  } }
  xcd_barrier(xb);
  ln_phase(p.x, nullptr, nullptr, nullptr, mod, 0, 1, ubuf);
  xcd_barrier(xb);

  for (int l = 0; l < 2; ++l) {
    const float* xin = l == 0 ? p.x : xbuf;
    float* xnext = l == 0 ? xbuf : p.out;
    const float* modl = mod + l * 2 * 12288;
    { PHASE_VARS Gemm g{ubuf, (const bf16_t*)(ws + O_WIN), T, NPHYS, 2048, 2048, 2048}; Sched S; S.init(T, NPHYS, nblk, bid);
      EpiIn E{hbuf, (bf16_t*)(ws + O_BVT), (bf16_t*)(ws + O_CVT), ropeA, ropeI};
      gemm_phase(ldsl, g, S, E); }
    { PHASE_VARS const int kc = bid >> 5;
      Gemm g{ubuf + kc * 256, (const bf16_t*)(ws + O_WMISC) + kc * 256, T, 256, 256, 2048, 2048}; Sched S; S.init(T, 256, 32, bid & 31);
      EpiHalfF32 E{(float*)(ws + O_MISCP) + (size_t)kc * T * 128};
      gemm_phase(ldsl, g, S, E); }
    xcd_barrier(xb);
    { PHASE_VARS const float* miscp = (const float*)(ws + O_MISCP); bf16_t* ikn = (bf16_t*)(ws + O_IKN); float* iwf = (float*)(ws + O_IWF); float* bgt = (float*)(ws + O_BG); float* srow = (float*)(ws + O_SROW);
      for (int row = gw; row < T; row += nw) {
        const int pos = row & (SL - 1);
        { const bf16x8 a = *(const bf16x8*)(hbuf + (size_t)row * NPHYS + H_ALAT + lane * 8); float s = 0;
          for (int j = 0; j < 8; ++j) { const float v = bf2f((bf16_t)a[j]); s += v * v; }
          s = wsum(s); if (lane == 0) srow[row] = rsqrtf(s * (1.f / 512.f) + 1e-6f); }
        { float v = 0.f; for (int k = 0; k < 8; ++k) v += miscp[((size_t)k * T + row) * 128 + lane]; const float mu = wsum(v) * (1.f / 64.f); const float d = v - mu; const float var = wsum(d * d) * (1.f / 64.f);
          const float y = d * rsqrtf(var + 1e-5f);
          const float y8 = __shfl_xor(y, 8);
          float o = y;
          if (lane < 16) { const int f = lane & 7; const float cs = ropeI[pos * 16 + f], sn = ropeI[pos * 16 + 8 + f]; o = lane < 8 ? y * cs - y8 * sn : y * cs + y8 * sn; }
          ikn[(size_t)row * 64 + lane] = f2bf(o); }
        { float v = 0.f; for (int k = 0; k < 8; ++k) v += miscp[((size_t)k * T + row) * 128 + 64 + lane];
          if (lane < 16) iwf[(size_t)row * 16 + lane] = v * (0.25f * 0.125f);
          else if (lane < 40) bgt[(size_t)row * 24 + (lane - 16)] = sigm(v); }
      }
      bf16_t* blk = (bf16_t*)(ws + O_BLK);
      for (int ch = gtid; ch < 2048 * 512; ch += gthreads) {
        const int row = ch >> 9, cc = ch & 511, j = cc >> 4, d8 = (cc & 15) * 8;
        const int kv = row >> 10, rr = row & 1023, b = rr >> 9, n = (rr & 511) >> 1, g = rr & 1, tok = 16 * n + j;
        u32x4 w = {0u, 0u, 0u, 0u};
        if (n < 255 && tok < SL) {
          const bf16x8 a = *(const bf16x8*)(hbuf + (size_t)(b * SL + tok) * NPHYS + H_BKV + kv * 256 + g * 128 + d8);
          const float* pe = p.cmp_pe + (size_t)((l * 2 + kv) * 32 + j) * 128 + d8;
          float v[8]; for (int q = 0; q < 8; ++q) v[q] = bf2f((bf16_t)a[q]) + pe[q];
          w = (u32x4){cvtpk(v[0], v[1]), cvtpk(v[2], v[3]), cvtpk(v[4], v[5]), cvtpk(v[6], v[7])};
        }
        *(u32x4*)(blk + (size_t)row * 4096 + cc * 8) = w;
      }
    }
    xcd_barrier(xb);
    { PHASE_VARS Gemm g{hbuf + H_ALAT, (const bf16_t*)(ws + O_WAUP), T, 2048, 512, NPHYS, 512}; Sched S; S.init(T, 2048, nblk, bid);
      EpiAup E{(bf16_t*)(ws + O_AK), (bf16_t*)(ws + O_AVT), (const float*)(ws + O_SROW), ropeA};
      gemm_phase(ldsl, g, S, E); }
    { PHASE_VARS if (bid < 64) { const int kc = bid >> 3;
      Gemm g{(const bf16_t*)(ws + O_BLK) + kc * 512, (const bf16_t*)(ws + O_WC1) + kc * 512, 2048, 256, 512, 4096, 4096}; Sched S; S.init(2048, 256, 8, bid & 7);
      EpiF32 E{(float*)(ws + O_CPART) + (size_t)kc * 2048 * 256, 256};
      gemm_phase(ldsl, g, S, E);
      asm volatile("s_waitcnt vmcnt(0)" ::: "memory"); __syncthreads();
      if (tid == 0) { __builtin_amdgcn_fence(__ATOMIC_RELEASE, "agent"); asm volatile("s_waitcnt vmcnt(0)" ::: "memory");
        __hip_atomic_fetch_add(ctr + l * 4 + 3, 1u, __ATOMIC_RELAXED, __HIP_MEMORY_SCOPE_AGENT); } } }
    idxsel_phase(lds, hbuf, (const bf16_t*)(ws + O_IKN), (const float*)(ws + O_IWF), (u64*)(ws + O_BITS), ctr + l * 4 + 0);
    { PHASE_VARS
      if (tid == 0) { unsigned sp_ = 0; while (__hip_atomic_load(ctr + l * 4 + 3, __ATOMIC_RELAXED, __HIP_MEMORY_SCOPE_AGENT) < 64u) { __builtin_amdgcn_s_sleep(1); if (++sp_ > (1u << 24)) break; }
        __builtin_amdgcn_fence(__ATOMIC_ACQUIRE, "agent"); asm volatile("s_waitcnt vmcnt(0)" ::: "memory"); }
      __syncthreads(); }
    { PHASE_VARS const float* cpart = (const float*)(ws + O_CPART); bf16_t* kc_ = (bf16_t*)(ws + O_KC); bf16_t* vct = (bf16_t*)(ws + O_VCT);
      float* hid = (float*)lds; float* red = (float*)lds + 128;
      for (int row = bid; row < 2048; row += nblk) {
        const int kv = row >> 10, rr = row & 1023, b = rr >> 9, n = (rr & 511) >> 1, g = rr & 1;
        __syncthreads();
        if (tid < 128) { float s = 0; for (int k = 0; k < 8; ++k) s += cpart[((size_t)k * 2048 + row) * 256 + kv * 128 + tid]; hid[tid] = silu(s); }
        __syncthreads();
        { const int cp = tid & 127, part = tid >> 7; const float* w2 = p.cmp_w2 + (size_t)(l * 2 + kv) * 128 * 128;
          float s = 0; for (int c = part * 32; c < part * 32 + 32; ++c) s += hid[c] * w2[c * 128 + cp];
          red[part * 128 + cp] = s; }
        __syncthreads();
        if (tid < 128) { const float s = red[tid] + red[128 + tid] + red[256 + tid] + red[384 + tid];
          if (kv == 0) kc_[(size_t)((b * 2 + g) * 256 + n) * 128 + tid] = f2bf(s); else vct[(size_t)((b * 2 + g) * 128 + tid) * 256 + n] = f2bf(s); }
      }
    }
    xcd_barrier(xb);
    { PHASE_VARS float* pcmp = (float*)(ws + O_PCMP); float* ml = (float*)(ws + O_ML);
      for (;;) {
        const int it = fetch_item(ctr + l * 4 + 1, slot);
        if (it >= 256) break;
        f32x16 o[4]; float mo, lo;
        const int r32 = lane & 31, hi = lane >> 5;
        const int qb = 15 - it / 16, r = it % 16, b = r >> 3, hh = r & 7, g = hh >> 2, rowg0 = b * SL + qb * 256;
        attn_core_skew<M_CMP>(ldsl, hbuf + (size_t)rowg0 * NPHYS + H_BQ + hh * 128, NPHYS, (const bf16_t*)(ws + O_KC) + (size_t)((b * 2 + g) * 256) * 128, 128,
                         (const bf16_t*)(ws + O_VCT) + (size_t)((b * 2 + g) * 128) * 256, 256, qb * 256, 0, 4, nullptr,
                         pcmp + ((size_t)(b * 8 + hh) * SL + qb * 256) * 256, o, mo, lo);
        store_o_bf16(ldsl, (bf16_t*)(ws + O_OCMP), rowg0, hh * 128, o);
        if (hi == 0) { float* mp = ml + ((size_t)(b * 8 + hh) * SL + qb * 256 + wid * 32 + r32) * 2; mp[0] = mo; mp[1] = lo; }
      }
    }
    xcd_barrier(xb);
    { PHASE_VARS const u64* sel = (const u64*)(ws + O_SEL); const float* bgt = (const float*)(ws + O_BG); const u64* bits = (const u64*)(ws + O_BITS);
      unsigned* scnt = (unsigned*)(ws + O_SC) + l * 64;
      for (;;) {
        const int it0 = fetch_item(ctr + l * 4 + 2, slot);
        if (it0 >= 1088) break;
        if (it0 < 64) {
          const int b = it0 >> 5, g = (it0 >> 4) & 1, qb = 15 - (it0 & 15);
          const float* pcmp = (const float*)(ws + O_PCMP); const float* ml = (const float*)(ws + O_ML); u64* selw_ = (u64*)(ws + O_SEL);
          for (int qq = 0; qq < 32; ++qq) {
            const int t = qb * 256 + wid * 32 + qq, m = lane, tc = t >= 31 ? ((t - 31) >> 4) : -1;
            float imp = 0.f;
            for (int hh = 0; hh < 4; ++hh) { const size_t rb = (size_t)(b * 8 + g * 4 + hh) * SL + t; const float* base = pcmp + rb * 256;
              const float mm = ml[rb * 2], ll = ml[rb * 2 + 1]; const float inv = ll > 0.f ? 1.f / ll : 0.f;
              const float NI = -__builtin_inff();
              const f32x4 s4 = 4 * m <= tc ? *(const f32x4*)(base + 4 * m) : (f32x4){NI, NI, NI, NI}; const float sm1 = (m > 0 && 4 * m - 1 <= tc) ? base[4 * m - 1] : NI;
              float ps = __builtin_amdgcn_exp2f((sm1 - mm) * C2);
              for (int j = 0; j < 4; ++j) ps += __builtin_amdgcn_exp2f((s4[j] - mm) * C2);
              imp += ps * inv; }
            const int cur = t >> 6;
            const bool forced = (m == 0) | (m == cur) | (m == cur - 1), adm = m <= cur;
            const float v = forced ? 1e6f : (adm ? imp : -1e30f);
            int rank = 0;
#pragma unroll
            for (int jj = 0; jj < 64; ++jj) { const float vj = __int_as_float(__builtin_amdgcn_readlane(__float_as_int(v), jj)); rank += (vj > v || (vj == v && jj < m)) ? 1 : 0; }
            const u64 w = __ballot(rank < 16);
            if (lane == 0) selw_[(size_t)(b * 2 + g) * SL + t] = w;
          }
          asm volatile("s_waitcnt vmcnt(0)" ::: "memory"); __syncthreads();
          if (ltid() == 0) { __builtin_amdgcn_fence(__ATOMIC_RELEASE, "agent"); asm volatile("s_waitcnt vmcnt(0)" ::: "memory");
            __hip_atomic_fetch_add(scnt + (b * 2 + g) * 16 + qb, 1u, __ATOMIC_RELAXED, __HIP_MEMORY_SCOPE_AGENT); }
          continue;
        }
        int it;
        if (it0 < 576) { const int j = it0 - 64; it = (j >> 5) * 48 + (j & 31); }
        else if (it0 < 832) { const int j = it0 - 576; it = (j >> 4) * 48 + 32 + (j & 15); }
        else it = 768 + (it0 - 832);
        f32x16 o[4]; float mo, lo;
        const int r32 = lane & 31, hi = lane >> 5;
        if (it >= 768) {
          const int i2 = it - 768, qb = 15 - i2 / 16, r = i2 % 16, b = r >> 3, hh = r & 7, g = hh >> 2, rowg0 = b * SL + qb * 256;
          const int jlo = 4 * qb - 8 > 0 ? 4 * qb - 8 : 0;
          attn_core_skew<M_WINDOW>(ldsl, hbuf + (size_t)rowg0 * NPHYS + H_BQ + hh * 128, NPHYS, hbuf + (size_t)(b * SL) * NPHYS + H_BKV + (8 + g) * 128, NPHYS,
                              (const bf16_t*)(ws + O_BVT) + (size_t)(((b * 2 + 1) * 2 + g) * 128) * SL, SL, qb * 256, jlo, 4 * qb + 4, nullptr, nullptr, o, mo, lo);
          store_o_bf16(ldsl, (bf16_t*)(ws + O_OWIN), rowg0, hh * 128, o);
          continue;
        }
        const int qb = 15 - it / 48, r = it % 48;
        if (r < 16) {
          f32x16 o8[8];
          const int b = r >> 3, vh = r & 7, head = vh >> 1, mp = vh & 1, rowg0 = b * SL + qb * 256;
          attn_core<M_CAUSAL, 256>(ldsl, hbuf + (size_t)rowg0 * NPHYS + H_CQ + (head * 2 + mp) * 128, NPHYS, hbuf + (size_t)(b * SL) * NPHYS + H_CK + (head * 2 + mp) * 128, NPHYS,
                              (const bf16_t*)(ws + O_CVT) + (size_t)((b * 4 + head) * 256) * SL, SL, qb * 256, 0, 4 * qb + 4, nullptr, nullptr, o8, mo, lo);
          __syncthreads();
          { const int t2 = ltid(), l2 = t2 & 63, w2 = t2 >> 6, r2_ = l2 & 31, h2 = l2 >> 5;
            LAS unsigned char* pw = ldsl + w2 * 17408;
#pragma unroll
            for (int rr = 0; rr < 16; ++rr)
#pragma unroll
              for (int d = 0; d < 8; ++d) *(LAS bf16_t*)(pw + ((rr & 3) + 8 * (rr >> 2) + 4 * h2) * 544 + (d * 32 + r2_) * 2) = f2bf(o8[d][rr]);
            asm volatile("s_waitcnt lgkmcnt(0)" ::: "memory");
            bf16_t* ocp = (bf16_t*)(ws + O_OC) + (size_t)(rowg0 + w2 * 32) * 2048 + head * 512 + mp * 256;
#pragma unroll
            for (int i = 0; i < 16; ++i) { const int c = i * 64 + l2, row = c >> 5, c16 = c & 31;
              *(u32x4*)(ocp + (size_t)row * 2048 + c16 * 8) = *(const LAS u32x4*)(pw + row * 544 + c16 * 16); }
            asm volatile("s_waitcnt lgkmcnt(0)" ::: "memory"); }
        } else if (r < 32) {
          const int r2 = r - 16, b = r2 >> 3, hh = r2 & 7, rowg0 = b * SL + qb * 256;
          attn_core_skew<M_BITS>(ldsl, hbuf + (size_t)rowg0 * NPHYS + H_AQ + hh * 128, NPHYS, (const bf16_t*)(ws + O_AK) + (size_t)(b * SL) * 1024 + hh * 128, 1024,
                            (const bf16_t*)(ws + O_AVT) + (size_t)((b * 8 + hh) * 128) * SL, SL, qb * 256, 0, 4 * qb + 4, bits + (size_t)rowg0 * 64, nullptr, o, mo, lo);
          store_o_bf16(ldsl, (bf16_t*)(ws + O_YA), rowg0, hh * 128, o);
        } else {
          const int r2 = r - 32, b = r2 >> 3, hh = r2 & 7, g = hh >> 2, rowg0 = b * SL + qb * 256;
          if (ltid() == 0) { unsigned sp_ = 0; while (__hip_atomic_load(scnt + (b * 2 + g) * 16 + qb, __ATOMIC_RELAXED, __HIP_MEMORY_SCOPE_AGENT) < 1u) { __builtin_amdgcn_s_sleep(1); if (++sp_ > (1u << 24)) break; }
            __builtin_amdgcn_fence(__ATOMIC_ACQUIRE, "agent"); asm volatile("s_waitcnt vmcnt(0)" ::: "memory"); }
          __syncthreads();
          attn_core_skew<M_SLC>(ldsl, hbuf + (size_t)rowg0 * NPHYS + H_BQ + hh * 128, NPHYS, hbuf + (size_t)(b * SL) * NPHYS + H_BKV + (4 + g) * 128, NPHYS,
                           (const bf16_t*)(ws + O_BVT) + (size_t)(((b * 2 + 0) * 2 + g) * 128) * SL, SL, qb * 256, 0, 4 * qb + 4, sel + (size_t)(b * 2 + g) * SL + qb * 256, nullptr, o, mo, lo);
          store_o_bf16(ldsl, (bf16_t*)(ws + O_YB), rowg0, hh * 128, o);
        }
      }
      (void)bgt;
    }
    xcd_barrier(xb);
    { PHASE_VARS const bf16_t* ocmp = (const bf16_t*)(ws + O_OCMP); const bf16_t* owin = (const bf16_t*)(ws + O_OWIN); bf16_t* yb = (bf16_t*)(ws + O_YB); const float* bgt = (const float*)(ws + O_BG);
      for (int row = gw; row < T; row += nw) {
#pragma unroll
        for (int hq = 0; hq < 2; ++hq) { const int c0 = hq * 512 + lane * 8, hh = c0 >> 7; const float* gp = bgt + (size_t)row * 24 + hh * 3; const float g0 = gp[0], g1 = gp[1], g2 = gp[2];
          const size_t rw = (size_t)row * 1024 + c0;
          const bf16x8 a = *(const bf16x8*)(ocmp + rw), b8 = *(const bf16x8*)(yb + rw), c8 = *(const bf16x8*)(owin + rw);
          float v[8]; for (int q = 0; q < 8; ++q) v[q] = g0 * bf2f((bf16_t)a[q]) + g1 * bf2f((bf16_t)b8[q]) + g2 * bf2f((bf16_t)c8[q]);
          *(u32x4*)(yb + rw) = (u32x4){cvtpk(v[0], v[1]), cvtpk(v[2], v[3]), cvtpk(v[4], v[5]), cvtpk(v[6], v[7])}; }
      }
    }
    { PHASE_VARS const bf16_t* oc = (const bf16_t*)(ws + O_OC); bf16_t* yc = (bf16_t*)(ws + O_YC);
      const float lamv = scal[l * 2], omli = scal[l * 2 + 1];
      for (int it = gw; it < T * 4; it += nw) {
        const int row = it >> 2, head = it & 3;
        const s16x4 a = *(const s16x4*)(oc + (size_t)row * 2048 + head * 512 + lane * 4), b4 = *(const s16x4*)(oc + (size_t)row * 2048 + head * 512 + 256 + lane * 4);
        float v[4], s = 0; for (int j = 0; j < 4; ++j) { v[j] = bf2f((bf16_t)a[j]) - lamv * bf2f((bf16_t)b4[j]); s += v[j] * v[j]; }
        const float rs = rsqrtf(wsum(s) * (1.f / 256.f) + 1e-6f);
        const f32x4 gg = *(const f32x4*)(p.subln_g + l * 256 + lane * 4);
        float o4[4]; for (int j = 0; j < 4; ++j) o4[j] = v[j] * rs * gg[j] * omli;
        *(u32x2*)(yc + (size_t)row * 1024 + head * 256 + lane * 4) = (u32x2){cvtpk(o4[0], o4[1]), cvtpk(o4[2], o4[3])};
      }
    }
    xcd_barrier(xb);
    for (int r = 0; r < 3; ++r) { PHASE_VARS
      const bf16_t* yr = (const bf16_t*)(ws + (r == 0 ? O_YA : (r == 1 ? O_YB : O_YC)));
      Gemm g{yr, (const bf16_t*)(ws + O_WBR) + (size_t)r * 2048 * 1024, T, 2048, 1024, 1024, 1024}; Sched S; S.init(T, 2048, nblk, bid);
      EpiGate E{hbuf, (float*)(ws + O_TMP), (bf16_t*)(ws + O_MERG), r};
      gemm_phase(ldsl, g, S, E);
    }
    xcd_barrier(xb);
    { PHASE_VARS Gemm g{(const bf16_t*)(ws + O_MERG), (const bf16_t*)(ws + O_WO), T, 2048, 2048, 2048, 2048}; Sched S; S.init(T, 2048, nblk, bid);
      EpiLnFused E{xin, modl + 2 * 2048, p.ln_g + (size_t)(l * 2 + 0) * 2048, p.ln_b + (size_t)(l * 2 + 0) * 2048, (float*)(ws + O_X1), modl, 3, 4, ubuf,
                   (float*)(ws + O_LNS), (unsigned*)(ws + O_LNC) + (l * 2 + 0) * 64};
      gemm_phase(ldsl, g, S, E); }
    xcd_barrier(xb);
    { PHASE_VARS Gemm g{ubuf, (const bf16_t*)(ws + O_WF1), T, 2 * DFF, 2048, 2048, 2048}; Sched S; S.init(T, 2 * DFF, nblk, bid);
      EpiSwiglu E{(bf16_t*)(ws + O_HID)};
      gemm_phase(ldsl, g, S, E); }
    xcd_barrier(xb);
    { PHASE_VARS Gemm g{(const bf16_t*)(ws + O_HID), (const bf16_t*)(ws + O_WF2), T, 2048, DFF, DFF, DFF}; Sched S; S.init(T, 2048, nblk, bid);
      EpiLnFused E{(const float*)(ws + O_X1), modl + 5 * 2048, p.ln_g + (size_t)(l * 2 + 1) * 2048, p.ln_b + (size_t)(l * 2 + 1) * 2048, xnext, mod + 2 * 12288, 0, 1, l == 0 ? ubuf : nullptr,
                   (float*)(ws + O_LNS), (unsigned*)(ws + O_LNC) + (l * 2 + 1) * 64};
      gemm_phase(ldsl, g, S, E); }
    if (l == 0) { xcd_barrier(xb); convert_layer(p, 1, (float*)lds); xcd_barrier(xb); }
  }
}

extern "C" void kernel_launch(void* const* d_in, const int* in_sizes, int n_in, void* d_out, int out_size, void* d_ws, size_t ws_size, hipStream_t stream) {
  (void)in_sizes; (void)n_in; (void)out_size;
  static int grid_blocks = 0;
  if (!grid_blocks) {
    hipError_t e = hipFuncSetAttribute((const void*)fwd_megakernel, hipFuncAttributeMaxDynamicSharedMemorySize, LDS_BYTES);
    if (e != hipSuccess) fprintf(stderr, "hipFuncSetAttribute failed: %s\n", hipGetErrorString(e));
    int dev = 0, cus = 0, per_cu = 0;
    hipGetDevice(&dev);
    hipDeviceGetAttribute(&cus, hipDeviceAttributeMultiprocessorCount, dev);
    hipOccupancyMaxActiveBlocksPerMultiprocessor(&per_cu, fwd_megakernel, NTHR, LDS_BYTES);
    if (per_cu < 1) per_cu = 1;
    grid_blocks = cus;
    if (ws_size < WS_TOTAL) fprintf(stderr, "workspace too small: %zu < %zu\n", ws_size, (size_t)WS_TOTAL);
  }
  Params p{};
  p.x = (const float*)d_in[0]; p.c = (const float*)d_in[1]; p.w_ada = (const float*)d_in[2]; p.b_ada = (const float*)d_in[3]; p.w_in = (const float*)d_in[4];
  p.a_lat_g = (const float*)d_in[5]; p.a_up = (const float*)d_in[6]; p.cmp_w1 = (const float*)d_in[7]; p.cmp_w2 = (const float*)d_in[8]; p.cmp_pe = (const float*)d_in[9];
  p.lam = (const float*)d_in[10]; p.subln_g = (const float*)d_in[11]; p.w_br = (const float*)d_in[12]; p.w_o = (const float*)d_in[13]; p.w_f1 = (const float*)d_in[14];
  p.w_f2 = (const float*)d_in[15]; p.ln_g = (const float*)d_in[16]; p.ln_b = (const float*)d_in[17];
  p.out = (float*)d_out; p.ws = (unsigned char*)d_ws;
  void* args[] = {&p};
  hipError_t e = hipLaunchCooperativeKernel((const void*)fwd_megakernel, dim3(grid_blocks), dim3(NTHR), args, LDS_BYTES, stream);
  if (e != hipSuccess) fprintf(stderr, "cooperative launch failed: %s (grid %d)\n", hipGetErrorString(e), grid_blocks);
}
```

```cpp
#include <hip/hip_runtime.h>
#include <hip/hip_cooperative_groups.h>
#include <cstdio>
#include <cstdint>
namespace cg = cooperative_groups;

#define DI __device__ __forceinline__
#define LAS __attribute__((address_space(3)))
typedef unsigned short bf16_t;
typedef short bf16x8 __attribute__((ext_vector_type(8)));
typedef short s16x4 __attribute__((ext_vector_type(4)));
typedef float f32x4 __attribute__((ext_vector_type(4)));
typedef float f32x16 __attribute__((ext_vector_type(16)));
typedef unsigned u32x4 __attribute__((ext_vector_type(4)));
typedef unsigned u32x2 __attribute__((ext_vector_type(2)));
typedef unsigned long long u64;

constexpr int T = 8192, SL = 4096, DM = 2048, NPHYS = 14336, DFF = 5632, NIN = 14440;
constexpr int H_AQ = 0, H_ALAT = 1024, H_IQ = 1536, H_BQ = 2560, H_BKV = 3584, H_CQ = 5120, H_CK = 6144, H_GL = 8192;
constexpr float ALPHA = 1.4142135623730951f;
constexpr float C2 = 0.08838834764831845f * 1.4426950408889634f;
constexpr int NTHR = 512;
constexpr int LDS_BYTES = 147456, SLOT_OFF = 145408, XST_OFF = 146432, PD_OFF = 73728;

constexpr size_t al256(size_t x) { return (x + 255) & ~(size_t)255; }
constexpr size_t O_WIN = 0;
constexpr size_t O_WAUP = O_WIN + (size_t)NPHYS * 2048 * 2;
constexpr size_t O_WC1 = O_WAUP + (size_t)2048 * 512 * 2;
constexpr size_t O_WBR = O_WC1 + (size_t)256 * 4096 * 2;
constexpr size_t O_WO = O_WBR + (size_t)3 * 2048 * 1024 * 2;
constexpr size_t O_WF1 = O_WO + (size_t)2048 * 2048 * 2;
constexpr size_t O_WF2 = O_WF1 + (size_t)2 * DFF * 2048 * 2;
constexpr size_t O_WMISC = O_WF2 + (size_t)2048 * DFF * 2;
constexpr size_t O_H = O_WMISC + (size_t)256 * 2048 * 2;
constexpr size_t O_HID = O_H;
constexpr size_t O_X1 = O_H + (size_t)T * DFF * 2;
constexpr size_t O_S = O_H + (size_t)T * NPHYS * 2;
constexpr size_t O_MISCP = O_S;
constexpr size_t O_PCMP = O_S;
constexpr size_t O_OC = O_S + (size_t)T * 2048 * 4;
constexpr size_t O_TMP = O_S;
constexpr size_t O_Z = O_OC;
constexpr size_t O_XBUF = O_S + (size_t)T * 4096 * 4;
constexpr size_t O_UBUF = O_XBUF + (size_t)T * DM * 4;
constexpr size_t O_AVT = O_UBUF + (size_t)T * DM * 2;
constexpr size_t O_BVT = O_AVT + (size_t)2 * 8 * 128 * 4096 * 2;
constexpr size_t O_CVT = O_BVT + (size_t)2 * 2 * 2 * 128 * 4096 * 2;
constexpr size_t O_AK = O_CVT + (size_t)2 * 4 * 256 * 4096 * 2;
constexpr size_t O_MISC = O_AK + (size_t)T * 1024 * 2;
constexpr size_t O_IKN = O_MISC + (size_t)T * 128 * 4;
constexpr size_t O_IWF = O_IKN + (size_t)T * 64 * 2;
constexpr size_t O_BG = O_IWF + (size_t)T * 16 * 4;
constexpr size_t O_SROW = O_BG + (size_t)T * 24 * 4;
constexpr size_t O_BLK = O_SROW + (size_t)T * 4;
constexpr size_t O_CPART = O_BLK + (size_t)2048 * 4096 * 2;
constexpr size_t O_KC = O_CPART + (size_t)8 * 2048 * 256 * 4;
constexpr size_t O_VCT = O_KC + (size_t)2 * 2 * 256 * 128 * 2;
constexpr size_t O_BITS = O_VCT + (size_t)2 * 2 * 128 * 256 * 2;
constexpr size_t O_SEL = O_BITS + (size_t)T * 64 * 8;
constexpr size_t O_ML = O_SEL + (size_t)2 * 2 * 4096 * 8;
constexpr size_t O_YA = O_ML + (size_t)2 * 8 * 4096 * 2 * 4;
constexpr size_t O_YB = O_YA + (size_t)T * 1024 * 2;
constexpr size_t O_YC = O_YB + (size_t)T * 1024 * 2;
constexpr size_t O_OCMP = O_YC + (size_t)T * 1024 * 2;
constexpr size_t O_OWIN = O_OCMP + (size_t)T * 1024 * 2;
constexpr size_t O_MERG = O_OWIN + (size_t)T * 1024 * 2;
constexpr size_t O_MODP = O_MERG + (size_t)T * DM * 2;
constexpr size_t O_MOD = O_MODP + (size_t)8 * 2 * 2 * 12288 * 4;
constexpr size_t O_ROPA = O_MOD + (size_t)2 * 2 * 12288 * 4;
constexpr size_t O_ROPI = O_ROPA + (size_t)4096 * 32 * 4;
constexpr size_t O_SCAL = O_ROPI + (size_t)4096 * 16 * 4;
constexpr size_t O_CTR = O_SCAL + 256;
constexpr size_t O_LNC = O_CTR + 256;
constexpr size_t O_LNS = O_LNC + 1024;
constexpr size_t O_BAR = O_LNS + (size_t)2 * 32 * 256 * 16 * 4;
constexpr size_t WS_TOTAL = O_BAR + 3456 * 4;

struct Params {
  const float *x, *c, *w_ada, *b_ada, *w_in, *a_lat_g, *a_up, *cmp_w1, *cmp_w2, *cmp_pe, *lam, *subln_g, *w_br, *w_o, *w_f1, *w_f2, *ln_g, *ln_b;
  float* out;
  unsigned char* ws;
};

DI unsigned cvtpk(float lo, float hi) { unsigned r; asm volatile("v_cvt_pk_bf16_f32 %0, %1, %2" : "=v"(r) : "v"(lo), "v"(hi)); return r; }
DI float bf2f(bf16_t b) { return __uint_as_float(((unsigned)b) << 16); }
DI bf16_t f2bf(float f) { return (bf16_t)(cvtpk(f, 0.f) & 0xffffu); }
DI float wsum(float v) { for (int o = 32; o; o >>= 1) v += __shfl_xor(v, o); return v; }
DI float sigm(float x) { return __builtin_amdgcn_rcpf(1.f + __expf(-x)); }
DI float silu(float x) { return x * __builtin_amdgcn_rcpf(1.f + __expf(-x)); }
DI int crow(int r, int hi) { return (r & 3) + 8 * (r >> 2) + 4 * hi; }
DI float vmin_raw(float a, float b) { float r; asm("v_min_f32_e32 %0, %1, %2" : "=v"(r) : "v"(a), "v"(b)); return r; }
DI int ltid() { int t = threadIdx.x; asm volatile("" : "+v"(t)); return t; }
DI int lbid() { int b = blockIdx.x; asm volatile("" : "+s"(b)); return b; }
#define PHASE_VARS const int tid = ltid(), bid = lbid(), nblk = gridDim.x, gtid = bid * NTHR + tid, gthreads = nblk * NTHR, lane = tid & 63, wid = tid >> 6, gw = bid * 8 + wid, nw = nblk * 8; (void)gtid; (void)gthreads; (void)lane; (void)wid; (void)gw; (void)nw;

struct MapId { int off; DI int operator()(int n) const { return n + off; } };
struct MapIn { DI int operator()(int n) const {
    if (n < 2560) return n;
    if (n < 5120) return n + 80;
    return n + 104; } };
struct MapMisc { DI int operator()(int n) const { return n < 80 ? 2560 + n : (n < 104 ? 5200 + (n - 80) : -1); } };
struct MapF1 { DI int operator()(int n) const { const int q = n >> 5, r = n & 31; return r < 16 ? q * 16 + r : DFF + q * 16 + (r - 16); } };

template <class Map>
DI void conv_T(bf16_t* __restrict__ dst, const float* __restrict__ src, int K, int ldsrc, int nphys, Map map, const float* __restrict__ kscale, float* tile) {
  const int tid = ltid(), ntn = nphys >> 6, ntiles = (K >> 6) * ntn;
  for (int tl = lbid(); tl < ntiles; tl += gridDim.x) {
    const int k0 = (tl / ntn) << 6, n0 = (tl % ntn) << 6;
    const int nn = tid & 63, sc = map(n0 + nn);
#pragma unroll
    for (int i = 0; i < 8; ++i) { const int kk = i * 8 + (tid >> 6);
      float v = sc >= 0 ? src[(size_t)(k0 + kk) * ldsrc + sc] : 0.f;
      if (kscale) v *= kscale[k0 + kk];
      tile[kk * 65 + nn] = v; }
    __syncthreads();
    const int np = tid >> 3, ks = tid & 7;
    float v[8];
#pragma unroll
    for (int j = 0; j < 8; ++j) v[j] = tile[(ks * 8 + j) * 65 + np];
    u32x4 w = {cvtpk(v[0], v[1]), cvtpk(v[2], v[3]), cvtpk(v[4], v[5]), cvtpk(v[6], v[7])};
    *(u32x4*)(dst + (size_t)(n0 + np) * K + k0 + ks * 8) = w;
    __syncthreads();
  }
}

DI void convert_layer(const Params& p, int l, float* tile) {
  unsigned char* ws = p.ws;
  conv_T((bf16_t*)(ws + O_WIN), p.w_in + (size_t)l * 2048 * NIN, 2048, NIN, NPHYS, MapIn{}, nullptr, tile);
  conv_T((bf16_t*)(ws + O_WMISC), p.w_in + (size_t)l * 2048 * NIN, 2048, NIN, 256, MapMisc{}, nullptr, tile);
  conv_T((bf16_t*)(ws + O_WAUP), p.a_up + (size_t)l * 512 * 2048, 512, 2048, 2048, MapId{0}, p.a_lat_g + l * 512, tile);
  conv_T((bf16_t*)(ws + O_WC1), p.cmp_w1 + (size_t)(l * 2 + 0) * 4096 * 128, 4096, 128, 128, MapId{0}, nullptr, tile);
  conv_T((bf16_t*)(ws + O_WC1) + (size_t)128 * 4096, p.cmp_w1 + (size_t)(l * 2 + 1) * 4096 * 128, 4096, 128, 128, MapId{0}, nullptr, tile);
  for (int r = 0; r < 3; ++r)
    conv_T((bf16_t*)(ws + O_WBR) + (size_t)r * 2048 * 1024, p.w_br + (size_t)(l * 3 + r) * 1024 * 2048, 1024, 2048, 2048, MapId{0}, nullptr, tile);
  conv_T((bf16_t*)(ws + O_WO), p.w_o + (size_t)l * 2048 * 2048, 2048, 2048, 2048, MapId{0}, nullptr, tile);
  conv_T((bf16_t*)(ws + O_WF1), p.w_f1 + (size_t)l * 2048 * 2 * DFF, 2048, 2 * DFF, 2 * DFF, MapF1{}, nullptr, tile);
  conv_T((bf16_t*)(ws + O_WF2), p.w_f2 + (size_t)l * DFF * 2048, DFF, 2048, 2048, MapId{0}, nullptr, tile);
}

DI void ln_phase(const float* __restrict__ zin, const float* __restrict__ gam, const float* __restrict__ bet, float* __restrict__ xout,
                 const float* __restrict__ modl  , int sh_idx, int sc_idx, bf16_t* __restrict__ uout) {
  const int tid_ = ltid(), lane = tid_ & 63, gw = lbid() * 8 + (tid_ >> 6), nw = gridDim.x * 8;
  for (int row = gw; row < T; row += nw) {
    f32x4 v[8];
    const float* zr = zin + (size_t)row * DM;
#pragma unroll
    for (int i = 0; i < 8; ++i) v[i] = *(const f32x4*)(zr + i * 256 + lane * 4);
    if (gam) {
      float s = 0; for (int i = 0; i < 8; ++i) s += v[i][0] + v[i][1] + v[i][2] + v[i][3];
      const float mu = wsum(s) * (1.f / DM);
      float q = 0; for (int i = 0; i < 8; ++i) for (int j = 0; j < 4; ++j) { const float d = v[i][j] - mu; q += d * d; }
      const float rstd = rsqrtf(wsum(q) * (1.f / DM) + 1e-5f);
#pragma unroll
      for (int i = 0; i < 8; ++i) { const f32x4 g = *(const f32x4*)(gam + i * 256 + lane * 4), b = *(const f32x4*)(bet + i * 256 + lane * 4);
        for (int j = 0; j < 4; ++j) v[i][j] = (v[i][j] - mu) * rstd * g[j] + b[j];
        *(f32x4*)(xout + (size_t)row * DM + i * 256 + lane * 4) = v[i]; }
    }
    if (uout) {
      const float* mb = modl + (row >> 12) * 12288;
      float s = 0; for (int i = 0; i < 8; ++i) s += v[i][0] + v[i][1] + v[i][2] + v[i][3];
      const float mu = wsum(s) * (1.f / DM);
      float q = 0; for (int i = 0; i < 8; ++i) for (int j = 0; j < 4; ++j) { const float d = v[i][j] - mu; q += d * d; }
      const float rstd = rsqrtf(wsum(q) * (1.f / DM) + 1e-5f);
#pragma unroll
      for (int i = 0; i < 8; ++i) { const int c = i * 256 + lane * 4;
        const f32x4 sc = *(const f32x4*)(mb + sc_idx * 2048 + c), sh = *(const f32x4*)(mb + sh_idx * 2048 + c);
        float o[4]; for (int j = 0; j < 4; ++j) o[j] = (v[i][j] - mu) * rstd * (1.f + sc[j]) + sh[j];
        u32x2 w = {cvtpk(o[0], o[1]), cvtpk(o[2], o[3])};
        *(u32x2*)(uout + (size_t)row * DM + c) = w; }
    }
  }
}

constexpr int BM = 256, BK = 64, HALF = 128, HTB = HALF * BK * 2, NXCD = 8, WGM = 8;
DI int lds_byte(int r, int c) { const int st = (r >> 4) * 2 + (c >> 5), rr = r & 15, cc = c & 31, ob = rr * 64 + cc * 2; return st * 1024 + (ob ^ (((ob >> 9) & 1) << 5)); }
DI void stage_rc(int b, int& R, int& C) { const int st = b / 1024, sb = b % 1024, swz = sb ^ (((sb >> 9) & 1) << 5); R = (st >> 1) * 16 + swz / 64; C = (st & 1) * 32 + (swz % 64) / 2; }
DI int perm32(int rho) { const int n = rho >> 4, i = rho & 15; return 8 * (i >> 2) + 4 * n + (i & 3); }
struct Unit { int pm, pn; };
struct Gemm { const bf16_t* A; const bf16_t* Bt; int M, N, K, lda, ldb; };
struct Sched {
  int nM, nN, nwg, G, c, strm;
  DI void init(int M, int N, int G_, int c_) { nM = M / BM; nN = N / BM; nwg = nM * nN; G = G_; c = c_; strm = 0; }
  DI void tile_of(int wgid, Unit& u) const {
    { const int q = nwg / NXCD, r = nwg % NXCD, xcd = wgid % NXCD, off = wgid / NXCD; wgid = (xcd < r ? xcd * (q + 1) : r * (q + 1) + (xcd - r) * q) + off; }
    const int nig = WGM * nN, gid = wgid / nig, fm = gid * WGM, gsz = (nM - fm) < WGM ? (nM - fm) : WGM;
    u.pm = fm + ((wgid % nig) % gsz); u.pn = (wgid % nig) / gsz;
  }
  DI bool next(int i, Unit& u) const {
    if (strm) { if (i >= strm || c >= nwg) return false; tile_of(c, u); u.pm += nM * i; u.pn += nN * i; return true; }
    const long L = (long)i * G + c; if (L >= nwg) return false;
    tile_of((int)L, u); return true;
  }
};

template <class Epi>
DI void gemm_phase(LAS unsigned char* lds, const Gemm g, const Sched& S, const Epi& E) {
  const int tid = ltid(), wid = __builtin_amdgcn_readfirstlane(tid >> 6), lane = tid & 63, wr = wid >> 2, wc = wid & 3, fr = lane & 15, fq = lane >> 4;
  const int K = g.K, nt = K / BK;
  unsigned voffA[2], voffB[2];
#pragma unroll
  for (int i = 0; i < 2; ++i) { int R, C; stage_rc(tid * 16 + i * 8192, R, C); const int Rb = Epi::PERM ? ((R & ~31) + perm32(R & 31)) : R;
    voffA[i] = (unsigned)(R * g.lda + C) * 2u; voffB[i] = (unsigned)(Rb * g.ldb + C) * 2u; }
  const size_t kstep = (size_t)(BK * 2);
  const size_t hstepA = (size_t)HALF * g.lda * 2, hstepB = (size_t)HALF * g.ldb * 2;
  const size_t tstepA = 2 * hstepA, tstepB = 2 * hstepB;
  const unsigned ldsw = (unsigned)wid * 1024u;
  const int aoff = lds_byte(wr * 64 + fr, fq * 8), boff = lds_byte(wc * 32 + fr, fq * 8);
#define PG8_SA(b, h) (((b) * 2 + (h)) * HTB)
#define PG8_SB(b, h) ((4 + (b) * 2 + (h)) * HTB)
#define PG8_STAGE(bufoff, gbase, voff) do { _Pragma("unroll") for (int _i = 0; _i < 2; ++_i) \
        __builtin_amdgcn_global_load_lds((const unsigned*)((const char*)(gbase) + (voff)[_i]), (LAS unsigned*)(lds + (bufoff) + ldsw + _i * 8192), 16, 0, 0); } while (0)
#define PG8_LDA(dst, b, h) do { _Pragma("unroll") for (int m = 0; m < 4; ++m) _Pragma("unroll") for (int k = 0; k < 2; ++k) dst[m][k] = *(const LAS bf16x8*)(lds + PG8_SA(b, h) + aoff + m * 2048 + k * 1024); } while (0)
#define PG8_LDB(dst, b, h) do { _Pragma("unroll") for (int n = 0; n < 2; ++n) _Pragma("unroll") for (int k = 0; k < 2; ++k) dst[n][k] = *(const LAS bf16x8*)(lds + PG8_SB(b, h) + boff + n * 2048 + k * 1024); } while (0)
#define PG8_MMA(ai, bj, At, Bt) do { __builtin_amdgcn_s_setprio(1); _Pragma("unroll") for (int m = 0; m < 4; ++m) _Pragma("unroll") for (int n = 0; n < 2; ++n) _Pragma("unroll") for (int k = 0; k < 2; ++k) \
        acc[ai][bj][m][n] = __builtin_amdgcn_mfma_f32_16x16x32_bf16(Bt[n][k], At[m][k], acc[ai][bj][m][n], 0, 0, 0); __builtin_amdgcn_s_setprio(0); } while (0)
#define PG8_WAIT_V(n) asm volatile("s_waitcnt vmcnt(" #n ")" ::: "memory")
#define PG8_WAIT_L(n) asm volatile("s_waitcnt lgkmcnt(" #n ")" ::: "memory")
#define PG8_BAR __builtin_amdgcn_s_barrier()
#define PG8_SCHED __builtin_amdgcn_sched_barrier(0)
  Unit cur, nxt; int ui = 0;
  if (!S.next(0, cur)) return;
  f32x4 acc[2][2][4][2];
#pragma unroll
  for (int a = 0; a < 2; ++a)
#pragma unroll
    for (int b = 0; b < 2; ++b)
#pragma unroll
      for (int m = 0; m < 4; ++m)
#pragma unroll
        for (int n = 0; n < 2; ++n) acc[a][b][m][n] = (f32x4){0.f, 0.f, 0.f, 0.f};
  bf16x8 At[4][2], B0[2][2], B1[2][2];
  const char* cA = (const char*)g.A + (size_t)cur.pm * tstepA; const char* cB = (const char*)g.Bt + (size_t)cur.pn * tstepB;
  PG8_STAGE(PG8_SB(0, 0), cB, voffB); PG8_STAGE(PG8_SB(0, 1), cB + hstepB, voffB); PG8_STAGE(PG8_SA(0, 0), cA, voffA); PG8_STAGE(PG8_SA(0, 1), cA + hstepA, voffA);
  if (wr == 1) PG8_BAR;
  PG8_WAIT_V(2); PG8_BAR;
  PG8_STAGE(PG8_SB(1, 0), cB + kstep, voffB); PG8_STAGE(PG8_SA(1, 0), cA + kstep, voffA); PG8_STAGE(PG8_SB(1, 1), cB + hstepB + kstep, voffB);
  PG8_WAIT_V(6); PG8_BAR;
  for (;;) {
    const bool has_next = S.next(ui + 1, nxt);
    const char* nA = has_next ? (const char*)g.A + (size_t)nxt.pm * tstepA : cA; const char* nB = has_next ? (const char*)g.Bt + (size_t)nxt.pn * tstepB : cB;
    for (int t = 0; t < nt; t += 2) {
      const bool last = (t == nt - 2);
      const char* a1 = cA + (size_t)(t + 1) * kstep;
      const char* a2 = last ? nA : cA + (size_t)(t + 2) * kstep; const char* b2 = last ? nB : cB + (size_t)(t + 2) * kstep;
      const char* a3 = a2 + kstep; const char* b3 = b2 + kstep;
      PG8_LDB(B0, 0, 0); PG8_LDB(B1, 0, 1); PG8_SCHED; PG8_LDA(At, 0, 0); PG8_STAGE(PG8_SA(1, 1), a1 + hstepA, voffA);
      PG8_WAIT_V(8); PG8_WAIT_L(0); PG8_BAR; PG8_MMA(0, 0, At, B0); PG8_MMA(0, 1, At, B1); PG8_BAR; PG8_SCHED;
      PG8_LDA(At, 0, 1); PG8_STAGE(PG8_SB(0, 0), b2, voffB); PG8_STAGE(PG8_SB(0, 1), b2 + hstepB, voffB); PG8_STAGE(PG8_SA(0, 0), a2, voffA);
      PG8_WAIT_V(8); PG8_WAIT_L(0); PG8_BAR; PG8_MMA(1, 0, At, B0); PG8_MMA(1, 1, At, B1); PG8_BAR; PG8_SCHED;
      PG8_LDB(B0, 1, 0); PG8_LDB(B1, 1, 1); PG8_SCHED; PG8_LDA(At, 1, 0); PG8_STAGE(PG8_SA(0, 1), a2 + hstepA, voffA);
      PG8_WAIT_V(8); PG8_WAIT_L(0); PG8_BAR; PG8_MMA(0, 0, At, B0); PG8_MMA(0, 1, At, B1); PG8_BAR; PG8_SCHED;
      PG8_LDA(At, 1, 1); PG8_STAGE(PG8_SB(1, 0), b3, voffB); PG8_STAGE(PG8_SB(1, 1), b3 + hstepB, voffB); PG8_STAGE(PG8_SA(1, 0), a3, voffA);
      PG8_WAIT_V(8); PG8_WAIT_L(0); PG8_BAR; PG8_MMA(1, 0, At, B0); PG8_MMA(1, 1, At, B1); PG8_BAR; PG8_SCHED;
    }
    if constexpr (!Epi::AFTER_DRAIN) { if (wr == 0) PG8_BAR;
      E(acc, cur, wr, wc, fr, fq); }
    if (!has_next) break;
#pragma unroll
    for (int a = 0; a < 2; ++a)
#pragma unroll
      for (int b = 0; b < 2; ++b)
#pragma unroll
        for (int m = 0; m < 4; ++m)
#pragma unroll
          for (int n = 0; n < 2; ++n) acc[a][b][m][n] = (f32x4){0.f, 0.f, 0.f, 0.f};
    cur = nxt; cA = nA; cB = nB; ++ui;
    if constexpr (!Epi::AFTER_DRAIN) { if (wr == 1) PG8_BAR; }
  }
  PG8_WAIT_V(0);
  if constexpr (Epi::AFTER_DRAIN) { if (wr == 0) PG8_BAR; }
  PG8_BAR;
  if constexpr (Epi::AFTER_DRAIN) E.fused(acc, cur, lds, tid, wr, wc, fr, fq);
#undef PG8_SA
#undef PG8_SB
#undef PG8_STAGE
#undef PG8_LDA
#undef PG8_LDB
#undef PG8_MMA
#undef PG8_WAIT_V
#undef PG8_WAIT_L
#undef PG8_BAR
#undef PG8_SCHED
}

typedef f32x4 AccT[2][2][4][2];

DI void rope128(f32x4& v0, f32x4& v1, const float* ropeA, int pos, int fq) {
  const f32x4 cs = *(const f32x4*)(ropeA + pos * 32 + 4 * fq), sn = *(const f32x4*)(ropeA + pos * 32 + 16 + 4 * fq);
#pragma unroll
  for (int j = 0; j < 4; ++j) { const float x1 = v0[j], x2 = v1[j]; v0[j] = x1 * cs[j] - x2 * sn[j]; v1[j] = x2 * cs[j] + x1 * sn[j]; }
}
DI void store_vt(bf16_t* base  , int d0, int pos, const f32x4& v) {
#pragma unroll
  for (int j = 0; j < 4; ++j) base[(size_t)(d0 + j) * SL + pos] = f2bf(v[j]);
}

struct EpiIn {
  static constexpr bool PERM = false, AFTER_DRAIN = false;
  bf16_t* h; bf16_t* bvT; bf16_t* cvT; const float* ropeA; const float* ropeI;
  DI void operator()(const AccT& acc, const Unit& u, int wr, int wc, int fr, int fq) const {
#pragma unroll
    for (int bj = 0; bj < 2; ++bj) {
      const int cb = u.pn * 2 + bj;
      int type;
      if (cb < 8) type = 1; else if (cb < 12) type = 0; else if (cb < 20) type = 2; else if (cb < 28) type = 1;
      else if (cb < 40) { const int idx = cb - 28, br = idx >> 2, kv = (idx >> 1) & 1; type = kv == 0 ? 1 : (br == 0 ? 0 : 4); }
      else if (cb < 56) type = 1; else if (cb < 64) type = 5; else type = 6;
#pragma unroll
      for (int ai = 0; ai < 2; ++ai)
#pragma unroll
        for (int m = 0; m < 4; ++m) {
          const int row = u.pm * BM + ai * HALF + wr * 64 + m * 16 + fr, pos = row & (SL - 1), b = row >> 12;
          f32x4 v0 = acc[ai][bj][m][0], v1 = acc[ai][bj][m][1];
          const int cin = wc * 32 + 4 * fq;
          if (type == 1) { if (wc == 0) rope128(v0, v1, ropeA, pos, fq); }
          else if (type == 2) { if ((wc & 1) == 0) {
              const f32x4 cs = *(const f32x4*)(ropeI + pos * 16 + 4 * (fq & 1)), sn = *(const f32x4*)(ropeI + pos * 16 + 8 + 4 * (fq & 1));
#pragma unroll
              for (int j = 0; j < 4; ++j) { const float mine = v0[j], oth = __shfl_xor(mine, 32);
                v0[j] = fq < 2 ? mine * cs[j] - oth * sn[j] : mine * cs[j] + oth * sn[j]; } } }
          else if (type == 6) { for (int j = 0; j < 4; ++j) { v0[j] = sigm(v0[j]); v1[j] = sigm(v1[j]); } }
          if (type == 4) { const int idx = cb - 28, br = idx >> 2, gg = idx & 1; bf16_t* base = bvT + (size_t)(((b * 2 + (br - 1)) * 2 + gg) * 128) * SL;
            store_vt(base, cin, pos, v0); store_vt(base, cin + 16, pos, v1); }
          else if (type == 5) { const int idx = cb - 56; bf16_t* base = cvT + (size_t)((b * 4 + (idx >> 1)) * 256 + (idx & 1) * 128) * SL;
            store_vt(base, cin, pos, v0); store_vt(base, cin + 16, pos, v1); }
          else { bf16_t* dp = h + (size_t)row * NPHYS + cb * 128 + cin;
            *(u32x2*)dp = (u32x2){cvtpk(v0[0], v0[1]), cvtpk(v0[2], v0[3])}; *(u32x2*)(dp + 16) = (u32x2){cvtpk(v1[0], v1[1]), cvtpk(v1[2], v1[3])}; }
        }
    }
  }
};

struct EpiAup {
  static constexpr bool PERM = false, AFTER_DRAIN = false;
  bf16_t* ak; bf16_t* avT; const float* srow; const float* ropeA;
  DI void operator()(const AccT& acc, const Unit& u, int wr, int wc, int fr, int fq) const {
#pragma unroll
    for (int bj = 0; bj < 2; ++bj) {
      const int cb = u.pn * 2 + bj;
#pragma unroll
      for (int ai = 0; ai < 2; ++ai)
#pragma unroll
        for (int m = 0; m < 4; ++m) {
          const int row = u.pm * BM + ai * HALF + wr * 64 + m * 16 + fr, pos = row & (SL - 1), b = row >> 12;
          const float s = srow[row];
          f32x4 v0 = acc[ai][bj][m][0] * s, v1 = acc[ai][bj][m][1] * s;
          const int cin = wc * 32 + 4 * fq;
          if (cb < 8) { if (wc == 0) rope128(v0, v1, ropeA, pos, fq);
            bf16_t* dp = ak + (size_t)row * 1024 + cb * 128 + cin;
            *(u32x2*)dp = (u32x2){cvtpk(v0[0], v0[1]), cvtpk(v0[2], v0[3])}; *(u32x2*)(dp + 16) = (u32x2){cvtpk(v1[0], v1[1]), cvtpk(v1[2], v1[3])}; }
          else { bf16_t* base = avT + (size_t)((b * 8 + (cb - 8)) * 128) * SL; store_vt(base, cin, pos, v0); store_vt(base, cin + 16, pos, v1); }
        }
    }
  }
};

struct EpiF32 {
  static constexpr bool PERM = false, AFTER_DRAIN = false;
  float* C; int ldc;
  DI void operator()(const AccT& acc, const Unit& u, int wr, int wc, int fr, int fq) const {
#pragma unroll
    for (int ai = 0; ai < 2; ++ai)
#pragma unroll
      for (int m = 0; m < 4; ++m) { float* rowp = C + (size_t)(u.pm * BM + ai * HALF + wr * 64 + m * 16 + fr) * ldc + u.pn * BM + wc * 32 + 4 * fq;
#pragma unroll
        for (int bj = 0; bj < 2; ++bj)
#pragma unroll
          for (int n = 0; n < 2; ++n) *(f32x4*)(rowp + bj * HALF + n * 16) = acc[ai][bj][m][n]; }
  }
};

struct EpiHalfF32 {
  static constexpr bool PERM = false, AFTER_DRAIN = false;
  float* C;
  DI void operator()(const AccT& acc, const Unit& u, int wr, int wc, int fr, int fq) const {
#pragma unroll
    for (int ai = 0; ai < 2; ++ai)
#pragma unroll
      for (int m = 0; m < 4; ++m) { float* rowp = C + (size_t)(u.pm * BM + ai * HALF + wr * 64 + m * 16 + fr) * 128 + wc * 32 + 4 * fq;
#pragma unroll
        for (int n = 0; n < 2; ++n) *(f32x4*)(rowp + n * 16) = acc[ai][0][m][n]; }
  }
};

struct EpiGate {
  static constexpr bool PERM = true, AFTER_DRAIN = false;
  const bf16_t* h; float* tmp; bf16_t* merged;
  DI void operator()(const AccT& acc, const Unit& u, int wr, int wc, int fr, int fq) const {
#pragma unroll
    for (int ai = 0; ai < 2; ++ai)
#pragma unroll
      for (int m = 0; m < 4; ++m) {
        const int r = u.pm >> 5;
        const int row = (u.pm & 31) * BM + ai * HALF + wr * 64 + m * 16 + fr;
#pragma unroll
        for (int bj = 0; bj < 2; ++bj) {
          const int c8 = (u.pn & 7) * BM + bj * HALF + wc * 32 + 8 * fq;
          const bf16x8 gt = *(const bf16x8*)(h + (size_t)row * NPHYS + H_GL + r * 2048 + c8);
          bf16_t* mp = merged + (size_t)row * DM + c8;
          f32x4 a0 = acc[ai][bj][m][0], a1 = acc[ai][bj][m][1];
#pragma unroll
          for (int j = 0; j < 4; ++j) { a0[j] *= bf2f((bf16_t)gt[j]); a1[j] *= bf2f((bf16_t)gt[4 + j]); }
          if (r > 0) { const bf16x8 pv = *(const bf16x8*)mp;
#pragma unroll
            for (int j = 0; j < 4; ++j) { a0[j] += bf2f((bf16_t)pv[j]); a1[j] += bf2f((bf16_t)pv[4 + j]); } }
          { u32x4 w = {cvtpk(a0[0], a0[1]), cvtpk(a0[2], a0[3]), cvtpk(a1[0], a1[1]), cvtpk(a1[2], a1[3])}; *(u32x4*)mp = w; }
        }
      }
  }
};

struct EpiRes {
  static constexpr bool PERM = false, AFTER_DRAIN = false;
  const float* xin; const float* gv  ; float* z;
  DI void operator()(const AccT& acc, const Unit& u, int wr, int wc, int fr, int fq) const {
#pragma unroll
    for (int ai = 0; ai < 2; ++ai)
#pragma unroll
      for (int m = 0; m < 4; ++m) {
        const int row = u.pm * BM + ai * HALF + wr * 64 + m * 16 + fr, b = row >> 12;
#pragma unroll
        for (int bj = 0; bj < 2; ++bj)
#pragma unroll
          for (int n = 0; n < 2; ++n) { const int c = u.pn * BM + bj * HALF + wc * 32 + n * 16 + 4 * fq;
            const f32x4 xv = *(const f32x4*)(xin + (size_t)row * DM + c), g = *(const f32x4*)(gv + b * 12288 + c);
            f32x4 o; for (int j = 0; j < 4; ++j) o[j] = ALPHA * xv[j] + g[j] * acc[ai][bj][m][n][j];
            *(f32x4*)(z + (size_t)row * DM + c) = o; }
      }
  }
};


DI void ln_exchange(const AccT& acc, LAS float* red, float* stats, unsigned* cnt, int pm, int pn, int tid, int wr, int wc, int fr, int fq) {
#pragma unroll
  for (int ai = 0; ai < 2; ++ai)
#pragma unroll
    for (int m = 0; m < 4; ++m) {
      float s1 = 0.f, s2 = 0.f;
#pragma unroll
      for (int bj = 0; bj < 2; ++bj)
#pragma unroll
        for (int n = 0; n < 2; ++n)
#pragma unroll
          for (int j = 0; j < 4; ++j) { const float x = acc[ai][bj][m][n][j]; s1 += x; s2 += x * x; }
      s1 += __shfl_xor(s1, 16); s2 += __shfl_xor(s2, 16); s1 += __shfl_xor(s1, 32); s2 += __shfl_xor(s2, 32);
      if (fq == 0) { const int rl = ai * 128 + wr * 64 + m * 16 + fr; red[(rl * 4 + wc) * 2] = s1; red[(rl * 4 + wc) * 2 + 1] = s2; }
    }
  __syncthreads();
  if (tid < 256) { float a = 0.f, b = 0.f;
#pragma unroll
    for (int w = 0; w < 4; ++w) { a += red[(tid * 4 + w) * 2]; b += red[(tid * 4 + w) * 2 + 1]; }
    float* sp = stats + ((size_t)(pm * 256 + tid) * 8 + pn) * 2;
    __hip_atomic_store(sp, a, __ATOMIC_RELAXED, __HIP_MEMORY_SCOPE_AGENT); __hip_atomic_store(sp + 1, b, __ATOMIC_RELAXED, __HIP_MEMORY_SCOPE_AGENT); }
  asm volatile("s_waitcnt vmcnt(0)" ::: "memory");
  __syncthreads();
  if (tid == 0) {
    __builtin_amdgcn_fence(__ATOMIC_RELEASE, "agent");
    asm volatile("s_waitcnt vmcnt(0)" ::: "memory");
    __hip_atomic_fetch_add(cnt + pm, 1u, __ATOMIC_RELAXED, __HIP_MEMORY_SCOPE_AGENT);
    unsigned sp_ = 0;
    while (__hip_atomic_load(cnt + pm, __ATOMIC_RELAXED, __HIP_MEMORY_SCOPE_AGENT) < 8u) { __builtin_amdgcn_s_sleep(1); if (++sp_ > (1u << 24)) break; }
    __builtin_amdgcn_fence(__ATOMIC_ACQUIRE, "agent");
    asm volatile("s_waitcnt vmcnt(0)" ::: "memory");
  }
  __syncthreads();
  if (tid < 256) { float a = 0.f, b = 0.f; const float* sp = stats + (size_t)(pm * 256 + tid) * 16;
#pragma unroll
    for (int w = 0; w < 8; ++w) { a += __hip_atomic_load(sp + 2 * w, __ATOMIC_RELAXED, __HIP_MEMORY_SCOPE_AGENT); b += __hip_atomic_load(sp + 2 * w + 1, __ATOMIC_RELAXED, __HIP_MEMORY_SCOPE_AGENT); }
    const float mean = a * (1.f / DM), var = fmaxf(b * (1.f / DM) - mean * mean, 0.f);
    red[2048 + tid * 2] = mean; red[2048 + tid * 2 + 1] = rsqrtf(var + 1e-5f); }
  __syncthreads();
}

struct EpiLnFused {
  static constexpr bool PERM = false, AFTER_DRAIN = true;
  const float* xin; const float* gv; const float* gam; const float* bet; float* xout;
  const float* modn; int sh_idx, sc_idx; bf16_t* uout;
  float* stats; unsigned* cnt;
  DI void operator()(const AccT&, const Unit&, int, int, int, int) const {}
  DI void fused(AccT& acc, const Unit& u, LAS unsigned char* lds, int tid, int wr, int wc, int fr, int fq) const {
    LAS float* red = (LAS float*)lds;
    const int row0 = u.pm * BM + wr * 64 + fr, col0 = u.pn * BM + wc * 32 + 4 * fq, b = (u.pm * BM) >> 12;
    { f32x4 g[2][2], xc[2][2], xn[2][2];
#pragma unroll
      for (int bj = 0; bj < 2; ++bj)
#pragma unroll
        for (int n = 0; n < 2; ++n) g[bj][n] = *(const f32x4*)(gv + b * 12288 + col0 + bj * HALF + n * 16);
      { const float* xr = xin + (size_t)row0 * DM + col0;
#pragma unroll
        for (int bj = 0; bj < 2; ++bj)
#pragma unroll
          for (int n = 0; n < 2; ++n) xc[bj][n] = *(const f32x4*)(xr + bj * HALF + n * 16); }
#pragma unroll
      for (int k = 0; k < 8; ++k) { const int ai = k >> 2, m = k & 3;
        if (k < 7) { const int k1 = k + 1; const float* xr = xin + (size_t)(row0 + (k1 >> 2) * HALF + (k1 & 3) * 16) * DM + col0; asm volatile("" : "+v"(xr));
#pragma unroll
          for (int bj = 0; bj < 2; ++bj)
#pragma unroll
            for (int n = 0; n < 2; ++n) xn[bj][n] = *(const f32x4*)(xr + bj * HALF + n * 16); }
#pragma unroll
        for (int bj = 0; bj < 2; ++bj)
#pragma unroll
          for (int n = 0; n < 2; ++n)
#pragma unroll
            for (int j = 0; j < 4; ++j) acc[ai][bj][m][n][j] = ALPHA * xc[bj][n][j] + g[bj][n][j] * acc[ai][bj][m][n][j];
        asm volatile("" :: "v"(acc[ai][0][m][0]), "v"(acc[ai][0][m][1]), "v"(acc[ai][1][m][0]), "v"(acc[ai][1][m][1]));
#pragma unroll
        for (int bj = 0; bj < 2; ++bj)
#pragma unroll
          for (int n = 0; n < 2; ++n) xc[bj][n] = xn[bj][n]; } }
    ln_exchange(acc, red, stats, cnt, u.pm, u.pn, tid, wr, wc, fr, fq);
    { f32x4 g[2][2], bb[2][2];
#pragma unroll
      for (int bj = 0; bj < 2; ++bj)
#pragma unroll
        for (int n = 0; n < 2; ++n) { g[bj][n] = *(const f32x4*)(gam + col0 + bj * HALF + n * 16); bb[bj][n] = *(const f32x4*)(bet + col0 + bj * HALF + n * 16); }
#pragma unroll
      for (int ai = 0; ai < 2; ++ai)
#pragma unroll
        for (int m = 0; m < 4; ++m) { const int rl = ai * 128 + wr * 64 + m * 16 + fr; const float mean = red[2048 + rl * 2], rstd = red[2048 + rl * 2 + 1];
          float* xo = xout + (size_t)(u.pm * BM + rl) * DM + col0;
#pragma unroll
          for (int bj = 0; bj < 2; ++bj)
#pragma unroll
            for (int n = 0; n < 2; ++n) { f32x4 o;
#pragma unroll
              for (int j = 0; j < 4; ++j) { o[j] = (acc[ai][bj][m][n][j] - mean) * rstd * g[bj][n][j] + bb[bj][n][j]; acc[ai][bj][m][n][j] = o[j]; }
              *(f32x4*)(xo + bj * HALF + n * 16) = o; } } }
    if (uout) {
      __syncthreads();
      ln_exchange(acc, red, stats + (size_t)32 * 256 * 16, cnt + 32, u.pm, u.pn, tid, wr, wc, fr, fq);
      f32x4 sc[2][2], sh[2][2];
#pragma unroll
      for (int bj = 0; bj < 2; ++bj)
#pragma unroll
        for (int n = 0; n < 2; ++n) { sc[bj][n] = *(const f32x4*)(modn + b * 12288 + sc_idx * 2048 + col0 + bj * HALF + n * 16); sh[bj][n] = *(const f32x4*)(modn + b * 12288 + sh_idx * 2048 + col0 + bj * HALF + n * 16); }
#pragma unroll
      for (int ai = 0; ai < 2; ++ai)
#pragma unroll
        for (int m = 0; m < 4; ++m) { const int rl = ai * 128 + wr * 64 + m * 16 + fr; const float mean = red[2048 + rl * 2], rstd = red[2048 + rl * 2 + 1];
          bf16_t* uo = uout + (size_t)(u.pm * BM + rl) * DM + col0;
#pragma unroll
          for (int bj = 0; bj < 2; ++bj)
#pragma unroll
            for (int n = 0; n < 2; ++n) { float o[4];
#pragma unroll
              for (int j = 0; j < 4; ++j) o[j] = (acc[ai][bj][m][n][j] - mean) * rstd * (1.f + sc[bj][n][j]) + sh[bj][n][j];
              *(u32x2*)(uo + bj * HALF + n * 16) = (u32x2){cvtpk(o[0], o[1]), cvtpk(o[2], o[3])}; } }
    }
    __syncthreads();
  }
};

struct EpiSwiglu {
  static constexpr bool PERM = false, AFTER_DRAIN = false;
  bf16_t* hid;
  DI void operator()(const AccT& acc, const Unit& u, int wr, int wc, int fr, int fq) const {
#pragma unroll
    for (int ai = 0; ai < 2; ++ai)
#pragma unroll
      for (int m = 0; m < 4; ++m) {
        const int row = u.pm * BM + ai * HALF + wr * 64 + m * 16 + fr;
#pragma unroll
        for (int bj = 0; bj < 2; ++bj) { const int hc = (u.pn * BM + bj * HALF + wc * 32) / 2 + 4 * fq;
          const f32x4 g = acc[ai][bj][m][0], up = acc[ai][bj][m][1];
          float o[4]; for (int j = 0; j < 4; ++j) o[j] = silu(g[j]) * up[j];
          *(u32x2*)(hid + (size_t)row * DFF + hc) = (u32x2){cvtpk(o[0], o[1]), cvtpk(o[2], o[3])}; }
      }
  }
};

DI int fetch_item(unsigned* ctr0, int* slot) {
  __syncthreads();
  unsigned long long ca = (unsigned long long)ctr0; asm volatile("" : "+s"(ca));
  unsigned* ctr = (unsigned*)ca;
  if (ltid() == 0) *slot = (int)atomicAdd(ctr, 1u);
  __syncthreads();
  return *slot;
}

DI void idxsel_phase(unsigned char* lds, const bf16_t* __restrict__ hbuf, const bf16_t* __restrict__ ikn, const float* __restrict__ iwf, u64* __restrict__ bits, unsigned* ctr) {
  const int tid = ltid(), wid = tid >> 6, lane = tid & 63, i32 = lane & 31, kh = lane >> 5;
  int* slot = (int*)(lds + SLOT_OFF);
  LAS float* sc_l = (LAS float*)(LAS unsigned char*)lds;
  const int qi = (i32 >> 2) & 1, hd = (i32 & 3) + 4 * (i32 >> 3);
  for (;;) {
    const int it = fetch_item(ctr, slot);
    if (it >= 1024) break;
    const int b = it & 1, jq = 511 - (it >> 1), t0 = b * SL + 8 * jq, ntile = (8 * jq + 8 + 31) >> 5;
    { bf16x8 a[4][4]; f32x4 w[4][4];
#pragma unroll
      for (int u = 0; u < 4; ++u) {
        const bf16_t* ap = hbuf + (size_t)(t0 + 2 * u + qi) * NPHYS + H_IQ + hd * 64 + kh * 8;
        const float* wp = iwf + (size_t)(t0 + 2 * u + kh) * 16;
#pragma unroll
        for (int ks = 0; ks < 4; ++ks) { a[u][ks] = *(const bf16x8*)(ap + ks * 16); w[u][ks] = *(const f32x4*)(wp + 4 * ks); }
      }
      if (wid < ntile) {
        const bf16_t* kp = ikn + (size_t)(b * SL + 32 * wid + i32) * 64 + kh * 8;
        bf16x8 nb[4];
#pragma unroll
        for (int ks = 0; ks < 4; ++ks) nb[ks] = *(const bf16x8*)(kp + ks * 16);
        for (int kt = wid; kt < ntile; kt += 8) {
          bf16x8 bfr[4];
#pragma unroll
          for (int ks = 0; ks < 4; ++ks) bfr[ks] = nb[ks];
          if (kt + 8 < ntile) { kp += 8 * 32 * 64;
#pragma unroll
            for (int ks = 0; ks < 4; ++ks) nb[ks] = *(const bf16x8*)(kp + ks * 16); }
#pragma unroll
          for (int u = 0; u < 4; ++u) {
            f32x16 acc = {};
#pragma unroll
            for (int ks = 0; ks < 4; ++ks) acc = __builtin_amdgcn_mfma_f32_32x32x16_bf16(a[u][ks], bfr[ks], acc, 0, 0, 0);
            float sc = 0.f;
#pragma unroll
            for (int r4 = 0; r4 < 4; ++r4)
#pragma unroll
              for (int jj = 0; jj < 4; ++jj) sc += fmaxf(acc[4 * r4 + jj], 0.f) * w[u][r4][jj];
            sc_l[(2 * u + kh) * 4096 + 32 * kt + i32] = sc;
          }
        }
      }
    }
    __syncthreads();
    { const int t = 8 * jq + wid, row = t0 + wid;
      const LAS float* sr = sc_l + wid * 4096;
      unsigned key[64];
#pragma unroll
      for (int i = 0; i < 64; ++i) { const int sidx = 64 * i + lane; unsigned k = 0;
        if (sidx <= t) { const unsigned uu = __float_as_uint(sr[sidx]); k = (uu & 0x80000000u) ? ~uu : (uu | 0x80000000u); }
        key[i] = k; }
      unsigned thr = 0;
      if (t + 1 > 256) {
        for (int bit = 31; bit >= 0; --bit) {
          const unsigned cand = thr | (1u << bit);
          int cnt = 0;
#pragma unroll
          for (int i = 0; i < 64; ++i) cnt += __popcll(__ballot(key[i] >= cand));
          if (cnt >= 256) thr = cand;
          if (cnt == 256) break;
        }
      }
      u64 mine = 0;
#pragma unroll
      for (int i = 0; i < 64; ++i) { const int sidx = 64 * i + lane; const u64 wv = __ballot(sidx <= t && key[i] >= thr); if (lane == i) mine = wv; }
      bits[(size_t)row * 64 + lane] = mine;
    }
  }
}

enum { M_CAUSAL = 0, M_WINDOW = 1, M_BITS = 2, M_SLC = 3, M_CMP = 4 };
DI u64 cmask(int n) { return n >= 64 ? ~0ull : (n <= 0 ? 0ull : ((1ull << n) - 1ull)); }

template <int MODE, int DV>
DI void attn_core(LAS unsigned char* lds, const bf16_t* __restrict__ Qp, int ldq, const bf16_t* __restrict__ Kp, int ldk, const bf16_t* __restrict__ Vtp, int ldv,
                  int tq0, int jt_lo, int jt_hi, const u64* __restrict__ mk, float* __restrict__ pdump, f32x16 (&o)[DV / 32], float& m_out, float& l_out) {
  constexpr int ND = DV / 32, VBYTES = DV * 136, KBAT = DV == 256 ? 1 : 4, VBAT = DV == 256 ? 1 : 2;
  const int tid = ltid(), wid = tid >> 6, lane = tid & 63, r32 = lane & 31, hi = lane >> 5;
  const int tq = tq0 + wid * 32 + r32;
  constexpr int NQR = DV == 256 ? 4 : 8;
  const bf16_t* qlane = Qp + (size_t)(wid * 32 + r32) * ldq + hi * 8;
  bf16x8 qr[NQR];
#pragma unroll
  for (int d0 = 0; d0 < NQR; ++d0) qr[d0] = *(const bf16x8*)(qlane + d0 * 16);
  LAS float* wsc = (LAS float*)(lds + 34816 + 2 * VBYTES) + wid * 64;
  const int krow = tid >> 3, kc16 = tid & 7, vrow = tid >> 2, vc = tid & 3;
  bf16x8 sk0, sk1, sv0, sv1;
#define AT_LOAD_K(jt) do { const bf16_t* kp_ = Kp + (size_t)((jt) * 64 + krow) * ldk + kc16 * 8; sk0 = *(const bf16x8*)kp_; sk1 = *(const bf16x8*)(kp_ + 64); } while (0)
#define AT_LOAD_V(jt, half) do { const bf16_t* vp_ = Vtp + (size_t)(vrow + 128 * (half)) * ldv + (jt) * 64 + vc * 8; sv0 = *(const bf16x8*)vp_; sv1 = *(const bf16x8*)(vp_ + 32); } while (0)
#define AT_WRITE_K(buf) do { LAS unsigned char* kb_ = lds + (buf) * 17408 + krow * 272 + kc16 * 16; *(LAS bf16x8*)kb_ = sk0; *(LAS bf16x8*)(kb_ + 128) = sk1; } while (0)
#define AT_WRITE_V(buf, half) do { LAS unsigned char* vb_ = lds + 34816 + (buf) * VBYTES + (vrow + 128 * (half)) * 136 + vc * 16; \
    *(LAS s16x4*)vb_ = __builtin_shufflevector(sv0, sv0, 0, 1, 2, 3); *(LAS s16x4*)(vb_ + 8) = __builtin_shufflevector(sv0, sv0, 4, 5, 6, 7); \
    *(LAS s16x4*)(vb_ + 64) = __builtin_shufflevector(sv1, sv1, 0, 1, 2, 3); *(LAS s16x4*)(vb_ + 72) = __builtin_shufflevector(sv1, sv1, 4, 5, 6, 7); } while (0)
  float m_reg = -1e30f, l_reg = 0.f;
#pragma unroll
  for (int d = 0; d < ND; ++d) o[d] = (f32x16){};
  u64 selw = 0;
  if (MODE == M_SLC) selw = mk[wid * 32 + r32];
  const int tcmp = tq >= 31 ? ((tq - 31) >> 4) : -1;
  const bool trail_ = __builtin_amdgcn_readfirstlane(wid) >= 4;
  if (trail_) __builtin_amdgcn_s_setprio(1);
  AT_LOAD_K(jt_lo); AT_LOAD_V(jt_lo, 0); AT_WRITE_K(0); AT_WRITE_V(0, 0);
  if (DV == 256) { AT_LOAD_V(jt_lo, 1); AT_WRITE_V(0, 1); }
  __syncthreads();
  int cur = 0;
  for (int jt = jt_lo; jt < jt_hi; ++jt) {
    const bool pre = jt + 1 < jt_hi;
    bf16x8 qx[4];
    if (DV == 256) { const bf16_t* q2 = qlane; asm volatile("" : "+v"(q2));
#pragma unroll
      for (int u = 0; u < 4; ++u) qx[u] = *(const bf16x8*)(q2 + (4 + u) * 16); }
    if (pre) { AT_LOAD_K(jt + 1); AT_LOAD_V(jt + 1, 0); }
    const int kb = jt * 64;
    u64 allow;
    if (MODE == M_CAUSAL) allow = cmask(tq - kb + 1);
    else if (MODE == M_WINDOW) allow = cmask(tq - kb + 1) & ~cmask(tq - 512 - kb + 1);
    else if (MODE == M_BITS) allow = mk[(size_t)(wid * 32 + r32) * 64 + jt] & cmask(tq - kb + 1);
    else if (MODE == M_SLC) allow = ((selw >> jt) & 1ull) ? cmask(tq - kb + 1) : 0ull;
    else allow = cmask(tcmp - kb + 1);
    const bool act = MODE == M_CMP || __any(allow != 0ull);
    bf16x8 pa[4];
    if (act) {
      const LAS unsigned char* Kb = lds + cur * 17408 + r32 * 272 + hi * 16;
      f32x16 p0 = {}, p1 = {};
#pragma unroll
      for (int db = 0; db < 8; db += KBAT) { bf16x8 ka[KBAT], kc[KBAT];
#pragma unroll
        for (int u = 0; u < KBAT; ++u) { ka[u] = *(const LAS bf16x8*)(Kb + (db + u) * 32); kc[u] = *(const LAS bf16x8*)(Kb + 32 * 272 + (db + u) * 32); }
        __builtin_amdgcn_sched_barrier(0);
#pragma unroll
        for (int u = 0; u < KBAT; ++u) { const int d0 = db + u; const bf16x8 qf = d0 < NQR ? qr[d0 < NQR ? d0 : 0] : qx[d0 >= NQR ? d0 - NQR : 0];
          p0 = __builtin_amdgcn_mfma_f32_32x32x16_bf16(ka[u], qf, p0, 0, 0, 0);
          p1 = __builtin_amdgcn_mfma_f32_32x32x16_bf16(kc[u], qf, p1, 0, 0, 0); }
        __builtin_amdgcn_sched_barrier(0); }
      if (pre) AT_WRITE_K(cur ^ 1);
      if (!__all(allow == ~0ull)) {
        const u64 a = ~(allow >> (4 * hi)); const int nlo = (int)(unsigned)a, nhw = (int)(unsigned)(a >> 32);
#pragma unroll
        for (int r = 0; r < 16; ++r) { const int cp = (r & 3) + 8 * (r >> 2);
          const unsigned b0 = ((unsigned)((nlo << (31 - cp)) >> 31) & 0x80000000u) | 0x7f800000u, b1 = ((unsigned)((nhw << (31 - cp)) >> 31) & 0x80000000u) | 0x7f800000u;
          p0[r] = vmin_raw(p0[r], __uint_as_float(b0)); p1[r] = vmin_raw(p1[r], __uint_as_float(b1)); }
      }
      if (MODE == M_CMP) {
        float* pr = pdump + (size_t)(wid * 32 + r32) * 256 + kb + 4 * hi;
#pragma unroll
        for (int g4 = 0; g4 < 4; ++g4) { *(f32x4*)(pr + 8 * g4) = (f32x4){p0[4 * g4], p0[4 * g4 + 1], p0[4 * g4 + 2], p0[4 * g4 + 3]};
          *(f32x4*)(pr + 32 + 8 * g4) = (f32x4){p1[4 * g4], p1[4 * g4 + 1], p1[4 * g4 + 2], p1[4 * g4 + 3]}; }
      }
      float mx = p0[0];
#pragma unroll
      for (int r = 1; r < 16; ++r) mx = fmaxf(mx, p0[r]);
#pragma unroll
      for (int r = 0; r < 16; ++r) mx = fmaxf(mx, p1[r]);
      mx = fmaxf(mx, __shfl_xor(mx, 32));
      float mn = m_reg, alpha = 1.f;
      if (!__all((mx - m_reg) * C2 <= 8.f)) { mn = fmaxf(m_reg, mx); alpha = __builtin_amdgcn_exp2f((m_reg - mn) * C2); m_reg = mn; }
      const float nm = -mn * C2;
      float ps = 0.f;
#pragma unroll
      for (int r = 0; r < 16; ++r) { p0[r] = __builtin_amdgcn_exp2f(fmaf(p0[r], C2, nm)); p1[r] = __builtin_amdgcn_exp2f(fmaf(p1[r], C2, nm)); ps += p0[r] + p1[r]; }
      ps += __shfl_xor(ps, 32);
      l_reg = l_reg * alpha + ps;
      if (__any(alpha < 1.f)) {
        if (hi == 0) wsc[r32] = alpha;
        asm volatile("s_waitcnt lgkmcnt(0)" ::: "memory");
#pragma unroll
        for (int r = 0; r < 16; ++r) { const float al = wsc[crow(r, hi)];
#pragma unroll
          for (int d = 0; d < ND; ++d) o[d][r] *= al; }
        asm volatile("s_waitcnt lgkmcnt(0)" ::: "memory");
      }
      { u32x4 w;
        w = (u32x4){cvtpk(p0[0], p0[1]), cvtpk(p0[2], p0[3]), cvtpk(p0[4], p0[5]), cvtpk(p0[6], p0[7])}; pa[0] = *reinterpret_cast<bf16x8*>(&w);
        w = (u32x4){cvtpk(p0[8], p0[9]), cvtpk(p0[10], p0[11]), cvtpk(p0[12], p0[13]), cvtpk(p0[14], p0[15])}; pa[1] = *reinterpret_cast<bf16x8*>(&w);
        w = (u32x4){cvtpk(p1[0], p1[1]), cvtpk(p1[2], p1[3]), cvtpk(p1[4], p1[5]), cvtpk(p1[6], p1[7])}; pa[2] = *reinterpret_cast<bf16x8*>(&w);
        w = (u32x4){cvtpk(p1[8], p1[9]), cvtpk(p1[10], p1[11]), cvtpk(p1[12], p1[13]), cvtpk(p1[14], p1[15])}; pa[3] = *reinterpret_cast<bf16x8*>(&w); }
    }
    if (pre && !act) AT_WRITE_K(cur ^ 1);
    if (DV == 256 && pre) { AT_WRITE_V(cur ^ 1, 0); AT_LOAD_V(jt + 1, 1); }
    if (act) {
      const LAS unsigned char* Vb = lds + 34816 + cur * VBYTES + r32 * 136 + hi * 8;
#pragma unroll
      for (int dbb = 0; dbb < ND; dbb += VBAT) { bf16x8 vf[VBAT * 4];
#pragma unroll
        for (int u = 0; u < VBAT; ++u)
#pragma unroll
          for (int s = 0; s < 4; ++s) { const int d = dbb + u; const s16x4 lo4 = *(const LAS s16x4*)(Vb + d * 32 * 136 + s * 32), hi4 = *(const LAS s16x4*)(Vb + d * 32 * 136 + s * 32 + 16);
            vf[u * 4 + s] = __builtin_shufflevector(lo4, hi4, 0, 1, 2, 3, 4, 5, 6, 7); }
        __builtin_amdgcn_sched_barrier(0);
#pragma unroll
        for (int u = 0; u < VBAT; ++u)
#pragma unroll
          for (int s = 0; s < 4; ++s) o[dbb + u] = __builtin_amdgcn_mfma_f32_32x32x16_bf16(pa[s], vf[u * 4 + s], o[dbb + u], 0, 0, 0);
        __builtin_amdgcn_sched_barrier(0); }
    }
    if (pre) { AT_WRITE_V(cur ^ 1, DV == 256 ? 1 : 0); }
    __syncthreads();
    cur ^= 1;
  }
  if (trail_) __builtin_amdgcn_s_setprio(0);
  if (hi == 0) wsc[r32] = l_reg;
  asm volatile("s_waitcnt lgkmcnt(0)" ::: "memory");
#pragma unroll
  for (int r = 0; r < 16; ++r) { const float lr = wsc[crow(r, hi)]; const float inv = lr > 0.f ? 1.f / lr : 0.f;
#pragma unroll
    for (int d = 0; d < ND; ++d) o[d][r] *= inv; }
  asm volatile("s_waitcnt lgkmcnt(0)" ::: "memory");
  m_out = m_reg; l_out = l_reg;
#undef AT_LOAD_K
#undef AT_LOAD_V
#undef AT_WRITE_K
#undef AT_WRITE_V
}


template <int MODE>
DI void attn_core_skew(LAS unsigned char* lds, const bf16_t* __restrict__ Qp, int ldq, const bf16_t* __restrict__ Kp, int ldk, const bf16_t* __restrict__ Vtp, int ldv,
                       int tq0, int jt_lo, int jt_hi, const u64* __restrict__ mk, float* __restrict__ pdump, f32x16 (&o)[4], float& m_out, float& l_out) {
  const int tid = ltid(), wid = tid >> 6, lane = tid & 63, r32 = lane & 31, hi = lane >> 5;
  const bool lead = __builtin_amdgcn_readfirstlane(wid) < 4;
  if (!lead) __builtin_amdgcn_s_setprio(1);
  const int tq = tq0 + wid * 32 + r32;
  const bf16_t* qlane = Qp + (size_t)(wid * 32 + r32) * ldq + hi * 8;
  bf16x8 qr[8];
#pragma unroll
  for (int d0 = 0; d0 < 8; ++d0) qr[d0] = *(const bf16x8*)(qlane + d0 * 16);
  LAS float* wsc = (LAS float*)(lds + 34816 + 2 * 17408) + wid * 64;
  const int st = tid & 255, krow = st >> 4, kch = st & 15, vrow = st >> 3, vch = st & 7;
  bf16x8 sgc[4], sgn[4];
#define SK_BAR() do { asm volatile("s_waitcnt lgkmcnt(0)" ::: "memory"); __builtin_amdgcn_s_barrier(); asm volatile("" ::: "memory"); } while (0)
#define SK_LOAD(sg, jt) do { if (lead) { const bf16_t* kp_ = Kp + (size_t)((jt) * 64 + krow) * ldk + kch * 8; \
      _Pragma("unroll") for (int i_ = 0; i_ < 4; ++i_) sg[i_] = *(const bf16x8*)(kp_ + (size_t)(16 * i_) * ldk); } \
    else { const bf16_t* vp_ = Vtp + (size_t)vrow * ldv + (jt) * 64 + vch * 8; \
      _Pragma("unroll") for (int i_ = 0; i_ < 4; ++i_) sg[i_] = *(const bf16x8*)(vp_ + (size_t)(32 * i_) * ldv); } } while (0)
#define SK_WRITE(sg, buf) do { if (lead) { LAS unsigned char* kb_ = lds + (buf) * 17408 + krow * 272 + kch * 16; \
      _Pragma("unroll") for (int i_ = 0; i_ < 4; ++i_) *(LAS bf16x8*)(kb_ + i_ * 16 * 272) = sg[i_]; } \
    else { LAS unsigned char* vb_ = lds + 34816 + (buf) * 17408 + vrow * 136 + vch * 16; \
      _Pragma("unroll") for (int i_ = 0; i_ < 4; ++i_) { *(LAS s16x4*)(vb_ + i_ * 32 * 136) = __builtin_shufflevector(sg[i_], sg[i_], 0, 1, 2, 3); \
        *(LAS s16x4*)(vb_ + i_ * 32 * 136 + 8) = __builtin_shufflevector(sg[i_], sg[i_], 4, 5, 6, 7); } } } while (0)
  float m_reg = -1e30f, l_reg = 0.f;
#pragma unroll
  for (int d = 0; d < 4; ++d) o[d] = (f32x16){};
  u64 selw = 0;
  if (MODE == M_SLC) selw = mk[wid * 32 + r32];
  const int tcmp = tq >= 31 ? ((tq - 31) >> 4) : -1;
  const u64* mrow = mk + (size_t)(wid * 32 + r32) * 64;
  u64 bw = 0; if (MODE == M_BITS) bw = mrow[jt_lo];
  SK_LOAD(sgc, jt_lo); SK_WRITE(sgc, 0);
  if (jt_lo + 1 < jt_hi) SK_LOAD(sgc, jt_lo + 1);
  SK_BAR();
  if (!lead) SK_BAR();
  int cur = 0;
  for (int jt = jt_lo; jt < jt_hi; ++jt) {
    const bool pre = jt + 1 < jt_hi;
    if (jt + 2 < jt_hi) SK_LOAD(sgn, jt + 2);
    u64 bwn = 0; if (MODE == M_BITS && pre) bwn = mrow[jt + 1];
    const int kb = jt * 64;
    u64 allow;
    if (MODE == M_CAUSAL) allow = cmask(tq - kb + 1);
    else if (MODE == M_WINDOW) allow = cmask(tq - kb + 1) & ~cmask(tq - 512 - kb + 1);
    else if (MODE == M_BITS) allow = bw & cmask(tq - kb + 1);
    else if (MODE == M_SLC) allow = ((selw >> jt) & 1ull) ? cmask(tq - kb + 1) : 0ull;
    else allow = cmask(tcmp - kb + 1);
    const bool act = MODE == M_CMP || __any(allow != 0ull);
    f32x16 p0, p1;
    float alpha;
    if (act) {
      alpha = 1.f;
      const LAS unsigned char* Kb = lds + cur * 17408 + r32 * 272 + hi * 16;
#pragma unroll
      for (int db = 0; db < 8; db += 4) { bf16x8 ka[4], kc[4];
#pragma unroll
        for (int u = 0; u < 4; ++u) { ka[u] = *(const LAS bf16x8*)(Kb + (db + u) * 32); kc[u] = *(const LAS bf16x8*)(Kb + 32 * 272 + (db + u) * 32); }
        __builtin_amdgcn_sched_barrier(0);
#pragma unroll
        for (int u = 0; u < 4; ++u) { const f32x16 z = {};
          p0 = __builtin_amdgcn_mfma_f32_32x32x16_bf16(ka[u], qr[db + u], (db + u == 0) ? z : p0, 0, 0, 0);
          p1 = __builtin_amdgcn_mfma_f32_32x32x16_bf16(kc[u], qr[db + u], (db + u == 0) ? z : p1, 0, 0, 0); }
        __builtin_amdgcn_sched_barrier(0); }
      if (!__all(allow == ~0ull)) {
        const u64 a = ~(allow >> (4 * hi)); const int nlo = (int)(unsigned)a, nhw = (int)(unsigned)(a >> 32);
#pragma unroll
        for (int r = 0; r < 16; ++r) { const int cp = (r & 3) + 8 * (r >> 2);
          const unsigned b0 = ((unsigned)((nlo << (31 - cp)) >> 31) & 0x80000000u) | 0x7f800000u, b1 = ((unsigned)((nhw << (31 - cp)) >> 31) & 0x80000000u) | 0x7f800000u;
          p0[r] = vmin_raw(p0[r], __uint_as_float(b0)); p1[r] = vmin_raw(p1[r], __uint_as_float(b1)); }
      }
      if (MODE == M_CMP && __any(allow != 0ull)) {
        LAS float* pw = (LAS float*)(lds + PD_OFF + wid * 8704);
#pragma unroll
        for (int g4 = 0; g4 < 4; ++g4) { *(LAS f32x4*)(pw + r32 * 68 + 8 * g4 + 4 * hi) = (f32x4){p0[4 * g4], p0[4 * g4 + 1], p0[4 * g4 + 2], p0[4 * g4 + 3]};
          *(LAS f32x4*)(pw + r32 * 68 + 32 + 8 * g4 + 4 * hi) = (f32x4){p1[4 * g4], p1[4 * g4 + 1], p1[4 * g4 + 2], p1[4 * g4 + 3]}; }
        asm volatile("s_waitcnt lgkmcnt(0)" ::: "memory");
#pragma unroll
        for (int i = 0; i < 8; ++i) { const int c = i * 64 + lane, row = c >> 4, c16 = c & 15;
          *(f32x4*)(pdump + (size_t)(wid * 32 + row) * 256 + kb + c16 * 4) = *(const LAS f32x4*)(pw + row * 68 + c16 * 4);
        }
      }
      float mx = p0[0];
#pragma unroll
      for (int r = 1; r < 16; ++r) mx = fmaxf(mx, p0[r]);
#pragma unroll
      for (int r = 0; r < 16; ++r) mx = fmaxf(mx, p1[r]);
      mx = fmaxf(mx, __shfl_xor(mx, 32));
      float mn = m_reg;
      if (!__all((mx - m_reg) * C2 <= 8.f)) { mn = fmaxf(m_reg, mx); alpha = __builtin_amdgcn_exp2f((m_reg - mn) * C2); m_reg = mn; }
      const float nm = -mn * C2;
#pragma unroll
      for (int r = 0; r < 16; ++r) { p0[r] = __builtin_amdgcn_exp2f(fmaf(p0[r], C2, nm)); p1[r] = __builtin_amdgcn_exp2f(fmaf(p1[r], C2, nm)); }
    }
    SK_BAR();
    if (act) {
      float ps = 0.f;
#pragma unroll
      for (int r = 0; r < 16; ++r) ps += p0[r] + p1[r];
      ps += __shfl_xor(ps, 32);
      l_reg = l_reg * alpha + ps;
      if (__any(alpha < 1.f)) {
        if (hi == 0) wsc[r32] = alpha;
        asm volatile("s_waitcnt lgkmcnt(0)" ::: "memory");
#pragma unroll
        for (int r = 0; r < 16; ++r) { const float al = wsc[crow(r, hi)];
#pragma unroll
          for (int d = 0; d < 4; ++d) o[d][r] *= al; }
        asm volatile("s_waitcnt lgkmcnt(0)" ::: "memory");
      }
      bf16x8 pa[4];
      { u32x4 w;
        w = (u32x4){cvtpk(p0[0], p0[1]), cvtpk(p0[2], p0[3]), cvtpk(p0[4], p0[5]), cvtpk(p0[6], p0[7])}; pa[0] = *reinterpret_cast<bf16x8*>(&w);
        w = (u32x4){cvtpk(p0[8], p0[9]), cvtpk(p0[10], p0[11]), cvtpk(p0[12], p0[13]), cvtpk(p0[14], p0[15])}; pa[1] = *reinterpret_cast<bf16x8*>(&w);
        w = (u32x4){cvtpk(p1[0], p1[1]), cvtpk(p1[2], p1[3]), cvtpk(p1[4], p1[5]), cvtpk(p1[6], p1[7])}; pa[2] = *reinterpret_cast<bf16x8*>(&w);
        w = (u32x4){cvtpk(p1[8], p1[9]), cvtpk(p1[10], p1[11]), cvtpk(p1[12], p1[13]), cvtpk(p1[14], p1[15])}; pa[3] = *reinterpret_cast<bf16x8*>(&w); }
      const LAS unsigned char* Vb = lds + 34816 + cur * 17408 + r32 * 136 + hi * 8;
#pragma unroll
      for (int dbb = 0; dbb < 4; dbb += 2) { bf16x8 vf[8];
#pragma unroll
        for (int u = 0; u < 2; ++u)
#pragma unroll
          for (int s4 = 0; s4 < 4; ++s4) { const int d = dbb + u; const s16x4 lo4 = *(const LAS s16x4*)(Vb + d * 32 * 136 + s4 * 32), hi4 = *(const LAS s16x4*)(Vb + d * 32 * 136 + s4 * 32 + 16);
            vf[u * 4 + s4] = __builtin_shufflevector(lo4, hi4, 0, 1, 2, 3, 4, 5, 6, 7); }
        __builtin_amdgcn_sched_barrier(0);
#pragma unroll
        for (int u = 0; u < 2; ++u)
#pragma unroll
          for (int s4 = 0; s4 < 4; ++s4) o[dbb + u] = __builtin_amdgcn_mfma_f32_32x32x16_bf16(pa[s4], vf[u * 4 + s4], o[dbb + u], 0, 0, 0);
        __builtin_amdgcn_sched_barrier(0); }
    }
    if (pre) SK_WRITE(sgc, cur ^ 1);
    SK_BAR();
    cur ^= 1; bw = bwn;
#pragma unroll
    for (int i_ = 0; i_ < 4; ++i_) sgc[i_] = sgn[i_];
  }
  if (lead) SK_BAR();
  if (!lead) __builtin_amdgcn_s_setprio(0);
  if (hi == 0) wsc[r32] = l_reg;
  asm volatile("s_waitcnt lgkmcnt(0)" ::: "memory");
#pragma unroll
  for (int r = 0; r < 16; ++r) { const float lr = wsc[crow(r, hi)]; const float inv = lr > 0.f ? 1.f / lr : 0.f;
#pragma unroll
    for (int d = 0; d < 4; ++d) o[d][r] *= inv; }
  asm volatile("s_waitcnt lgkmcnt(0)" ::: "memory");
  m_out = m_reg; l_out = l_reg;
#undef SK_BAR
#undef SK_LOAD
#undef SK_WRITE
}

DI void store_o_bf16(LAS unsigned char* lds, bf16_t* dst, int rowg0, int hcol, const f32x16 (&o)[4]) {
  const int tid_ = ltid(), lane = tid_ & 63, wid = tid_ >> 6, r32 = lane & 31, hi = lane >> 5;
  LAS unsigned char* pw = lds + wid * 8704;
#pragma unroll
  for (int r = 0; r < 16; ++r)
#pragma unroll
    for (int d = 0; d < 4; ++d) *(LAS bf16_t*)(pw + crow(r, hi) * 272 + (d * 32 + r32) * 2) = f2bf(o[d][r]);
  asm volatile("s_waitcnt lgkmcnt(0)" ::: "memory");
#pragma unroll
  for (int i = 0; i < 8; ++i) { const int c = i * 64 + lane, row = c >> 4, c16 = c & 15;
    *(u32x4*)(dst + (size_t)(rowg0 + wid * 32 + row) * 1024 + hcol + c16 * 8) = *(const LAS u32x4*)(pw + row * 272 + c16 * 16); }
  asm volatile("s_waitcnt lgkmcnt(0)" ::: "memory");
}

#define XB_TMO      128
#define XB_XCNT(j)  (256  + 64 * (j))
#define XB_XSUB(j)  (1280 + 64 * (j))
#define XB_XGEN(j)  (2304 + 64 * (j))
#define XB_TOP      3328
#define XB_TOPGEN   3392
#define XCD_BAR_WORDS 3456
#define XB_SPIN_CAP (1u << 22)
DI unsigned xb_ld(unsigned* p)              { return __hip_atomic_load(p, __ATOMIC_RELAXED, __HIP_MEMORY_SCOPE_AGENT); }
DI unsigned xb_add(unsigned* p, unsigned v) { return __hip_atomic_fetch_add(p, v, __ATOMIC_RELAXED, __HIP_MEMORY_SCOPE_AGENT); }
DI unsigned xb_xcc_id() { return (unsigned)__builtin_amdgcn_s_getreg((3 << 11) | 20) & 0xFu; }
#define XB_SPIN(cond, bar) do { unsigned _sp = 0; while (cond) { __builtin_amdgcn_s_sleep(1); \
    if ((++_sp & 255u) == 0u) { if (xb_ld(&(bar)[XB_TMO])) break; if (_sp > XB_SPIN_CAP) { atomicAdd(&(bar)[XB_TMO], 1u); break; } } } } while (0)
struct XcdBarrier { unsigned* bar; unsigned x; volatile LAS unsigned* st; };
DI XcdBarrier xcd_barrier_post(unsigned* bar, volatile LAS unsigned* st) {
  XcdBarrier b; b.bar = bar; b.x = xb_xcc_id(); b.st = st;
  if (threadIdx.x == 0) (void)xb_add(&bar[XB_XCNT(b.x)], 1u);
  return b;
}
DI void xcd_barrier_complete(unsigned* bar, unsigned x, unsigned& nloc, unsigned& nx) {
  const unsigned G = gridDim.x * gridDim.y * gridDim.z;
  unsigned sum, cnt, mine, sp = 0u;
  for (;;) {
    sum = 0u; cnt = 0u; mine = 0u;
#pragma unroll
    for (unsigned j = 0; j < 16; ++j) { const unsigned c = xb_ld(&bar[XB_XCNT(j)]); sum += c; cnt += (c > 0u) ? 1u : 0u; mine = (j == x) ? c : mine; }
    if (sum == G) break;
    __builtin_amdgcn_s_sleep(1);
    if ((++sp & 255u) == 0u) { if (xb_ld(&bar[XB_TMO])) break; if (sp > XB_SPIN_CAP) { atomicAdd(&bar[XB_TMO], 1u); break; } }
  }
  nloc = mine > 0u ? mine : 1u; nx = cnt > 0u ? cnt : 1u;
}
DI void xcd_barrier(const XcdBarrier& b) {
  asm volatile("s_waitcnt vmcnt(0)" ::: "memory");
  __syncthreads();
  if (threadIdx.x == 0) {
    unsigned long long ba_ = (unsigned long long)b.bar; unsigned bx = b.x; asm volatile("" : "+v"(bx));
    unsigned* bar = (unsigned*)ba_;
    __builtin_amdgcn_s_waitcnt(0);
    unsigned nloc = b.st[0], nx = b.st[1];
    if (nloc == 0u) { xcd_barrier_complete(bar, bx, nloc, nx); b.st[0] = nloc; b.st[1] = nx; }
    const unsigned old = xb_add(&bar[XB_XSUB(bx)], 1u);
    const unsigned gen = old / nloc;
    if (old + 1u == (gen + 1u) * nloc) {
      __builtin_amdgcn_fence(__ATOMIC_RELEASE, "agent");
      asm volatile("s_waitcnt vmcnt(0)" ::: "memory");
      const unsigned og = xb_add(&bar[XB_TOP], 1u);
      const unsigned tg = og / nx;
      if (og + 1u == (tg + 1u) * nx) xb_add(&bar[XB_TOPGEN], 1u);
      else XB_SPIN(xb_ld(&bar[XB_TOPGEN]) == tg, bar);
      __builtin_amdgcn_fence(__ATOMIC_ACQUIRE, "agent");
      xb_add(&bar[XB_XGEN(bx)], 1u);
      asm volatile("s_waitcnt vmcnt(0)" ::: "memory");
    } else {
      XB_SPIN(xb_ld(&bar[XB_XGEN(bx)]) == gen, bar);
      __builtin_amdgcn_fence(__ATOMIC_ACQUIRE, "agent");
      asm volatile("s_waitcnt vmcnt(0)" ::: "memory");
    }
  }
  __syncthreads();
}

__global__ void __launch_bounds__(NTHR) fwd_megakernel(Params p) {
  extern __shared__ __attribute__((aligned(16))) unsigned char shm[];
  cg::grid_group grid = cg::this_grid();
  LAS unsigned char* ldsl = (LAS unsigned char*)shm;
  unsigned char* lds = shm;
  unsigned char* ws = p.ws;

  bf16_t* hbuf = (bf16_t*)(ws + O_H);
  float* modp = (float*)(ws + O_MODP);
  float* mod = (float*)(ws + O_MOD);
  float* ropeA = (float*)(ws + O_ROPA);
  float* ropeI = (float*)(ws + O_ROPI);
  float* scal = (float*)(ws + O_SCAL);
  unsigned* ctr = (unsigned*)(ws + O_CTR);
  bf16_t* ubuf = (bf16_t*)(ws + O_UBUF);
  float* xbuf = (float*)(ws + O_XBUF);
  int* slot = (int*)(lds + SLOT_OFF);

  { PHASE_VARS
  if (bid == 0) {
    if (tid < 16) ctr[tid] = 0u;
    if (tid < 256) ((unsigned*)(ws + O_LNC))[tid] = 0u;
    for (int i = tid; i < XCD_BAR_WORDS; i += NTHR) ((unsigned*)(ws + O_BAR))[i] = 0u;
    if (tid < 2) { const float* lm = p.lam + tid * 4 * 128; float s0 = 0, s1 = 0; for (int i = 0; i < 128; ++i) { s0 += lm[i] * lm[128 + i]; s1 += lm[256 + i] * lm[384 + i]; }
      const float lam_init = 0.8f - 0.6f * expf(-0.3f * (float)tid);
      scal[tid * 2] = expf(s0) - expf(s1) + lam_init; scal[tid * 2 + 1] = 1.f - lam_init; }
  }
  for (int i = gtid; i < 4096 * 24; i += gthreads) {
    const int pos = i / 24, f = i % 24;
    float inv; if (f < 16) inv = powf(500000.f, -((float)f * 2.f) / 32.f); else inv = powf(500000.f, -((float)(f - 16) * 2.f) / 16.f);
    const float ang = (float)pos * inv;
    const double kk = rint((double)ang * 0.15915494309189535); const float red = (float)((double)ang - kk * 6.283185307179586);
    const float cs = cosf(red), sn = sinf(red);
    if (f < 16) { ropeA[pos * 32 + f] = cs; ropeA[pos * 32 + 16 + f] = sn; } else { ropeI[pos * 16 + (f - 16)] = cs; ropeI[pos * 16 + 8 + (f - 16)] = sn; }
  }
  float* csl = (float*)lds;
  for (int i = tid; i < 4096; i += NTHR) csl[i] = silu(p.c[i]);
  __syncthreads();
  for (int i = gtid; i < 8 * 2 * 12288; i += gthreads) {
    const int col = i % 12288, l = (i / 12288) & 1, kc = i / (2 * 12288);
    const float* w = p.w_ada + (size_t)l * 2048 * 12288 + (size_t)(kc * 256) * 12288 + col;
    float a0 = 0, a1 = 0;
#pragma unroll 8
    for (int k = 0; k < 256; ++k) { const float wv = w[(size_t)k * 12288]; a0 += csl[kc * 256 + k] * wv; a1 += csl[2048 + kc * 256 + k] * wv; }
    modp[((size_t)(kc * 2 + l) * 2 + 0) * 12288 + col] = a0; modp[((size_t)(kc * 2 + l) * 2 + 1) * 12288 + col] = a1;
  }
  __syncthreads();
  }
  convert_layer(p, 0, (float*)lds);
  grid.sync();
  volatile LAS unsigned* xst = (volatile LAS unsigned*)(ldsl + XST_OFF);
  if (threadIdx.x == 0) { xst[0] = 0u; xst[1] = 0u; }
  __syncthreads();
  XcdBarrier xb = xcd_barrier_post((unsigned*)(ws + O_BAR), xst);

  { PHASE_VARS
  for (int i = gtid; i < 2 * 2 * 12288; i += gthreads) {
    const int col = i % 12288, lb = i / 12288, l = lb >> 1;
    float a = p.b_ada[l * 12288 + col];
    for (int kc = 0; kc < 8; ++kc) a += modp[((size_t)kc * 4 + lb) * 12288 + col];
    mod[i] = a;
  } }
  xcd_barrier(xb);
  ln_phase(p.x, nullptr, nullptr, nullptr, mod, 0, 1, ubuf);
  xcd_barrier(xb);

  for (int l = 0; l < 2; ++l) {
    const float* xin = l == 0 ? p.x : xbuf;
    float* xnext = l == 0 ? xbuf : p.out;
    const float* modl = mod + l * 2 * 12288;
    { PHASE_VARS Gemm g{ubuf, (const bf16_t*)(ws + O_WIN), T, NPHYS, 2048, 2048, 2048}; Sched S; S.init(T, NPHYS, nblk, bid);
      EpiIn E{hbuf, (bf16_t*)(ws + O_BVT), (bf16_t*)(ws + O_CVT), ropeA, ropeI};
      gemm_phase(ldsl, g, S, E); }
    { PHASE_VARS const int kc = bid >> 5;
      Gemm g{ubuf + kc * 256, (const bf16_t*)(ws + O_WMISC) + kc * 256, T, 256, 256, 2048, 2048}; Sched S; S.init(T, 256, 32, bid & 31);
      EpiHalfF32 E{(float*)(ws + O_MISCP) + (size_t)kc * T * 128};
      gemm_phase(ldsl, g, S, E); }
    xcd_barrier(xb);
    { PHASE_VARS const float* miscp = (const float*)(ws + O_MISCP); bf16_t* ikn = (bf16_t*)(ws + O_IKN); float* iwf = (float*)(ws + O_IWF); float* bgt = (float*)(ws + O_BG); float* srow = (float*)(ws + O_SROW);
      for (int row = gw; row < T; row += nw) {
        const int pos = row & (SL - 1);
        { const bf16x8 a = *(const bf16x8*)(hbuf + (size_t)row * NPHYS + H_ALAT + lane * 8); float s = 0;
          for (int j = 0; j < 8; ++j) { const float v = bf2f((bf16_t)a[j]); s += v * v; }
          s = wsum(s); if (lane == 0) srow[row] = rsqrtf(s * (1.f / 512.f) + 1e-6f); }
        { float v = 0.f; for (int k = 0; k < 8; ++k) v += miscp[((size_t)k * T + row) * 128 + lane]; const float mu = wsum(v) * (1.f / 64.f); const float d = v - mu; const float var = wsum(d * d) * (1.f / 64.f);
          const float y = d * rsqrtf(var + 1e-5f);
          const float y8 = __shfl_xor(y, 8);
          float o = y;
          if (lane < 16) { const int f = lane & 7; const float cs = ropeI[pos * 16 + f], sn = ropeI[pos * 16 + 8 + f]; o = lane < 8 ? y * cs - y8 * sn : y * cs + y8 * sn; }
          ikn[(size_t)row * 64 + lane] = f2bf(o); }
        { float v = 0.f; for (int k = 0; k < 8; ++k) v += miscp[((size_t)k * T + row) * 128 + 64 + lane];
          if (lane < 16) iwf[(size_t)row * 16 + lane] = v * (0.25f * 0.125f);
          else if (lane < 40) bgt[(size_t)row * 24 + (lane - 16)] = sigm(v); }
      }
      bf16_t* blk = (bf16_t*)(ws + O_BLK);
      for (int ch = gtid; ch < 2048 * 512; ch += gthreads) {
        const int row = ch >> 9, cc = ch & 511, j = cc >> 4, d8 = (cc & 15) * 8;
        const int kv = row >> 10, rr = row & 1023, b = rr >> 9, n = (rr & 511) >> 1, g = rr & 1, tok = 16 * n + j;
        u32x4 w = {0u, 0u, 0u, 0u};
        if (n < 255 && tok < SL) {
          const bf16x8 a = *(const bf16x8*)(hbuf + (size_t)(b * SL + tok) * NPHYS + H_BKV + kv * 256 + g * 128 + d8);
          const float* pe = p.cmp_pe + (size_t)((l * 2 + kv) * 32 + j) * 128 + d8;
          float v[8]; for (int q = 0; q < 8; ++q) v[q] = bf2f((bf16_t)a[q]) + pe[q];
          w = (u32x4){cvtpk(v[0], v[1]), cvtpk(v[2], v[3]), cvtpk(v[4], v[5]), cvtpk(v[6], v[7])};
        }
        *(u32x4*)(blk + (size_t)row * 4096 + cc * 8) = w;
      }
    }
    xcd_barrier(xb);
    { PHASE_VARS Gemm g{hbuf + H_ALAT, (const bf16_t*)(ws + O_WAUP), T, 2048, 512, NPHYS, 512}; Sched S; S.init(T, 2048, nblk, bid);
      EpiAup E{(bf16_t*)(ws + O_AK), (bf16_t*)(ws + O_AVT), (const float*)(ws + O_SROW), ropeA};
      gemm_phase(ldsl, g, S, E); }
    { PHASE_VARS if (bid < 64) { const int kc = bid >> 3;
      Gemm g{(const bf16_t*)(ws + O_BLK) + kc * 512, (const bf16_t*)(ws + O_WC1) + kc * 512, 2048, 256, 512, 4096, 4096}; Sched S; S.init(2048, 256, 8, bid & 7);
      EpiF32 E{(float*)(ws + O_CPART) + (size_t)kc * 2048 * 256, 256};
      gemm_phase(ldsl, g, S, E);
      asm volatile("s_waitcnt vmcnt(0)" ::: "memory"); __syncthreads();
      if (tid == 0) { __builtin_amdgcn_fence(__ATOMIC_RELEASE, "agent"); asm volatile("s_waitcnt vmcnt(0)" ::: "memory");
        __hip_atomic_fetch_add(ctr + l * 4 + 3, 1u, __ATOMIC_RELAXED, __HIP_MEMORY_SCOPE_AGENT); } } }
    idxsel_phase(lds, hbuf, (const bf16_t*)(ws + O_IKN), (const float*)(ws + O_IWF), (u64*)(ws + O_BITS), ctr + l * 4 + 0);
    { PHASE_VARS
      if (tid == 0) { unsigned sp_ = 0; while (__hip_atomic_load(ctr + l * 4 + 3, __ATOMIC_RELAXED, __HIP_MEMORY_SCOPE_AGENT) < 64u) { __builtin_amdgcn_s_sleep(1); if (++sp_ > (1u << 24)) break; }
        __builtin_amdgcn_fence(__ATOMIC_ACQUIRE, "agent"); asm volatile("s_waitcnt vmcnt(0)" ::: "memory"); }
      __syncthreads(); }
    { PHASE_VARS const float* cpart = (const float*)(ws + O_CPART); bf16_t* kc_ = (bf16_t*)(ws + O_KC); bf16_t* vct = (bf16_t*)(ws + O_VCT);
      float* hid = (float*)lds; float* red = (float*)lds + 128;
      for (int row = bid; row < 2048; row += nblk) {
        const int kv = row >> 10, rr = row & 1023, b = rr >> 9, n = (rr & 511) >> 1, g = rr & 1;
        __syncthreads();
        if (tid < 128) { float s = 0; for (int k = 0; k < 8; ++k) s += cpart[((size_t)k * 2048 + row) * 256 + kv * 128 + tid]; hid[tid] = silu(s); }
        __syncthreads();
        { const int cp = tid & 127, part = tid >> 7; const float* w2 = p.cmp_w2 + (size_t)(l * 2 + kv) * 128 * 128;
          float s = 0; for (int c = part * 32; c < part * 32 + 32; ++c) s += hid[c] * w2[c * 128 + cp];
          red[part * 128 + cp] = s; }
        __syncthreads();
        if (tid < 128) { const float s = red[tid] + red[128 + tid] + red[256 + tid] + red[384 + tid];
          if (kv == 0) kc_[(size_t)((b * 2 + g) * 256 + n) * 128 + tid] = f2bf(s); else vct[(size_t)((b * 2 + g) * 128 + tid) * 256 + n] = f2bf(s); }
      }
    }
    xcd_barrier(xb);
    { PHASE_VARS float* pcmp = (float*)(ws + O_PCMP); float* ml = (float*)(ws + O_ML);
      for (;;) {
        const int it = fetch_item(ctr + l * 4 + 1, slot);
        if (it >= 256) break;
        f32x16 o[4]; float mo, lo;
        const int r32 = lane & 31, hi = lane >> 5;
        const int qb = 15 - it / 16, r = it % 16, b = r >> 3, hh = r & 7, g = hh >> 2, rowg0 = b * SL + qb * 256;
        attn_core_skew<M_CMP>(ldsl, hbuf + (size_t)rowg0 * NPHYS + H_BQ + hh * 128, NPHYS, (const bf16_t*)(ws + O_KC) + (size_t)((b * 2 + g) * 256) * 128, 128,
                         (const bf16_t*)(ws + O_VCT) + (size_t)((b * 2 + g) * 128) * 256, 256, qb * 256, 0, 4, nullptr,
                         pcmp + ((size_t)(b * 8 + hh) * SL + qb * 256) * 256, o, mo, lo);
        store_o_bf16(ldsl, (bf16_t*)(ws + O_OCMP), rowg0, hh * 128, o);
        if (hi == 0) { float* mp = ml + ((size_t)(b * 8 + hh) * SL + qb * 256 + wid * 32 + r32) * 2; mp[0] = mo; mp[1] = lo; }
      }
    }
    xcd_barrier(xb);
    { PHASE_VARS const float* pcmp = (const float*)(ws + O_PCMP); const float* ml = (const float*)(ws + O_ML); u64* sel = (u64*)(ws + O_SEL);
      for (int it = gw; it < 2 * 2 * SL; it += nw) {
        const int t = it & (SL - 1), bg = it >> 12, b = bg >> 1, g = bg & 1, m = lane, tc = t >= 31 ? ((t - 31) >> 4) : -1;
        float imp = 0.f;
        for (int hh = 0; hh < 4; ++hh) { const size_t rb = (size_t)(b * 8 + g * 4 + hh) * SL + t; const float* base = pcmp + rb * 256;
          const float mm = ml[rb * 2], ll = ml[rb * 2 + 1]; const float inv = ll > 0.f ? 1.f / ll : 0.f;
          const float NI = -__builtin_inff();
          const f32x4 s4 = 4 * m <= tc ? *(const f32x4*)(base + 4 * m) : (f32x4){NI, NI, NI, NI}; const float sm1 = (m > 0 && 4 * m - 1 <= tc) ? base[4 * m - 1] : NI;
          float ps = __builtin_amdgcn_exp2f((sm1 - mm) * C2);
          for (int j = 0; j < 4; ++j) ps += __builtin_amdgcn_exp2f((s4[j] - mm) * C2);
          imp += ps * inv; }
        const int cur = t >> 6;
        const bool forced = (m == 0) | (m == cur) | (m == cur - 1), adm = m <= cur;
        const float v = forced ? 1e6f : (adm ? imp : -1e30f);
        int rank = 0;
#pragma unroll
        for (int jj = 0; jj < 64; ++jj) { const float vj = __int_as_float(__builtin_amdgcn_readlane(__float_as_int(v), jj)); rank += (vj > v || (vj == v && jj < m)) ? 1 : 0; }
        const u64 w = __ballot(rank < 16);
        if (lane == 0) sel[it] = w;
      }
    }
    xcd_barrier(xb);
    { PHASE_VARS const u64* sel = (const u64*)(ws + O_SEL); const float* bgt = (const float*)(ws + O_BG); const u64* bits = (const u64*)(ws + O_BITS);
      for (;;) {
        const int it = fetch_item(ctr + l * 4 + 2, slot);
        if (it >= 1024) break;
        f32x16 o[4]; float mo, lo;
        const int r32 = lane & 31, hi = lane >> 5;
        if (it >= 768) {
          const int i2 = it - 768, qb = 15 - i2 / 16, r = i2 % 16, b = r >> 3, hh = r & 7, g = hh >> 2, rowg0 = b * SL + qb * 256;
          const int jlo = 4 * qb - 8 > 0 ? 4 * qb - 8 : 0;
          attn_core_skew<M_WINDOW>(ldsl, hbuf + (size_t)rowg0 * NPHYS + H_BQ + hh * 128, NPHYS, hbuf + (size_t)(b * SL) * NPHYS + H_BKV + (8 + g) * 128, NPHYS,
                              (const bf16_t*)(ws + O_BVT) + (size_t)(((b * 2 + 1) * 2 + g) * 128) * SL, SL, qb * 256, jlo, 4 * qb + 4, nullptr, nullptr, o, mo, lo);
          store_o_bf16(ldsl, (bf16_t*)(ws + O_OWIN), rowg0, hh * 128, o);
          continue;
        }
        const int qb = 15 - it / 48, r = it % 48;
        if (r < 16) {
          f32x16 o8[8];
          const int b = r >> 3, vh = r & 7, head = vh >> 1, mp = vh & 1, rowg0 = b * SL + qb * 256;
          attn_core<M_CAUSAL, 256>(ldsl, hbuf + (size_t)rowg0 * NPHYS + H_CQ + (head * 2 + mp) * 128, NPHYS, hbuf + (size_t)(b * SL) * NPHYS + H_CK + (head * 2 + mp) * 128, NPHYS,
                              (const bf16_t*)(ws + O_CVT) + (size_t)((b * 4 + head) * 256) * SL, SL, qb * 256, 0, 4 * qb + 4, nullptr, nullptr, o8, mo, lo);
          __syncthreads();
          { const int t2 = ltid(), l2 = t2 & 63, w2 = t2 >> 6, r2_ = l2 & 31, h2 = l2 >> 5;
            LAS unsigned char* pw = ldsl + w2 * 17408;
#pragma unroll
            for (int rr = 0; rr < 16; ++rr)
#pragma unroll
              for (int d = 0; d < 8; ++d) *(LAS bf16_t*)(pw + ((rr & 3) + 8 * (rr >> 2) + 4 * h2) * 544 + (d * 32 + r2_) * 2) = f2bf(o8[d][rr]);
            asm volatile("s_waitcnt lgkmcnt(0)" ::: "memory");
            bf16_t* ocp = (bf16_t*)(ws + O_OC) + (size_t)(rowg0 + w2 * 32) * 2048 + head * 512 + mp * 256;
#pragma unroll
            for (int i = 0; i < 16; ++i) { const int c = i * 64 + l2, row = c >> 5, c16 = c & 31;
              *(u32x4*)(ocp + (size_t)row * 2048 + c16 * 8) = *(const LAS u32x4*)(pw + row * 544 + c16 * 16); }
            asm volatile("s_waitcnt lgkmcnt(0)" ::: "memory"); }
        } else if (r < 32) {
          const int r2 = r - 16, b = r2 >> 3, hh = r2 & 7, rowg0 = b * SL + qb * 256;
          attn_core_skew<M_BITS>(ldsl, hbuf + (size_t)rowg0 * NPHYS + H_AQ + hh * 128, NPHYS, (const bf16_t*)(ws + O_AK) + (size_t)(b * SL) * 1024 + hh * 128, 1024,
                            (const bf16_t*)(ws + O_AVT) + (size_t)((b * 8 + hh) * 128) * SL, SL, qb * 256, 0, 4 * qb + 4, bits + (size_t)rowg0 * 64, nullptr, o, mo, lo);
          store_o_bf16(ldsl, (bf16_t*)(ws + O_YA), rowg0, hh * 128, o);
        } else {
          const int r2 = r - 32, b = r2 >> 3, hh = r2 & 7, g = hh >> 2, rowg0 = b * SL + qb * 256;
          attn_core_skew<M_SLC>(ldsl, hbuf + (size_t)rowg0 * NPHYS + H_BQ + hh * 128, NPHYS, hbuf + (size_t)(b * SL) * NPHYS + H_BKV + (4 + g) * 128, NPHYS,
                           (const bf16_t*)(ws + O_BVT) + (size_t)(((b * 2 + 0) * 2 + g) * 128) * SL, SL, qb * 256, 0, 4 * qb + 4, sel + (size_t)(b * 2 + g) * SL + qb * 256, nullptr, o, mo, lo);
          store_o_bf16(ldsl, (bf16_t*)(ws + O_YB), rowg0, hh * 128, o);
        }
      }
      (void)bgt;
    }
    xcd_barrier(xb);
    { PHASE_VARS const bf16_t* ocmp = (const bf16_t*)(ws + O_OCMP); const bf16_t* owin = (const bf16_t*)(ws + O_OWIN); bf16_t* yb = (bf16_t*)(ws + O_YB); const float* bgt = (const float*)(ws + O_BG);
      for (int row = gw; row < T; row += nw) {
#pragma unroll
        for (int hq = 0; hq < 2; ++hq) { const int c0 = hq * 512 + lane * 8, hh = c0 >> 7; const float* gp = bgt + (size_t)row * 24 + hh * 3; const float g0 = gp[0], g1 = gp[1], g2 = gp[2];
          const size_t rw = (size_t)row * 1024 + c0;
          const bf16x8 a = *(const bf16x8*)(ocmp + rw), b8 = *(const bf16x8*)(yb + rw), c8 = *(const bf16x8*)(owin + rw);
          float v[8]; for (int q = 0; q < 8; ++q) v[q] = g0 * bf2f((bf16_t)a[q]) + g1 * bf2f((bf16_t)b8[q]) + g2 * bf2f((bf16_t)c8[q]);
          *(u32x4*)(yb + rw) = (u32x4){cvtpk(v[0], v[1]), cvtpk(v[2], v[3]), cvtpk(v[4], v[5]), cvtpk(v[6], v[7])}; }
      }
    }
    { PHASE_VARS const bf16_t* oc = (const bf16_t*)(ws + O_OC); bf16_t* yc = (bf16_t*)(ws + O_YC);
      const float lamv = scal[l * 2], omli = scal[l * 2 + 1];
      for (int it = gw; it < T * 4; it += nw) {
        const int row = it >> 2, head = it & 3;
        const s16x4 a = *(const s16x4*)(oc + (size_t)row * 2048 + head * 512 + lane * 4), b4 = *(const s16x4*)(oc + (size_t)row * 2048 + head * 512 + 256 + lane * 4);
        float v[4], s = 0; for (int j = 0; j < 4; ++j) { v[j] = bf2f((bf16_t)a[j]) - lamv * bf2f((bf16_t)b4[j]); s += v[j] * v[j]; }
        const float rs = rsqrtf(wsum(s) * (1.f / 256.f) + 1e-6f);
        const f32x4 gg = *(const f32x4*)(p.subln_g + l * 256 + lane * 4);
        float o4[4]; for (int j = 0; j < 4; ++j) o4[j] = v[j] * rs * gg[j] * omli;
        *(u32x2*)(yc + (size_t)row * 1024 + head * 256 + lane * 4) = (u32x2){cvtpk(o4[0], o4[1]), cvtpk(o4[2], o4[3])};
      }
    }
    xcd_barrier(xb);
    { PHASE_VARS
      static_assert(O_YB == O_YA + (size_t)T * 1024 * 2 && O_YC == O_YB + (size_t)T * 1024 * 2, "branch outputs must be contiguous");
      Gemm g{(const bf16_t*)(ws + O_YA), (const bf16_t*)(ws + O_WBR), T, 2048, 1024, 1024, 1024}; Sched S; S.init(T, 2048, nblk, bid); S.strm = 3;
      EpiGate E{hbuf, (float*)(ws + O_TMP), (bf16_t*)(ws + O_MERG)};
      gemm_phase(ldsl, g, S, E);
    }
    xcd_barrier(xb);
    { PHASE_VARS Gemm g{(const bf16_t*)(ws + O_MERG), (const bf16_t*)(ws + O_WO), T, 2048, 2048, 2048, 2048}; Sched S; S.init(T, 2048, nblk, bid);
      EpiLnFused E{xin, modl + 2 * 2048, p.ln_g + (size_t)(l * 2 + 0) * 2048, p.ln_b + (size_t)(l * 2 + 0) * 2048, (float*)(ws + O_X1), modl, 3, 4, ubuf,
                   (float*)(ws + O_LNS), (unsigned*)(ws + O_LNC) + (l * 2 + 0) * 64};
      gemm_phase(ldsl, g, S, E); }
    xcd_barrier(xb);
    { PHASE_VARS Gemm g{ubuf, (const bf16_t*)(ws + O_WF1), T, 2 * DFF, 2048, 2048, 2048}; Sched S; S.init(T, 2 * DFF, nblk, bid);
      EpiSwiglu E{(bf16_t*)(ws + O_HID)};
      gemm_phase(ldsl, g, S, E); }
    xcd_barrier(xb);
    { PHASE_VARS Gemm g{(const bf16_t*)(ws + O_HID), (const bf16_t*)(ws + O_WF2), T, 2048, DFF, DFF, DFF}; Sched S; S.init(T, 2048, nblk, bid);
      EpiLnFused E{(const float*)(ws + O_X1), modl + 5 * 2048, p.ln_g + (size_t)(l * 2 + 1) * 2048, p.ln_b + (size_t)(l * 2 + 1) * 2048, xnext, mod + 2 * 12288, 0, 1, l == 0 ? ubuf : nullptr,
                   (float*)(ws + O_LNS), (unsigned*)(ws + O_LNC) + (l * 2 + 1) * 64};
      gemm_phase(ldsl, g, S, E); }
    if (l == 0) { xcd_barrier(xb); convert_layer(p, 1, (float*)lds); xcd_barrier(xb); }
  }
}

extern "C" void kernel_launch(void* const* d_in, const int* in_sizes, int n_in, void* d_out, int out_size, void* d_ws, size_t ws_size, hipStream_t stream) {
  (void)in_sizes; (void)n_in; (void)out_size;
  static int grid_blocks = 0;
  if (!grid_blocks) {
    hipError_t e = hipFuncSetAttribute((const void*)fwd_megakernel, hipFuncAttributeMaxDynamicSharedMemorySize, LDS_BYTES);
    if (e != hipSuccess) fprintf(stderr, "hipFuncSetAttribute failed: %s\n", hipGetErrorString(e));
    int dev = 0, cus = 0, per_cu = 0;
    hipGetDevice(&dev);
    hipDeviceGetAttribute(&cus, hipDeviceAttributeMultiprocessorCount, dev);
    hipOccupancyMaxActiveBlocksPerMultiprocessor(&per_cu, fwd_megakernel, NTHR, LDS_BYTES);
    if (per_cu < 1) per_cu = 1;
    grid_blocks = cus;
    if (ws_size < WS_TOTAL) fprintf(stderr, "workspace too small: %zu < %zu\n", ws_size, (size_t)WS_TOTAL);
  }
  Params p{};
  p.x = (const float*)d_in[0]; p.c = (const float*)d_in[1]; p.w_ada = (const float*)d_in[2]; p.b_ada = (const float*)d_in[3]; p.w_in = (const float*)d_in[4];
  p.a_lat_g = (const float*)d_in[5]; p.a_up = (const float*)d_in[6]; p.cmp_w1 = (const float*)d_in[7]; p.cmp_w2 = (const float*)d_in[8]; p.cmp_pe = (const float*)d_in[9];
  p.lam = (const float*)d_in[10]; p.subln_g = (const float*)d_in[11]; p.w_br = (const float*)d_in[12]; p.w_o = (const float*)d_in[13]; p.w_f1 = (const float*)d_in[14];
  p.w_f2 = (const float*)d_in[15]; p.ln_g = (const float*)d_in[16]; p.ln_b = (const float*)d_in[17];
  p.out = (float*)d_out; p.ws = (unsigned char*)d_ws;
  void* args[] = {&p};
  hipError_t e = hipLaunchCooperativeKernel((const void*)fwd_megakernel, dim3(grid_blocks), dim3(NTHR), args, LDS_BYTES, stream);
  if (e != hipSuccess) fprintf(stderr, "cooperative launch failed: %s (grid %d)\n", hipGetErrorString(e), grid_blocks);
}
```

```cpp
#include <hip/hip_runtime.h>
#include <hip/hip_cooperative_groups.h>
#include <cstdio>
#include <cstdint>
namespace cg = cooperative_groups;

#define DI __device__ __forceinline__
#define LAS __attribute__((address_space(3)))
typedef unsigned short bf16_t;
typedef short bf16x8 __attribute__((ext_vector_type(8)));
typedef short s16x4 __attribute__((ext_vector_type(4)));
typedef float f32x4 __attribute__((ext_vector_type(4)));
typedef float f32x16 __attribute__((ext_vector_type(16)));
typedef unsigned u32x4 __attribute__((ext_vector_type(4)));
typedef unsigned u32x2 __attribute__((ext_vector_type(2)));
typedef unsigned long long u64;

constexpr int T = 8192, SL = 4096, DM = 2048, NPHYS = 14336, DFF = 5632, NIN = 14440;
constexpr int H_AQ = 0, H_ALAT = 1024, H_IQ = 1536, H_BQ = 2560, H_BKV = 3584, H_CQ = 5120, H_CK = 6144, H_GL = 8192;
constexpr float ALPHA = 1.4142135623730951f;
constexpr float C2 = 0.08838834764831845f * 1.4426950408889634f;
constexpr int NTHR = 512;
constexpr int LDS_BYTES = 147456, SLOT_OFF = 145408, XST_OFF = 146432, PD_OFF = 73728;

constexpr size_t al256(size_t x) { return (x + 255) & ~(size_t)255; }
constexpr size_t O_WIN = 0;
constexpr size_t O_WAUP = O_WIN + (size_t)NPHYS * 2048 * 2;
constexpr size_t O_WC1 = O_WAUP + (size_t)2048 * 512 * 2;
constexpr size_t O_WBR = O_WC1 + (size_t)256 * 4096 * 2;
constexpr size_t O_WO = O_WBR + (size_t)3 * 2048 * 1024 * 2;
constexpr size_t O_WF1 = O_WO + (size_t)2048 * 2048 * 2;
constexpr size_t O_WF2 = O_WF1 + (size_t)2 * DFF * 2048 * 2;
constexpr size_t O_WMISC = O_WF2 + (size_t)2048 * DFF * 2;
constexpr size_t O_H = O_WMISC + (size_t)256 * 2048 * 2;
constexpr size_t O_HID = O_H;
constexpr size_t O_X1 = O_H + (size_t)T * DFF * 2;
constexpr size_t O_S = O_H + (size_t)T * NPHYS * 2;
constexpr size_t O_MISCP = O_S;
constexpr size_t O_PCMP = O_S;
constexpr size_t O_OC = O_S + (size_t)T * 2048 * 4;
constexpr size_t O_TMP = O_S;
constexpr size_t O_Z = O_OC;
constexpr size_t O_XBUF = O_S + (size_t)T * 4096 * 4;
constexpr size_t O_UBUF = O_XBUF + (size_t)T * DM * 4;
constexpr size_t O_AVT = O_UBUF + (size_t)T * DM * 2;
constexpr size_t O_BVT = O_AVT + (size_t)2 * 8 * 128 * 4096 * 2;
constexpr size_t O_CVT = O_BVT + (size_t)2 * 2 * 2 * 128 * 4096 * 2;
constexpr size_t O_AK = O_CVT + (size_t)2 * 4 * 256 * 4096 * 2;
constexpr size_t O_MISC = O_AK + (size_t)T * 1024 * 2;
constexpr size_t O_IKN = O_MISC + (size_t)T * 128 * 4;
constexpr size_t O_IWF = O_IKN + (size_t)T * 64 * 2;
constexpr size_t O_BG = O_IWF + (size_t)T * 16 * 4;
constexpr size_t O_SROW = O_BG + (size_t)T * 24 * 4;
constexpr size_t O_BLK = O_SROW + (size_t)T * 4;
constexpr size_t O_CPART = O_BLK + (size_t)2048 * 4096 * 2;
constexpr size_t O_KC = O_CPART + (size_t)8 * 2048 * 256 * 4;
constexpr size_t O_VCT = O_KC + (size_t)2 * 2 * 256 * 128 * 2;
constexpr size_t O_BITS = O_VCT + (size_t)2 * 2 * 128 * 256 * 2;
constexpr size_t O_SEL = O_BITS + (size_t)T * 64 * 8;
constexpr size_t O_ML = O_SEL + (size_t)2 * 2 * 4096 * 8;
constexpr size_t O_YA = O_ML + (size_t)2 * 8 * 4096 * 2 * 4;
constexpr size_t O_YB = O_YA + (size_t)T * 1024 * 2;
constexpr size_t O_YC = O_YB + (size_t)T * 1024 * 2;
constexpr size_t O_OCMP = O_YC + (size_t)T * 1024 * 2;
constexpr size_t O_OWIN = O_OCMP + (size_t)T * 1024 * 2;
constexpr size_t O_MERG = O_OWIN + (size_t)T * 1024 * 2;
constexpr size_t O_MODP = O_MERG + (size_t)T * DM * 2;
constexpr size_t O_MOD = O_MODP + (size_t)8 * 2 * 2 * 12288 * 4;
constexpr size_t O_ROPA = O_MOD + (size_t)2 * 2 * 12288 * 4;
constexpr size_t O_ROPI = O_ROPA + (size_t)4096 * 32 * 4;
constexpr size_t O_SCAL = O_ROPI + (size_t)4096 * 16 * 4;
constexpr size_t O_CTR = O_SCAL + 256;
constexpr size_t O_LNC = O_CTR + 256;
constexpr size_t O_LNS = O_LNC + 1024;
constexpr size_t O_BAR = O_LNS + (size_t)2 * 32 * 256 * 16 * 4;
constexpr size_t WS_TOTAL = O_BAR + 3456 * 4;

struct Params {
  const float *x, *c, *w_ada, *b_ada, *w_in, *a_lat_g, *a_up, *cmp_w1, *cmp_w2, *cmp_pe, *lam, *subln_g, *w_br, *w_o, *w_f1, *w_f2, *ln_g, *ln_b;
  float* out;
  unsigned char* ws;
};

DI unsigned cvtpk(float lo, float hi) { unsigned r; asm volatile("v_cvt_pk_bf16_f32 %0, %1, %2" : "=v"(r) : "v"(lo), "v"(hi)); return r; }
DI float bf2f(bf16_t b) { return __uint_as_float(((unsigned)b) << 16); }
DI bf16_t f2bf(float f) { return (bf16_t)(cvtpk(f, 0.f) & 0xffffu); }
DI float wsum(float v) { for (int o = 32; o; o >>= 1) v += __shfl_xor(v, o); return v; }
DI float sigm(float x) { return __builtin_amdgcn_rcpf(1.f + __expf(-x)); }
DI float silu(float x) { return x * __builtin_amdgcn_rcpf(1.f + __expf(-x)); }
DI int crow(int r, int hi) { return (r & 3) + 8 * (r >> 2) + 4 * hi; }
DI float vmin_raw(float a, float b) { float r; asm("v_min_f32_e32 %0, %1, %2" : "=v"(r) : "v"(a), "v"(b)); return r; }
DI int ltid() { int t = threadIdx.x; asm volatile("" : "+v"(t)); return t; }
DI int lbid() { int b = blockIdx.x; asm volatile("" : "+s"(b)); return b; }
#define PHASE_VARS const int tid = ltid(), bid = lbid(), nblk = gridDim.x, gtid = bid * NTHR + tid, gthreads = nblk * NTHR, lane = tid & 63, wid = tid >> 6, gw = bid * 8 + wid, nw = nblk * 8; (void)gtid; (void)gthreads; (void)lane; (void)wid; (void)gw; (void)nw;

struct MapId { int off; DI int operator()(int n) const { return n + off; } };
struct MapIn { DI int operator()(int n) const {
    if (n < 2560) return n;
    if (n < 5120) return n + 80;
    return n + 104; } };
struct MapMisc { DI int operator()(int n) const { return n < 80 ? 2560 + n : (n < 104 ? 5200 + (n - 80) : -1); } };
struct MapF1 { DI int operator()(int n) const { const int q = n >> 5, r = n & 31; return r < 16 ? q * 16 + r : DFF + q * 16 + (r - 16); } };

template <class Map>
DI void conv_T(bf16_t* __restrict__ dst, const float* __restrict__ src, int K, int ldsrc, int nphys, Map map, const float* __restrict__ kscale, float* tile) {
  const int tid = ltid(), ntn = nphys >> 6, ntiles = (K >> 6) * ntn;
  for (int tl = lbid(); tl < ntiles; tl += gridDim.x) {
    const int k0 = (tl / ntn) << 6, n0 = (tl % ntn) << 6;
    const int nn = tid & 63, sc = map(n0 + nn);
#pragma unroll
    for (int i = 0; i < 8; ++i) { const int kk = i * 8 + (tid >> 6);
      float v = sc >= 0 ? __builtin_nontemporal_load(&src[(size_t)(k0 + kk) * ldsrc + sc]) : 0.f;
      if (kscale) v *= kscale[k0 + kk];
      tile[kk * 65 + nn] = v; }
    __syncthreads();
    const int np = tid >> 3, ks = tid & 7;
    float v[8];
#pragma unroll
    for (int j = 0; j < 8; ++j) v[j] = tile[(ks * 8 + j) * 65 + np];
    u32x4 w = {cvtpk(v[0], v[1]), cvtpk(v[2], v[3]), cvtpk(v[4], v[5]), cvtpk(v[6], v[7])};
    *(u32x4*)(dst + (size_t)(n0 + np) * K + k0 + ks * 8) = w;
    __syncthreads();
  }
}

DI void convert_layer(const Params& p, int l, float* tile) {
  unsigned char* ws = p.ws;
  conv_T((bf16_t*)(ws + O_WIN), p.w_in + (size_t)l * 2048 * NIN, 2048, NIN, NPHYS, MapIn{}, nullptr, tile);
  conv_T((bf16_t*)(ws + O_WMISC), p.w_in + (size_t)l * 2048 * NIN, 2048, NIN, 256, MapMisc{}, nullptr, tile);
  conv_T((bf16_t*)(ws + O_WAUP), p.a_up + (size_t)l * 512 * 2048, 512, 2048, 2048, MapId{0}, p.a_lat_g + l * 512, tile);
  conv_T((bf16_t*)(ws + O_WC1), p.cmp_w1 + (size_t)(l * 2 + 0) * 4096 * 128, 4096, 128, 128, MapId{0}, nullptr, tile);
  conv_T((bf16_t*)(ws + O_WC1) + (size_t)128 * 4096, p.cmp_w1 + (size_t)(l * 2 + 1) * 4096 * 128, 4096, 128, 128, MapId{0}, nullptr, tile);
  for (int r = 0; r < 3; ++r)
    conv_T((bf16_t*)(ws + O_WBR) + (size_t)r * 2048 * 1024, p.w_br + (size_t)(l * 3 + r) * 1024 * 2048, 1024, 2048, 2048, MapId{0}, nullptr, tile);
  conv_T((bf16_t*)(ws + O_WO), p.w_o + (size_t)l * 2048 * 2048, 2048, 2048, 2048, MapId{0}, nullptr, tile);
  conv_T((bf16_t*)(ws + O_WF1), p.w_f1 + (size_t)l * 2048 * 2 * DFF, 2048, 2 * DFF, 2 * DFF, MapF1{}, nullptr, tile);
  conv_T((bf16_t*)(ws + O_WF2), p.w_f2 + (size_t)l * DFF * 2048, DFF, 2048, 2048, MapId{0}, nullptr, tile);
}

DI void ln_phase(const float* __restrict__ zin, const float* __restrict__ gam, const float* __restrict__ bet, float* __restrict__ xout,
                 const float* __restrict__ modl  , int sh_idx, int sc_idx, bf16_t* __restrict__ uout) {
  const int tid_ = ltid(), lane = tid_ & 63, gw = lbid() * 8 + (tid_ >> 6), nw = gridDim.x * 8;
  for (int row = gw; row < T; row += nw) {
    f32x4 v[8];
    const float* zr = zin + (size_t)row * DM;
#pragma unroll
    for (int i = 0; i < 8; ++i) v[i] = *(const f32x4*)(zr + i * 256 + lane * 4);
    if (gam) {
      float s = 0; for (int i = 0; i < 8; ++i) s += v[i][0] + v[i][1] + v[i][2] + v[i][3];
      const float mu = wsum(s) * (1.f / DM);
      float q = 0; for (int i = 0; i < 8; ++i) for (int j = 0; j < 4; ++j) { const float d = v[i][j] - mu; q += d * d; }
      const float rstd = rsqrtf(wsum(q) * (1.f / DM) + 1e-5f);
#pragma unroll
      for (int i = 0; i < 8; ++i) { const f32x4 g = *(const f32x4*)(gam + i * 256 + lane * 4), b = *(const f32x4*)(bet + i * 256 + lane * 4);
        for (int j = 0; j < 4; ++j) v[i][j] = (v[i][j] - mu) * rstd * g[j] + b[j];
        *(f32x4*)(xout + (size_t)row * DM + i * 256 + lane * 4) = v[i]; }
    }
    if (uout) {
      const float* mb = modl + (row >> 12) * 12288;
      float s = 0; for (int i = 0; i < 8; ++i) s += v[i][0] + v[i][1] + v[i][2] + v[i][3];
      const float mu = wsum(s) * (1.f / DM);
      float q = 0; for (int i = 0; i < 8; ++i) for (int j = 0; j < 4; ++j) { const float d = v[i][j] - mu; q += d * d; }
      const float rstd = rsqrtf(wsum(q) * (1.f / DM) + 1e-5f);
#pragma unroll
      for (int i = 0; i < 8; ++i) { const int c = i * 256 + lane * 4;
        const f32x4 sc = *(const f32x4*)(mb + sc_idx * 2048 + c), sh = *(const f32x4*)(mb + sh_idx * 2048 + c);
        float o[4]; for (int j = 0; j < 4; ++j) o[j] = (v[i][j] - mu) * rstd * (1.f + sc[j]) + sh[j];
        u32x2 w = {cvtpk(o[0], o[1]), cvtpk(o[2], o[3])};
        *(u32x2*)(uout + (size_t)row * DM + c) = w; }
    }
  }
}

constexpr int BM = 256, BK = 64, HALF = 128, HTB = HALF * BK * 2, NXCD = 8, WGM = 8;
DI int lds_byte(int r, int c) { const int st = (r >> 4) * 2 + (c >> 5), rr = r & 15, cc = c & 31, ob = rr * 64 + cc * 2; return st * 1024 + (ob ^ (((ob >> 9) & 1) << 5)); }
DI void stage_rc(int b, int& R, int& C) { const int st = b / 1024, sb = b % 1024, swz = sb ^ (((sb >> 9) & 1) << 5); R = (st >> 1) * 16 + swz / 64; C = (st & 1) * 32 + (swz % 64) / 2; }
DI int perm32(int rho) { const int n = rho >> 4, i = rho & 15; return 8 * (i >> 2) + 4 * n + (i & 3); }
struct Unit { int pm, pn; };
struct Gemm { const bf16_t* A; const bf16_t* Bt; int M, N, K, lda, ldb; };
struct Sched {
  int nM, nN, nwg, G, c;
  DI void init(int M, int N, int G_, int c_) { nM = M / BM; nN = N / BM; nwg = nM * nN; G = G_; c = c_; }
  DI bool next(int i, Unit& u) const {
    const long L = (long)i * G + c; if (L >= nwg) return false;
    int wgid = (int)L; { const int q = nwg / NXCD, r = nwg % NXCD, xcd = wgid % NXCD, off = wgid / NXCD; wgid = (xcd < r ? xcd * (q + 1) : r * (q + 1) + (xcd - r) * q) + off; }
    const int nig = WGM * nN, gid = wgid / nig, fm = gid * WGM, gsz = (nM - fm) < WGM ? (nM - fm) : WGM;
    u.pm = fm + ((wgid % nig) % gsz); u.pn = (wgid % nig) / gsz; return true;
  }
};

template <class Epi>
DI void gemm_phase(LAS unsigned char* lds, const Gemm g, const Sched& S, const Epi& E) {
  const int tid = ltid(), wid = __builtin_amdgcn_readfirstlane(tid >> 6), lane = tid & 63, wr = wid >> 2, wc = wid & 3, fr = lane & 15, fq = lane >> 4;
  const int K = g.K, nt = K / BK;
  unsigned voffA[2], voffB[2];
#pragma unroll
  for (int i = 0; i < 2; ++i) { int R, C; stage_rc(tid * 16 + i * 8192, R, C); const int Rb = Epi::PERM ? ((R & ~31) + perm32(R & 31)) : R;
    voffA[i] = (unsigned)(R * g.lda + C) * 2u; voffB[i] = (unsigned)(Rb * g.ldb + C) * 2u; }
  const size_t kstep = (size_t)(BK * 2);
  const size_t hstepA = (size_t)HALF * g.lda * 2, hstepB = (size_t)HALF * g.ldb * 2;
  const size_t tstepA = 2 * hstepA, tstepB = 2 * hstepB;
  const unsigned ldsw = (unsigned)wid * 1024u;
  const int aoff = lds_byte(wr * 64 + fr, fq * 8), boff = lds_byte(wc * 32 + fr, fq * 8);
#define PG8_SA(b, h) (((b) * 2 + (h)) * HTB)
#define PG8_SB(b, h) ((4 + (b) * 2 + (h)) * HTB)
#define PG8_STAGE(bufoff, gbase, voff) do { _Pragma("unroll") for (int _i = 0; _i < 2; ++_i) \
        __builtin_amdgcn_global_load_lds((const unsigned*)((const char*)(gbase) + (voff)[_i]), (LAS unsigned*)(lds + (bufoff) + ldsw + _i * 8192), 16, 0, 0); } while (0)
#define PG8_LDA(dst, b, h) do { _Pragma("unroll") for (int m = 0; m < 4; ++m) _Pragma("unroll") for (int k = 0; k < 2; ++k) dst[m][k] = *(const LAS bf16x8*)(lds + PG8_SA(b, h) + aoff + m * 2048 + k * 1024); } while (0)
#define PG8_LDB(dst, b, h) do { _Pragma("unroll") for (int n = 0; n < 2; ++n) _Pragma("unroll") for (int k = 0; k < 2; ++k) dst[n][k] = *(const LAS bf16x8*)(lds + PG8_SB(b, h) + boff + n * 2048 + k * 1024); } while (0)
#define PG8_MMA(ai, bj, At, Bt) do { __builtin_amdgcn_s_setprio(1); _Pragma("unroll") for (int m = 0; m < 4; ++m) _Pragma("unroll") for (int n = 0; n < 2; ++n) _Pragma("unroll") for (int k = 0; k < 2; ++k) \
        acc[ai][bj][m][n] = __builtin_amdgcn_mfma_f32_16x16x32_bf16(Bt[n][k], At[m][k], acc[ai][bj][m][n], 0, 0, 0); __builtin_amdgcn_s_setprio(0); } while (0)
#define PG8_WAIT_V(n) asm volatile("s_waitcnt vmcnt(" #n ")" ::: "memory")
#define PG8_WAIT_L(n) asm volatile("s_waitcnt lgkmcnt(" #n ")" ::: "memory")
#define PG8_BAR __builtin_amdgcn_s_barrier()
#define PG8_SCHED __builtin_amdgcn_sched_barrier(0)
  Unit cur, nxt; int ui = 0;
  if (!S.next(0, cur)) return;
  f32x4 acc[2][2][4][2];
#pragma unroll
  for (int a = 0; a < 2; ++a)
#pragma unroll
    for (int b = 0; b < 2; ++b)
#pragma unroll
      for (int m = 0; m < 4; ++m)
#pragma unroll
        for (int n = 0; n < 2; ++n) acc[a][b][m][n] = (f32x4){0.f, 0.f, 0.f, 0.f};
  bf16x8 At[4][2], B0[2][2], B1[2][2];
  const char* cA = (const char*)g.A + (size_t)cur.pm * tstepA; const char* cB = (const char*)g.Bt + (size_t)cur.pn * tstepB;
  PG8_STAGE(PG8_SB(0, 0), cB, voffB); PG8_STAGE(PG8_SB(0, 1), cB + hstepB, voffB); PG8_STAGE(PG8_SA(0, 0), cA, voffA); PG8_STAGE(PG8_SA(0, 1), cA + hstepA, voffA);
  if (wr == 1) PG8_BAR;
  PG8_WAIT_V(2); PG8_BAR;
  PG8_STAGE(PG8_SB(1, 0), cB + kstep, voffB); PG8_STAGE(PG8_SA(1, 0), cA + kstep, voffA); PG8_STAGE(PG8_SB(1, 1), cB + hstepB + kstep, voffB);
  PG8_WAIT_V(6); PG8_BAR;
  for (;;) {
    const bool has_next = S.next(ui + 1, nxt);
    const char* nA = has_next ? (const char*)g.A + (size_t)nxt.pm * tstepA : cA; const char* nB = has_next ? (const char*)g.Bt + (size_t)nxt.pn * tstepB : cB;
    for (int t = 0; t < nt; t += 2) {
      const bool last = (t == nt - 2);
      const char* a1 = cA + (size_t)(t + 1) * kstep;
      const char* a2 = last ? nA : cA + (size_t)(t + 2) * kstep; const char* b2 = last ? nB : cB + (size_t)(t + 2) * kstep;
      const char* a3 = a2 + kstep; const char* b3 = b2 + kstep;
      PG8_LDB(B0, 0, 0); PG8_LDB(B1, 0, 1); PG8_SCHED; PG8_LDA(At, 0, 0); PG8_STAGE(PG8_SA(1, 1), a1 + hstepA, voffA);
      PG8_WAIT_V(8); PG8_WAIT_L(0); PG8_BAR; PG8_MMA(0, 0, At, B0); PG8_MMA(0, 1, At, B1); PG8_BAR; PG8_SCHED;
      PG8_LDA(At, 0, 1); PG8_STAGE(PG8_SB(0, 0), b2, voffB); PG8_STAGE(PG8_SB(0, 1), b2 + hstepB, voffB); PG8_STAGE(PG8_SA(0, 0), a2, voffA);
      PG8_WAIT_V(8); PG8_WAIT_L(0); PG8_BAR; PG8_MMA(1, 0, At, B0); PG8_MMA(1, 1, At, B1); PG8_BAR; PG8_SCHED;
      PG8_LDB(B0, 1, 0); PG8_LDB(B1, 1, 1); PG8_SCHED; PG8_LDA(At, 1, 0); PG8_STAGE(PG8_SA(0, 1), a2 + hstepA, voffA);
      PG8_WAIT_V(8); PG8_WAIT_L(0); PG8_BAR; PG8_MMA(0, 0, At, B0); PG8_MMA(0, 1, At, B1); PG8_BAR; PG8_SCHED;
      PG8_LDA(At, 1, 1); PG8_STAGE(PG8_SB(1, 0), b3, voffB); PG8_STAGE(PG8_SB(1, 1), b3 + hstepB, voffB); PG8_STAGE(PG8_SA(1, 0), a3, voffA);
      PG8_WAIT_V(8); PG8_WAIT_L(0); PG8_BAR; PG8_MMA(1, 0, At, B0); PG8_MMA(1, 1, At, B1); PG8_BAR; PG8_SCHED;
    }
    if constexpr (!Epi::AFTER_DRAIN) { if (wr == 0) PG8_BAR;
      E(acc, cur, wr, wc, fr, fq); }
    if (!has_next) break;
#pragma unroll
    for (int a = 0; a < 2; ++a)
#pragma unroll
      for (int b = 0; b < 2; ++b)
#pragma unroll
        for (int m = 0; m < 4; ++m)
#pragma unroll
          for (int n = 0; n < 2; ++n) acc[a][b][m][n] = (f32x4){0.f, 0.f, 0.f, 0.f};
    cur = nxt; cA = nA; cB = nB; ++ui;
    if constexpr (!Epi::AFTER_DRAIN) { if (wr == 1) PG8_BAR; }
  }
  PG8_WAIT_V(0);
  if constexpr (Epi::AFTER_DRAIN) { if (wr == 0) PG8_BAR; }
  PG8_BAR;
  if constexpr (Epi::AFTER_DRAIN) E.fused(acc, cur, lds, tid, wr, wc, fr, fq);
#undef PG8_SA
#undef PG8_SB
#undef PG8_STAGE
#undef PG8_LDA
#undef PG8_LDB
#undef PG8_MMA
#undef PG8_WAIT_V
#undef PG8_WAIT_L
#undef PG8_BAR
#undef PG8_SCHED
}

typedef f32x4 AccT[2][2][4][2];

DI void rope128(f32x4& v0, f32x4& v1, const float* ropeA, int pos, int fq) {
  const f32x4 cs = *(const f32x4*)(ropeA + pos * 32 + 4 * fq), sn = *(const f32x4*)(ropeA + pos * 32 + 16 + 4 * fq);
#pragma unroll
  for (int j = 0; j < 4; ++j) { const float x1 = v0[j], x2 = v1[j]; v0[j] = x1 * cs[j] - x2 * sn[j]; v1[j] = x2 * cs[j] + x1 * sn[j]; }
}
DI void store_vt(bf16_t* base  , int d0, int pos, const f32x4& v) {
#pragma unroll
  for (int j = 0; j < 4; ++j) base[(size_t)(d0 + j) * SL + pos] = f2bf(v[j]);
}

struct EpiIn {
  static constexpr bool PERM = false, AFTER_DRAIN = false;
  bf16_t* h; bf16_t* bvT; bf16_t* cvT; const float* ropeA; const float* ropeI;
  DI void operator()(const AccT& acc, const Unit& u, int wr, int wc, int fr, int fq) const {
#pragma unroll
    for (int bj = 0; bj < 2; ++bj) {
      const int cb = u.pn * 2 + bj;
      int type;
      if (cb < 8) type = 1; else if (cb < 12) type = 0; else if (cb < 20) type = 2; else if (cb < 28) type = 1;
      else if (cb < 40) { const int idx = cb - 28, br = idx >> 2, kv = (idx >> 1) & 1; type = kv == 0 ? 1 : (br == 0 ? 0 : 4); }
      else if (cb < 56) type = 1; else if (cb < 64) type = 5; else type = 6;
#pragma unroll
      for (int ai = 0; ai < 2; ++ai)
#pragma unroll
        for (int m = 0; m < 4; ++m) {
          const int row = u.pm * BM + ai * HALF + wr * 64 + m * 16 + fr, pos = row & (SL - 1), b = row >> 12;
          f32x4 v0 = acc[ai][bj][m][0], v1 = acc[ai][bj][m][1];
          const int cin = wc * 32 + 4 * fq;
          if (type == 1) { if (wc == 0) rope128(v0, v1, ropeA, pos, fq); }
          else if (type == 2) { if ((wc & 1) == 0) {
              const f32x4 cs = *(const f32x4*)(ropeI + pos * 16 + 4 * (fq & 1)), sn = *(const f32x4*)(ropeI + pos * 16 + 8 + 4 * (fq & 1));
#pragma unroll
              for (int j = 0; j < 4; ++j) { const float mine = v0[j], oth = __shfl_xor(mine, 32);
                v0[j] = fq < 2 ? mine * cs[j] - oth * sn[j] : mine * cs[j] + oth * sn[j]; } } }
          else if (type == 6) { for (int j = 0; j < 4; ++j) { v0[j] = sigm(v0[j]); v1[j] = sigm(v1[j]); } }
          if (type == 4) { const int idx = cb - 28, br = idx >> 2, gg = idx & 1; bf16_t* base = bvT + (size_t)(((b * 2 + (br - 1)) * 2 + gg) * 128) * SL;
            store_vt(base, cin, pos, v0); store_vt(base, cin + 16, pos, v1); }
          else if (type == 5) { const int idx = cb - 56; bf16_t* base = cvT + (size_t)((b * 4 + (idx >> 1)) * 256 + (idx & 1) * 128) * SL;
            store_vt(base, cin, pos, v0); store_vt(base, cin + 16, pos, v1); }
          else { bf16_t* dp = h + (size_t)row * NPHYS + cb * 128 + cin;
            *(u32x2*)dp = (u32x2){cvtpk(v0[0], v0[1]), cvtpk(v0[2], v0[3])}; *(u32x2*)(dp + 16) = (u32x2){cvtpk(v1[0], v1[1]), cvtpk(v1[2], v1[3])}; }
        }
    }
  }
};

struct EpiAup {
  static constexpr bool PERM = false, AFTER_DRAIN = false;
  bf16_t* ak; bf16_t* avT; const float* srow; const float* ropeA;
  DI void operator()(const AccT& acc, const Unit& u, int wr, int wc, int fr, int fq) const {
#pragma unroll
    for (int bj = 0; bj < 2; ++bj) {
      const int cb = u.pn * 2 + bj;
#pragma unroll
      for (int ai = 0; ai < 2; ++ai)
#pragma unroll
        for (int m = 0; m < 4; ++m) {
          const int row = u.pm * BM + ai * HALF + wr * 64 + m * 16 + fr, pos = row & (SL - 1), b = row >> 12;
          const float s = srow[row];
          f32x4 v0 = acc[ai][bj][m][0] * s, v1 = acc[ai][bj][m][1] * s;
          const int cin = wc * 32 + 4 * fq;
          if (cb < 8) { if (wc == 0) rope128(v0, v1, ropeA, pos, fq);
            bf16_t* dp = ak + (size_t)row * 1024 + cb * 128 + cin;
            *(u32x2*)dp = (u32x2){cvtpk(v0[0], v0[1]), cvtpk(v0[2], v0[3])}; *(u32x2*)(dp + 16) = (u32x2){cvtpk(v1[0], v1[1]), cvtpk(v1[2], v1[3])}; }
          else { bf16_t* base = avT + (size_t)((b * 8 + (cb - 8)) * 128) * SL; store_vt(base, cin, pos, v0); store_vt(base, cin + 16, pos, v1); }
        }
    }
  }
};

struct EpiF32 {
  static constexpr bool PERM = false, AFTER_DRAIN = false;
  float* C; int ldc;
  DI void operator()(const AccT& acc, const Unit& u, int wr, int wc, int fr, int fq) const {
#pragma unroll
    for (int ai = 0; ai < 2; ++ai)
#pragma unroll
      for (int m = 0; m < 4; ++m) { float* rowp = C + (size_t)(u.pm * BM + ai * HALF + wr * 64 + m * 16 + fr) * ldc + u.pn * BM + wc * 32 + 4 * fq;
#pragma unroll
        for (int bj = 0; bj < 2; ++bj)
#pragma unroll
          for (int n = 0; n < 2; ++n) *(f32x4*)(rowp + bj * HALF + n * 16) = acc[ai][bj][m][n]; }
  }
};

struct EpiHalfF32 {
  static constexpr bool PERM = false, AFTER_DRAIN = false;
  float* C;
  DI void operator()(const AccT& acc, const Unit& u, int wr, int wc, int fr, int fq) const {
#pragma unroll
    for (int ai = 0; ai < 2; ++ai)
#pragma unroll
      for (int m = 0; m < 4; ++m) { float* rowp = C + (size_t)(u.pm * BM + ai * HALF + wr * 64 + m * 16 + fr) * 128 + wc * 32 + 4 * fq;
#pragma unroll
        for (int n = 0; n < 2; ++n) *(f32x4*)(rowp + n * 16) = acc[ai][0][m][n]; }
  }
};

struct EpiGate {
  static constexpr bool PERM = true, AFTER_DRAIN = false;
  const bf16_t* h; float* tmp; bf16_t* merged; int r;
  DI void operator()(const AccT& acc, const Unit& u, int wr, int wc, int fr, int fq) const {
#pragma unroll
    for (int ai = 0; ai < 2; ++ai)
#pragma unroll
      for (int m = 0; m < 4; ++m) {
        const int row = u.pm * BM + ai * HALF + wr * 64 + m * 16 + fr;
#pragma unroll
        for (int bj = 0; bj < 2; ++bj) {
          const int c8 = u.pn * BM + bj * HALF + wc * 32 + 8 * fq;
          const bf16x8 gt = *(const bf16x8*)(h + (size_t)row * NPHYS + H_GL + r * 2048 + c8);
          bf16_t* mp = merged + (size_t)row * DM + c8;
          f32x4 a0 = acc[ai][bj][m][0], a1 = acc[ai][bj][m][1];
#pragma unroll
          for (int j = 0; j < 4; ++j) { a0[j] *= bf2f((bf16_t)gt[j]); a1[j] *= bf2f((bf16_t)gt[4 + j]); }
          if (r > 0) { const bf16x8 pv = *(const bf16x8*)mp;
#pragma unroll
            for (int j = 0; j < 4; ++j) { a0[j] += bf2f((bf16_t)pv[j]); a1[j] += bf2f((bf16_t)pv[4 + j]); } }
          { u32x4 w = {cvtpk(a0[0], a0[1]), cvtpk(a0[2], a0[3]), cvtpk(a1[0], a1[1]), cvtpk(a1[2], a1[3])}; *(u32x4*)mp = w; }
        }
      }
  }
};

struct EpiRes {
  static constexpr bool PERM = false, AFTER_DRAIN = false;
  const float* xin; const float* gv  ; float* z;
  DI void operator()(const AccT& acc, const Unit& u, int wr, int wc, int fr, int fq) const {
#pragma unroll
    for (int ai = 0; ai < 2; ++ai)
#pragma unroll
      for (int m = 0; m < 4; ++m) {
        const int row = u.pm * BM + ai * HALF + wr * 64 + m * 16 + fr, b = row >> 12;
#pragma unroll
        for (int bj = 0; bj < 2; ++bj)
#pragma unroll
          for (int n = 0; n < 2; ++n) { const int c = u.pn * BM + bj * HALF + wc * 32 + n * 16 + 4 * fq;
            const f32x4 xv = *(const f32x4*)(xin + (size_t)row * DM + c), g = *(const f32x4*)(gv + b * 12288 + c);
            f32x4 o; for (int j = 0; j < 4; ++j) o[j] = ALPHA * xv[j] + g[j] * acc[ai][bj][m][n][j];
            *(f32x4*)(z + (size_t)row * DM + c) = o; }
      }
  }
};


DI void ln_exchange(const AccT& acc, LAS float* red, float* stats, unsigned* cnt, int pm, int pn, int tid, int wr, int wc, int fr, int fq) {
#pragma unroll
  for (int ai = 0; ai < 2; ++ai)
#pragma unroll
    for (int m = 0; m < 4; ++m) {
      float s1 = 0.f, s2 = 0.f;
#pragma unroll
      for (int bj = 0; bj < 2; ++bj)
#pragma unroll
        for (int n = 0; n < 2; ++n)
#pragma unroll
          for (int j = 0; j < 4; ++j) { const float x = acc[ai][bj][m][n][j]; s1 += x; s2 += x * x; }
      s1 += __shfl_xor(s1, 16); s2 += __shfl_xor(s2, 16); s1 += __shfl_xor(s1, 32); s2 += __shfl_xor(s2, 32);
      if (fq == 0) { const int rl = ai * 128 + wr * 64 + m * 16 + fr; red[(rl * 4 + wc) * 2] = s1; red[(rl * 4 + wc) * 2 + 1] = s2; }
    }
  __syncthreads();
  if (tid < 256) { float a = 0.f, b = 0.f;
#pragma unroll
    for (int w = 0; w < 4; ++w) { a += red[(tid * 4 + w) * 2]; b += red[(tid * 4 + w) * 2 + 1]; }
    float* sp = stats + ((size_t)(pm * 256 + tid) * 8 + pn) * 2;
    __hip_atomic_store(sp, a, __ATOMIC_RELAXED, __HIP_MEMORY_SCOPE_AGENT); __hip_atomic_store(sp + 1, b, __ATOMIC_RELAXED, __HIP_MEMORY_SCOPE_AGENT); }
  asm volatile("s_waitcnt vmcnt(0)" ::: "memory");
  __syncthreads();
  if (tid == 0) {
    __builtin_amdgcn_fence(__ATOMIC_RELEASE, "agent");
    asm volatile("s_waitcnt vmcnt(0)" ::: "memory");
    __hip_atomic_fetch_add(cnt + pm, 1u, __ATOMIC_RELAXED, __HIP_MEMORY_SCOPE_AGENT);
    unsigned sp_ = 0;
    while (__hip_atomic_load(cnt + pm, __ATOMIC_RELAXED, __HIP_MEMORY_SCOPE_AGENT) < 8u) { __builtin_amdgcn_s_sleep(1); if (++sp_ > (1u << 24)) break; }
    __builtin_amdgcn_fence(__ATOMIC_ACQUIRE, "agent");
    asm volatile("s_waitcnt vmcnt(0)" ::: "memory");
  }
  __syncthreads();
  if (tid < 256) { float a = 0.f, b = 0.f; const float* sp = stats + (size_t)(pm * 256 + tid) * 16;
#pragma unroll
    for (int w = 0; w < 8; ++w) { a += __hip_atomic_load(sp + 2 * w, __ATOMIC_RELAXED, __HIP_MEMORY_SCOPE_AGENT); b += __hip_atomic_load(sp + 2 * w + 1, __ATOMIC_RELAXED, __HIP_MEMORY_SCOPE_AGENT); }
    const float mean = a * (1.f / DM), var = fmaxf(b * (1.f / DM) - mean * mean, 0.f);
    red[2048 + tid * 2] = mean; red[2048 + tid * 2 + 1] = rsqrtf(var + 1e-5f); }
  __syncthreads();
}

struct EpiLnFused {
  static constexpr bool PERM = false, AFTER_DRAIN = true;
  const float* xin; const float* gv; const float* gam; const float* bet; float* xout;
  const float* modn; int sh_idx, sc_idx; bf16_t* uout;
  float* stats; unsigned* cnt;
  DI void operator()(const AccT&, const Unit&, int, int, int, int) const {}
  DI void fused(AccT& acc, const Unit& u, LAS unsigned char* lds, int tid, int wr, int wc, int fr, int fq) const {
    LAS float* red = (LAS float*)lds;
    const int row0 = u.pm * BM + wr * 64 + fr, col0 = u.pn * BM + wc * 32 + 4 * fq, b = (u.pm * BM) >> 12;
    { f32x4 g[2][2], xc[2][2], xn[2][2];
#pragma unroll
      for (int bj = 0; bj < 2; ++bj)
#pragma unroll
        for (int n = 0; n < 2; ++n) g[bj][n] = *(const f32x4*)(gv + b * 12288 + col0 + bj * HALF + n * 16);
      { const float* xr = xin + (size_t)row0 * DM + col0;
#pragma unroll
        for (int bj = 0; bj < 2; ++bj)
#pragma unroll
          for (int n = 0; n < 2; ++n) xc[bj][n] = *(const f32x4*)(xr + bj * HALF + n * 16); }
#pragma unroll
      for (int k = 0; k < 8; ++k) { const int ai = k >> 2, m = k & 3;
        if (k < 7) { const int k1 = k + 1; const float* xr = xin + (size_t)(row0 + (k1 >> 2) * HALF + (k1 & 3) * 16) * DM + col0; asm volatile("" : "+v"(xr));
#pragma unroll
          for (int bj = 0; bj < 2; ++bj)
#pragma unroll
            for (int n = 0; n < 2; ++n) xn[bj][n] = *(const f32x4*)(xr + bj * HALF + n * 16); }
#pragma unroll
        for (int bj = 0; bj < 2; ++bj)
#pragma unroll
          for (int n = 0; n < 2; ++n)
#pragma unroll
            for (int j = 0; j < 4; ++j) acc[ai][bj][m][n][j] = ALPHA * xc[bj][n][j] + g[bj][n][j] * acc[ai][bj][m][n][j];
        asm volatile("" :: "v"(acc[ai][0][m][0]), "v"(acc[ai][0][m][1]), "v"(acc[ai][1][m][0]), "v"(acc[ai][1][m][1]));
#pragma unroll
        for (int bj = 0; bj < 2; ++bj)
#pragma unroll
          for (int n = 0; n < 2; ++n) xc[bj][n] = xn[bj][n]; } }
    ln_exchange(acc, red, stats, cnt, u.pm, u.pn, tid, wr, wc, fr, fq);
    { f32x4 g[2][2], bb[2][2];
#pragma unroll
      for (int bj = 0; bj < 2; ++bj)
#pragma unroll
        for (int n = 0; n < 2; ++n) { g[bj][n] = *(const f32x4*)(gam + col0 + bj * HALF + n * 16); bb[bj][n] = *(const f32x4*)(bet + col0 + bj * HALF + n * 16); }
#pragma unroll
      for (int ai = 0; ai < 2; ++ai)
#pragma unroll
        for (int m = 0; m < 4; ++m) { const int rl = ai * 128 + wr * 64 + m * 16 + fr; const float mean = red[2048 + rl * 2], rstd = red[2048 + rl * 2 + 1];
          float* xo = xout + (size_t)(u.pm * BM + rl) * DM + col0;
#pragma unroll
          for (int bj = 0; bj < 2; ++bj)
#pragma unroll
            for (int n = 0; n < 2; ++n) { f32x4 o;
#pragma unroll
              for (int j = 0; j < 4; ++j) { o[j] = (acc[ai][bj][m][n][j] - mean) * rstd * g[bj][n][j] + bb[bj][n][j]; acc[ai][bj][m][n][j] = o[j]; }
              *(f32x4*)(xo + bj * HALF + n * 16) = o; } } }
    if (uout) {
      __syncthreads();
      ln_exchange(acc, red, stats + (size_t)32 * 256 * 16, cnt + 32, u.pm, u.pn, tid, wr, wc, fr, fq);
      f32x4 sc[2][2], sh[2][2];
#pragma unroll
      for (int bj = 0; bj < 2; ++bj)
#pragma unroll
        for (int n = 0; n < 2; ++n) { sc[bj][n] = *(const f32x4*)(modn + b * 12288 + sc_idx * 2048 + col0 + bj * HALF + n * 16); sh[bj][n] = *(const f32x4*)(modn + b * 12288 + sh_idx * 2048 + col0 + bj * HALF + n * 16); }
#pragma unroll
      for (int ai = 0; ai < 2; ++ai)
#pragma unroll
        for (int m = 0; m < 4; ++m) { const int rl = ai * 128 + wr * 64 + m * 16 + fr; const float mean = red[2048 + rl * 2], rstd = red[2048 + rl * 2 + 1];
          bf16_t* uo = uout + (size_t)(u.pm * BM + rl) * DM + col0;
#pragma unroll
          for (int bj = 0; bj < 2; ++bj)
#pragma unroll
            for (int n = 0; n < 2; ++n) { float o[4];
#pragma unroll
              for (int j = 0; j < 4; ++j) o[j] = (acc[ai][bj][m][n][j] - mean) * rstd * (1.f + sc[bj][n][j]) + sh[bj][n][j];
              *(u32x2*)(uo + bj * HALF + n * 16) = (u32x2){cvtpk(o[0], o[1]), cvtpk(o[2], o[3])}; } }
    }
    __syncthreads();
  }
};

struct EpiSwiglu {
  static constexpr bool PERM = false, AFTER_DRAIN = false;
  bf16_t* hid;
  DI void operator()(const AccT& acc, const Unit& u, int wr, int wc, int fr, int fq) const {
#pragma unroll
    for (int ai = 0; ai < 2; ++ai)
#pragma unroll
      for (int m = 0; m < 4; ++m) {
        const int row = u.pm * BM + ai * HALF + wr * 64 + m * 16 + fr;
#pragma unroll
        for (int bj = 0; bj < 2; ++bj) { const int hc = (u.pn * BM + bj * HALF + wc * 32) / 2 + 4 * fq;
          const f32x4 g = acc[ai][bj][m][0], up = acc[ai][bj][m][1];
          float o[4]; for (int j = 0; j < 4; ++j) o[j] = silu(g[j]) * up[j];
          *(u32x2*)(hid + (size_t)row * DFF + hc) = (u32x2){cvtpk(o[0], o[1]), cvtpk(o[2], o[3])}; }
      }
  }
};

DI int fetch_item(unsigned* ctr0, int* slot) {
  __syncthreads();
  unsigned long long ca = (unsigned long long)ctr0; asm volatile("" : "+s"(ca));
  unsigned* ctr = (unsigned*)ca;
  if (ltid() == 0) *slot = (int)atomicAdd(ctr, 1u);
  __syncthreads();
  return *slot;
}

DI void idxsel_phase(unsigned char* lds, const bf16_t* __restrict__ hbuf, const bf16_t* __restrict__ ikn, const float* __restrict__ iwf, u64* __restrict__ bits, unsigned* ctr) {
  const int tid = ltid(), wid = tid >> 6, lane = tid & 63, i32 = lane & 31, kh = lane >> 5;
  int* slot = (int*)(lds + SLOT_OFF);
  LAS float* sc_l = (LAS float*)(LAS unsigned char*)lds;
  const int qi = (i32 >> 2) & 1, hd = (i32 & 3) + 4 * (i32 >> 3);
  for (;;) {
    const int it = fetch_item(ctr, slot);
    if (it >= 1024) break;
    const int b = it & 1, jq = 511 - (it >> 1), t0 = b * SL + 8 * jq, ntile = (8 * jq + 8 + 31) >> 5;
    { bf16x8 a[4][4]; f32x4 w[4][4];
#pragma unroll
      for (int u = 0; u < 4; ++u) {
        const bf16_t* ap = hbuf + (size_t)(t0 + 2 * u + qi) * NPHYS + H_IQ + hd * 64 + kh * 8;
        const float* wp = iwf + (size_t)(t0 + 2 * u + kh) * 16;
#pragma unroll
        for (int ks = 0; ks < 4; ++ks) { a[u][ks] = *(const bf16x8*)(ap + ks * 16); w[u][ks] = *(const f32x4*)(wp + 4 * ks); }
      }
      if (wid < ntile) {
        const bf16_t* kp = ikn + (size_t)(b * SL + 32 * wid + i32) * 64 + kh * 8;
        bf16x8 nb[4];
#pragma unroll
        for (int ks = 0; ks < 4; ++ks) nb[ks] = *(const bf16x8*)(kp + ks * 16);
        for (int kt = wid; kt < ntile; kt += 8) {
          bf16x8 bfr[4];
#pragma unroll
          for (int ks = 0; ks < 4; ++ks) bfr[ks] = nb[ks];
          if (kt + 8 < ntile) { kp += 8 * 32 * 64;
#pragma unroll
            for (int ks = 0; ks < 4; ++ks) nb[ks] = *(const bf16x8*)(kp + ks * 16); }
#pragma unroll
          for (int u = 0; u < 4; ++u) {
            f32x16 acc = {};
#pragma unroll
            for (int ks = 0; ks < 4; ++ks) acc = __builtin_amdgcn_mfma_f32_32x32x16_bf16(a[u][ks], bfr[ks], acc, 0, 0, 0);
            float sc = 0.f;
#pragma unroll
            for (int r4 = 0; r4 < 4; ++r4)
#pragma unroll
              for (int jj = 0; jj < 4; ++jj) sc += fmaxf(acc[4 * r4 + jj], 0.f) * w[u][r4][jj];
            sc_l[(2 * u + kh) * 4096 + 32 * kt + i32] = sc;
          }
        }
      }
    }
    __syncthreads();
    { const int t = 8 * jq + wid, row = t0 + wid;
      const LAS float* sr = sc_l + wid * 4096;
      unsigned key[64];
#pragma unroll
      for (int i = 0; i < 64; ++i) { const int sidx = 64 * i + lane; unsigned k = 0;
        if (sidx <= t) { const unsigned uu = __float_as_uint(sr[sidx]); k = (uu & 0x80000000u) ? ~uu : (uu | 0x80000000u); }
        key[i] = k; }
      unsigned thr = 0;
      if (t + 1 > 256) {
        for (int bit = 31; bit >= 0; --bit) {
          const unsigned cand = thr | (1u << bit);
          int cnt = 0;
#pragma unroll
          for (int i = 0; i < 64; ++i) cnt += __popcll(__ballot(key[i] >= cand));
          if (cnt >= 256) thr = cand;
          if (cnt == 256) break;
        }
      }
      u64 mine = 0;
#pragma unroll
      for (int i = 0; i < 64; ++i) { const int sidx = 64 * i + lane; const u64 wv = __ballot(sidx <= t && key[i] >= thr); if (lane == i) mine = wv; }
      bits[(size_t)row * 64 + lane] = mine;
    }
  }
}

enum { M_CAUSAL = 0, M_WINDOW = 1, M_BITS = 2, M_SLC = 3, M_CMP = 4 };
DI u64 cmask(int n) { return n >= 64 ? ~0ull : (n <= 0 ? 0ull : ((1ull << n) - 1ull)); }

template <int MODE, int DV>
DI void attn_core(LAS unsigned char* lds, const bf16_t* __restrict__ Qp, int ldq, const bf16_t* __restrict__ Kp, int ldk, const bf16_t* __restrict__ Vtp, int ldv,
                  int tq0, int jt_lo, int jt_hi, const u64* __restrict__ mk, float* __restrict__ pdump, f32x16 (&o)[DV / 32], float& m_out, float& l_out) {
  constexpr int ND = DV / 32, VBYTES = DV * 136, KBAT = DV == 256 ? 1 : 4, VBAT = DV == 256 ? 1 : 2;
  const int tid = ltid(), wid = tid >> 6, lane = tid & 63, r32 = lane & 31, hi = lane >> 5;
  const int tq = tq0 + wid * 32 + r32;
  constexpr int NQR = DV == 256 ? 4 : 8;
  const bf16_t* qlane = Qp + (size_t)(wid * 32 + r32) * ldq + hi * 8;
  bf16x8 qr[NQR];
#pragma unroll
  for (int d0 = 0; d0 < NQR; ++d0) qr[d0] = *(const bf16x8*)(qlane + d0 * 16);
  LAS float* wsc = (LAS float*)(lds + 34816 + 2 * VBYTES) + wid * 64;
  const int krow = tid >> 3, kc16 = tid & 7, vrow = tid >> 2, vc = tid & 3;
  bf16x8 sk0, sk1, sv0, sv1;
#define AT_LOAD_K(jt) do { const bf16_t* kp_ = Kp + (size_t)((jt) * 64 + krow) * ldk + kc16 * 8; sk0 = *(const bf16x8*)kp_; sk1 = *(const bf16x8*)(kp_ + 64); } while (0)
#define AT_LOAD_V(jt, half) do { const bf16_t* vp_ = Vtp + (size_t)(vrow + 128 * (half)) * ldv + (jt) * 64 + vc * 8; sv0 = *(const bf16x8*)vp_; sv1 = *(const bf16x8*)(vp_ + 32); } while (0)
#define AT_WRITE_K(buf) do { LAS unsigned char* kb_ = lds + (buf) * 17408 + krow * 272 + kc16 * 16; *(LAS bf16x8*)kb_ = sk0; *(LAS bf16x8*)(kb_ + 128) = sk1; } while (0)
#define AT_WRITE_V(buf, half) do { LAS unsigned char* vb_ = lds + 34816 + (buf) * VBYTES + (vrow + 128 * (half)) * 136 + vc * 16; \
    *(LAS s16x4*)vb_ = __builtin_shufflevector(sv0, sv0, 0, 1, 2, 3); *(LAS s16x4*)(vb_ + 8) = __builtin_shufflevector(sv0, sv0, 4, 5, 6, 7); \
    *(LAS s16x4*)(vb_ + 64) = __builtin_shufflevector(sv1, sv1, 0, 1, 2, 3); *(LAS s16x4*)(vb_ + 72) = __builtin_shufflevector(sv1, sv1, 4, 5, 6, 7); } while (0)
  float m_reg = -1e30f, l_reg = 0.f;
#pragma unroll
  for (int d = 0; d < ND; ++d) o[d] = (f32x16){};
  u64 selw = 0;
  if (MODE == M_SLC) selw = mk[wid * 32 + r32];
  const int tcmp = tq >= 31 ? ((tq - 31) >> 4) : -1;
  const bool trail_ = __builtin_amdgcn_readfirstlane(wid) >= 4;
  if (trail_) __builtin_amdgcn_s_setprio(1);
  AT_LOAD_K(jt_lo); AT_LOAD_V(jt_lo, 0); AT_WRITE_K(0); AT_WRITE_V(0, 0);
  if (DV == 256) { AT_LOAD_V(jt_lo, 1); AT_WRITE_V(0, 1); }
  __syncthreads();
  int cur = 0;
  for (int jt = jt_lo; jt < jt_hi; ++jt) {
    const bool pre = jt + 1 < jt_hi;
    bf16x8 qx[4];
    if (DV == 256) { const bf16_t* q2 = qlane; asm volatile("" : "+v"(q2));
#pragma unroll
      for (int u = 0; u < 4; ++u) qx[u] = *(const bf16x8*)(q2 + (4 + u) * 16); }
    if (pre) { AT_LOAD_K(jt + 1); AT_LOAD_V(jt + 1, 0); }
    const int kb = jt * 64;
    u64 allow;
    if (MODE == M_CAUSAL) allow = cmask(tq - kb + 1);
    else if (MODE == M_WINDOW) allow = cmask(tq - kb + 1) & ~cmask(tq - 512 - kb + 1);
    else if (MODE == M_BITS) allow = mk[(size_t)(wid * 32 + r32) * 64 + jt] & cmask(tq - kb + 1);
    else if (MODE == M_SLC) allow = ((selw >> jt) & 1ull) ? cmask(tq - kb + 1) : 0ull;
    else allow = cmask(tcmp - kb + 1);
    const bool act = MODE == M_CMP || __any(allow != 0ull);
    bf16x8 pa[4];
    if (act) {
      const LAS unsigned char* Kb = lds + cur * 17408 + r32 * 272 + hi * 16;
      f32x16 p0 = {}, p1 = {};
#pragma unroll
      for (int db = 0; db < 8; db += KBAT) { bf16x8 ka[KBAT], kc[KBAT];
#pragma unroll
        for (int u = 0; u < KBAT; ++u) { ka[u] = *(const LAS bf16x8*)(Kb + (db + u) * 32); kc[u] = *(const LAS bf16x8*)(Kb + 32 * 272 + (db + u) * 32); }
        __builtin_amdgcn_sched_barrier(0);
#pragma unroll
        for (int u = 0; u < KBAT; ++u) { const int d0 = db + u; const bf16x8 qf = d0 < NQR ? qr[d0 < NQR ? d0 : 0] : qx[d0 >= NQR ? d0 - NQR : 0];
          p0 = __builtin_amdgcn_mfma_f32_32x32x16_bf16(ka[u], qf, p0, 0, 0, 0);
          p1 = __builtin_amdgcn_mfma_f32_32x32x16_bf16(kc[u], qf, p1, 0, 0, 0); }
        __builtin_amdgcn_sched_barrier(0); }
      if (pre) AT_WRITE_K(cur ^ 1);
      if (!__all(allow == ~0ull)) {
        const u64 a = ~(allow >> (4 * hi)); const int nlo = (int)(unsigned)a, nhw = (int)(unsigned)(a >> 32);
#pragma unroll
        for (int r = 0; r < 16; ++r) { const int cp = (r & 3) + 8 * (r >> 2);
          const unsigned b0 = ((unsigned)((nlo << (31 - cp)) >> 31) & 0x80000000u) | 0x7f800000u, b1 = ((unsigned)((nhw << (31 - cp)) >> 31) & 0x80000000u) | 0x7f800000u;
          p0[r] = vmin_raw(p0[r], __uint_as_float(b0)); p1[r] = vmin_raw(p1[r], __uint_as_float(b1)); }
      }
      if (MODE == M_CMP) {
        float* pr = pdump + (size_t)(wid * 32 + r32) * 256 + kb + 4 * hi;
#pragma unroll
        for (int g4 = 0; g4 < 4; ++g4) { *(f32x4*)(pr + 8 * g4) = (f32x4){p0[4 * g4], p0[4 * g4 + 1], p0[4 * g4 + 2], p0[4 * g4 + 3]};
          *(f32x4*)(pr + 32 + 8 * g4) = (f32x4){p1[4 * g4], p1[4 * g4 + 1], p1[4 * g4 + 2], p1[4 * g4 + 3]}; }
      }
      float mx = p0[0];
#pragma unroll
      for (int r = 1; r < 16; ++r) mx = fmaxf(mx, p0[r]);
#pragma unroll
      for (int r = 0; r < 16; ++r) mx = fmaxf(mx, p1[r]);
      mx = fmaxf(mx, __shfl_xor(mx, 32));
      float mn = m_reg, alpha = 1.f;
      if (!__all((mx - m_reg) * C2 <= 8.f)) { mn = fmaxf(m_reg, mx); alpha = __builtin_amdgcn_exp2f((m_reg - mn) * C2); m_reg = mn; }
      const float nm = -mn * C2;
      float ps = 0.f;
#pragma unroll
      for (int r = 0; r < 16; ++r) { p0[r] = __builtin_amdgcn_exp2f(fmaf(p0[r], C2, nm)); p1[r] = __builtin_amdgcn_exp2f(fmaf(p1[r], C2, nm)); ps += p0[r] + p1[r]; }
      ps += __shfl_xor(ps, 32);
      l_reg = l_reg * alpha + ps;
      if (__any(alpha < 1.f)) {
        if (hi == 0) wsc[r32] = alpha;
        asm volatile("s_waitcnt lgkmcnt(0)" ::: "memory");
#pragma unroll
        for (int r = 0; r < 16; ++r) { const float al = wsc[crow(r, hi)];
#pragma unroll
          for (int d = 0; d < ND; ++d) o[d][r] *= al; }
        asm volatile("s_waitcnt lgkmcnt(0)" ::: "memory");
      }
      { u32x4 w;
        w = (u32x4){cvtpk(p0[0], p0[1]), cvtpk(p0[2], p0[3]), cvtpk(p0[4], p0[5]), cvtpk(p0[6], p0[7])}; pa[0] = *reinterpret_cast<bf16x8*>(&w);
        w = (u32x4){cvtpk(p0[8], p0[9]), cvtpk(p0[10], p0[11]), cvtpk(p0[12], p0[13]), cvtpk(p0[14], p0[15])}; pa[1] = *reinterpret_cast<bf16x8*>(&w);
        w = (u32x4){cvtpk(p1[0], p1[1]), cvtpk(p1[2], p1[3]), cvtpk(p1[4], p1[5]), cvtpk(p1[6], p1[7])}; pa[2] = *reinterpret_cast<bf16x8*>(&w);
        w = (u32x4){cvtpk(p1[8], p1[9]), cvtpk(p1[10], p1[11]), cvtpk(p1[12], p1[13]), cvtpk(p1[14], p1[15])}; pa[3] = *reinterpret_cast<bf16x8*>(&w); }
    }
    if (pre && !act) AT_WRITE_K(cur ^ 1);
    if (DV == 256 && pre) { AT_WRITE_V(cur ^ 1, 0); AT_LOAD_V(jt + 1, 1); }
    if (act) {
      const LAS unsigned char* Vb = lds + 34816 + cur * VBYTES + r32 * 136 + hi * 8;
#pragma unroll
      for (int dbb = 0; dbb < ND; dbb += VBAT) { bf16x8 vf[VBAT * 4];
#pragma unroll
        for (int u = 0; u < VBAT; ++u)
#pragma unroll
          for (int s = 0; s < 4; ++s) { const int d = dbb + u; const s16x4 lo4 = *(const LAS s16x4*)(Vb + d * 32 * 136 + s * 32), hi4 = *(const LAS s16x4*)(Vb + d * 32 * 136 + s * 32 + 16);
            vf[u * 4 + s] = __builtin_shufflevector(lo4, hi4, 0, 1, 2, 3, 4, 5, 6, 7); }
        __builtin_amdgcn_sched_barrier(0);
#pragma unroll
        for (int u = 0; u < VBAT; ++u)
#pragma unroll
          for (int s = 0; s < 4; ++s) o[dbb + u] = __builtin_amdgcn_mfma_f32_32x32x16_bf16(pa[s], vf[u * 4 + s], o[dbb + u], 0, 0, 0);
        __builtin_amdgcn_sched_barrier(0); }
    }
    if (pre) { AT_WRITE_V(cur ^ 1, DV == 256 ? 1 : 0); }
    __syncthreads();
    cur ^= 1;
  }
  if (trail_) __builtin_amdgcn_s_setprio(0);
  if (hi == 0) wsc[r32] = l_reg;
  asm volatile("s_waitcnt lgkmcnt(0)" ::: "memory");
#pragma unroll
  for (int r = 0; r < 16; ++r) { const float lr = wsc[crow(r, hi)]; const float inv = lr > 0.f ? 1.f / lr : 0.f;
#pragma unroll
    for (int d = 0; d < ND; ++d) o[d][r] *= inv; }
  asm volatile("s_waitcnt lgkmcnt(0)" ::: "memory");
  m_out = m_reg; l_out = l_reg;
#undef AT_LOAD_K
#undef AT_LOAD_V
#undef AT_WRITE_K
#undef AT_WRITE_V
}


template <int MODE>
DI void attn_core_skew(LAS unsigned char* lds, const bf16_t* __restrict__ Qp, int ldq, const bf16_t* __restrict__ Kp, int ldk, const bf16_t* __restrict__ Vtp, int ldv,
                       int tq0, int jt_lo, int jt_hi, const u64* __restrict__ mk, float* __restrict__ pdump, f32x16 (&o)[4], float& m_out, float& l_out) {
  const int tid = ltid(), wid = tid >> 6, lane = tid & 63, r32 = lane & 31, hi = lane >> 5;
  const bool lead = __builtin_amdgcn_readfirstlane(wid) < 4;
  if (!lead) __builtin_amdgcn_s_setprio(1);
  const int tq = tq0 + wid * 32 + r32;
  const bf16_t* qlane = Qp + (size_t)(wid * 32 + r32) * ldq + hi * 8;
  bf16x8 qr[8];
#pragma unroll
  for (int d0 = 0; d0 < 8; ++d0) qr[d0] = *(const bf16x8*)(qlane + d0 * 16);
  LAS float* wsc = (LAS float*)(lds + 34816 + 2 * 17408) + wid * 64;
  const int st = tid & 255, krow = st >> 4, kch = st & 15, vrow = st >> 3, vch = st & 7;
  bf16x8 sgc[4], sgn[4];
#define SK_BAR() do { asm volatile("s_waitcnt lgkmcnt(0)" ::: "memory"); __builtin_amdgcn_s_barrier(); asm volatile("" ::: "memory"); } while (0)
#define SK_LOAD(sg, jt) do { if (lead) { const bf16_t* kp_ = Kp + (size_t)((jt) * 64 + krow) * ldk + kch * 8; \
      _Pragma("unroll") for (int i_ = 0; i_ < 4; ++i_) sg[i_] = *(const bf16x8*)(kp_ + (size_t)(16 * i_) * ldk); } \
    else { const bf16_t* vp_ = Vtp + (size_t)vrow * ldv + (jt) * 64 + vch * 8; \
      _Pragma("unroll") for (int i_ = 0; i_ < 4; ++i_) sg[i_] = *(const bf16x8*)(vp_ + (size_t)(32 * i_) * ldv); } } while (0)
#define SK_WRITE(sg, buf) do { if (lead) { LAS unsigned char* kb_ = lds + (buf) * 17408 + krow * 272 + kch * 16; \
      _Pragma("unroll") for (int i_ = 0; i_ < 4; ++i_) *(LAS bf16x8*)(kb_ + i_ * 16 * 272) = sg[i_]; } \
    else { LAS unsigned char* vb_ = lds + 34816 + (buf) * 17408 + vrow * 136 + vch * 16; \
      _Pragma("unroll") for (int i_ = 0; i_ < 4; ++i_) { *(LAS s16x4*)(vb_ + i_ * 32 * 136) = __builtin_shufflevector(sg[i_], sg[i_], 0, 1, 2, 3); \
        *(LAS s16x4*)(vb_ + i_ * 32 * 136 + 8) = __builtin_shufflevector(sg[i_], sg[i_], 4, 5, 6, 7); } } } while (0)
  float m_reg = -1e30f, l_reg = 0.f;
#pragma unroll
  for (int d = 0; d < 4; ++d) o[d] = (f32x16){};
  u64 selw = 0;
  if (MODE == M_SLC) selw = mk[wid * 32 + r32];
  const int tcmp = tq >= 31 ? ((tq - 31) >> 4) : -1;
  const u64* mrow = mk + (size_t)(wid * 32 + r32) * 64;
  u64 bw = 0; if (MODE == M_BITS) bw = mrow[jt_lo];
  SK_LOAD(sgc, jt_lo); SK_WRITE(sgc, 0);
  if (jt_lo + 1 < jt_hi) SK_LOAD(sgc, jt_lo + 1);
  SK_BAR();
  if (!lead) SK_BAR();
  int cur = 0;
  for (int jt = jt_lo; jt < jt_hi; ++jt) {
    const bool pre = jt + 1 < jt_hi;
    if (jt + 2 < jt_hi) SK_LOAD(sgn, jt + 2);
    u64 bwn = 0; if (MODE == M_BITS && pre) bwn = mrow[jt + 1];
    const int kb = jt * 64;
    u64 allow;
    if (MODE == M_CAUSAL) allow = cmask(tq - kb + 1);
    else if (MODE == M_WINDOW) allow = cmask(tq - kb + 1) & ~cmask(tq - 512 - kb + 1);
    else if (MODE == M_BITS) allow = bw & cmask(tq - kb + 1);
    else if (MODE == M_SLC) allow = ((selw >> jt) & 1ull) ? cmask(tq - kb + 1) : 0ull;
    else allow = cmask(tcmp - kb + 1);
    const bool act = MODE == M_CMP || __any(allow != 0ull);
    f32x16 p0, p1;
    float alpha;
    if (act) {
      alpha = 1.f;
      const LAS unsigned char* Kb = lds + cur * 17408 + r32 * 272 + hi * 16;
#pragma unroll
      for (int db = 0; db < 8; db += 4) { bf16x8 ka[4], kc[4];
#pragma unroll
        for (int u = 0; u < 4; ++u) { ka[u] = *(const LAS bf16x8*)(Kb + (db + u) * 32); kc[u] = *(const LAS bf16x8*)(Kb + 32 * 272 + (db + u) * 32); }
        __builtin_amdgcn_sched_barrier(0);
#pragma unroll
        for (int u = 0; u < 4; ++u) { const f32x16 z = {};
          p0 = __builtin_amdgcn_mfma_f32_32x32x16_bf16(ka[u], qr[db + u], (db + u == 0) ? z : p0, 0, 0, 0);
          p1 = __builtin_amdgcn_mfma_f32_32x32x16_bf16(kc[u], qr[db + u], (db + u == 0) ? z : p1, 0, 0, 0); }
        __builtin_amdgcn_sched_barrier(0); }
      if (!__all(allow == ~0ull)) {
        const u64 a = ~(allow >> (4 * hi)); const int nlo = (int)(unsigned)a, nhw = (int)(unsigned)(a >> 32);
#pragma unroll
        for (int r = 0; r < 16; ++r) { const int cp = (r & 3) + 8 * (r >> 2);
          const unsigned b0 = ((unsigned)((nlo << (31 - cp)) >> 31) & 0x80000000u) | 0x7f800000u, b1 = ((unsigned)((nhw << (31 - cp)) >> 31) & 0x80000000u) | 0x7f800000u;
          p0[r] = vmin_raw(p0[r], __uint_as_float(b0)); p1[r] = vmin_raw(p1[r], __uint_as_float(b1)); }
      }
      if (MODE == M_CMP && __any(allow != 0ull)) {
        LAS float* pw = (LAS float*)(lds + PD_OFF + wid * 8704);
#pragma unroll
        for (int g4 = 0; g4 < 4; ++g4) { *(LAS f32x4*)(pw + r32 * 68 + 8 * g4 + 4 * hi) = (f32x4){p0[4 * g4], p0[4 * g4 + 1], p0[4 * g4 + 2], p0[4 * g4 + 3]};
          *(LAS f32x4*)(pw + r32 * 68 + 32 + 8 * g4 + 4 * hi) = (f32x4){p1[4 * g4], p1[4 * g4 + 1], p1[4 * g4 + 2], p1[4 * g4 + 3]}; }
        asm volatile("s_waitcnt lgkmcnt(0)" ::: "memory");
#pragma unroll
        for (int i = 0; i < 8; ++i) { const int c = i * 64 + lane, row = c >> 4, c16 = c & 15;
          *(f32x4*)(pdump + (size_t)(wid * 32 + row) * 256 + kb + c16 * 4) = *(const LAS f32x4*)(pw + row * 68 + c16 * 4);
        }
      }
      float mx = p0[0];
#pragma unroll
      for (int r = 1; r < 16; ++r) mx = fmaxf(mx, p0[r]);
#pragma unroll
      for (int r = 0; r < 16; ++r) mx = fmaxf(mx, p1[r]);
      mx = fmaxf(mx, __shfl_xor(mx, 32));
      float mn = m_reg;
      if (!__all((mx - m_reg) * C2 <= 8.f)) { mn = fmaxf(m_reg, mx); alpha = __builtin_amdgcn_exp2f((m_reg - mn) * C2); m_reg = mn; }
      const float nm = -mn * C2;
#pragma unroll
      for (int r = 0; r < 16; ++r) { p0[r] = __builtin_amdgcn_exp2f(fmaf(p0[r], C2, nm)); p1[r] = __builtin_amdgcn_exp2f(fmaf(p1[r], C2, nm)); }
    }
    SK_BAR();
    if (act) {
      float ps = 0.f;
#pragma unroll
      for (int r = 0; r < 16; ++r) ps += p0[r] + p1[r];
      ps += __shfl_xor(ps, 32);
      l_reg = l_reg * alpha + ps;
      if (__any(alpha < 1.f)) {
        if (hi == 0) wsc[r32] = alpha;
        asm volatile("s_waitcnt lgkmcnt(0)" ::: "memory");
#pragma unroll
        for (int r = 0; r < 16; ++r) { const float al = wsc[crow(r, hi)];
#pragma unroll
          for (int d = 0; d < 4; ++d) o[d][r] *= al; }
        asm volatile("s_waitcnt lgkmcnt(0)" ::: "memory");
      }
      bf16x8 pa[4];
      { u32x4 w;
        w = (u32x4){cvtpk(p0[0], p0[1]), cvtpk(p0[2], p0[3]), cvtpk(p0[4], p0[5]), cvtpk(p0[6], p0[7])}; pa[0] = *reinterpret_cast<bf16x8*>(&w);
        w = (u32x4){cvtpk(p0[8], p0[9]), cvtpk(p0[10], p0[11]), cvtpk(p0[12], p0[13]), cvtpk(p0[14], p0[15])}; pa[1] = *reinterpret_cast<bf16x8*>(&w);
        w = (u32x4){cvtpk(p1[0], p1[1]), cvtpk(p1[2], p1[3]), cvtpk(p1[4], p1[5]), cvtpk(p1[6], p1[7])}; pa[2] = *reinterpret_cast<bf16x8*>(&w);
        w = (u32x4){cvtpk(p1[8], p1[9]), cvtpk(p1[10], p1[11]), cvtpk(p1[12], p1[13]), cvtpk(p1[14], p1[15])}; pa[3] = *reinterpret_cast<bf16x8*>(&w); }
      const LAS unsigned char* Vb = lds + 34816 + cur * 17408 + r32 * 136 + hi * 8;
#pragma unroll
      for (int dbb = 0; dbb < 4; dbb += 2) { bf16x8 vf[8];
#pragma unroll
        for (int u = 0; u < 2; ++u)
#pragma unroll
          for (int s4 = 0; s4 < 4; ++s4) { const int d = dbb + u; const s16x4 lo4 = *(const LAS s16x4*)(Vb + d * 32 * 136 + s4 * 32), hi4 = *(const LAS s16x4*)(Vb + d * 32 * 136 + s4 * 32 + 16);
            vf[u * 4 + s4] = __builtin_shufflevector(lo4, hi4, 0, 1, 2, 3, 4, 5, 6, 7); }
        __builtin_amdgcn_sched_barrier(0);
#pragma unroll
        for (int u = 0; u < 2; ++u)
#pragma unroll
          for (int s4 = 0; s4 < 4; ++s4) o[dbb + u] = __builtin_amdgcn_mfma_f32_32x32x16_bf16(pa[s4], vf[u * 4 + s4], o[dbb + u], 0, 0, 0);
        __builtin_amdgcn_sched_barrier(0); }
    }
    if (pre) SK_WRITE(sgc, cur ^ 1);
    SK_BAR();
    cur ^= 1; bw = bwn;
#pragma unroll
    for (int i_ = 0; i_ < 4; ++i_) sgc[i_] = sgn[i_];
  }
  if (lead) SK_BAR();
  if (!lead) __builtin_amdgcn_s_setprio(0);
  if (hi == 0) wsc[r32] = l_reg;
  asm volatile("s_waitcnt lgkmcnt(0)" ::: "memory");
#pragma unroll
  for (int r = 0; r < 16; ++r) { const float lr = wsc[crow(r, hi)]; const float inv = lr > 0.f ? 1.f / lr : 0.f;
#pragma unroll
    for (int d = 0; d < 4; ++d) o[d][r] *= inv; }
  asm volatile("s_waitcnt lgkmcnt(0)" ::: "memory");
  m_out = m_reg; l_out = l_reg;
#undef SK_BAR
#undef SK_LOAD
#undef SK_WRITE
}

DI void store_o_bf16(LAS unsigned char* lds, bf16_t* dst, int rowg0, int hcol, const f32x16 (&o)[4]) {
  const int tid_ = ltid(), lane = tid_ & 63, wid = tid_ >> 6, r32 = lane & 31, hi = lane >> 5;
  LAS unsigned char* pw = lds + wid * 8704;
#pragma unroll
  for (int r = 0; r < 16; ++r)
#pragma unroll
    for (int d = 0; d < 4; ++d) *(LAS bf16_t*)(pw + crow(r, hi) * 272 + (d * 32 + r32) * 2) = f2bf(o[d][r]);
  asm volatile("s_waitcnt lgkmcnt(0)" ::: "memory");
#pragma unroll
  for (int i = 0; i < 8; ++i) { const int c = i * 64 + lane, row = c >> 4, c16 = c & 15;
    *(u32x4*)(dst + (size_t)(rowg0 + wid * 32 + row) * 1024 + hcol + c16 * 8) = *(const LAS u32x4*)(pw + row * 272 + c16 * 16); }
  asm volatile("s_waitcnt lgkmcnt(0)" ::: "memory");
}

#define XB_TMO      128
#define XB_XCNT(j)  (256  + 64 * (j))
#define XB_XSUB(j)  (1280 + 64 * (j))
#define XB_XGEN(j)  (2304 + 64 * (j))
#define XB_TOP      3328
#define XB_TOPGEN   3392
#define XCD_BAR_WORDS 3456
#define XB_SPIN_CAP (1u << 22)
DI unsigned xb_ld(unsigned* p)              { return __hip_atomic_load(p, __ATOMIC_RELAXED, __HIP_MEMORY_SCOPE_AGENT); }
DI unsigned xb_add(unsigned* p, unsigned v) { return __hip_atomic_fetch_add(p, v, __ATOMIC_RELAXED, __HIP_MEMORY_SCOPE_AGENT); }
DI unsigned xb_xcc_id() { return (unsigned)__builtin_amdgcn_s_getreg((3 << 11) | 20) & 0xFu; }
#define XB_SPIN(cond, bar) do { unsigned _sp = 0; while (cond) { __builtin_amdgcn_s_sleep(1); \
    if ((++_sp & 255u) == 0u) { if (xb_ld(&(bar)[XB_TMO])) break; if (_sp > XB_SPIN_CAP) { atomicAdd(&(bar)[XB_TMO], 1u); break; } } } } while (0)
struct XcdBarrier { unsigned* bar; unsigned x; volatile LAS unsigned* st; };
DI XcdBarrier xcd_barrier_post(unsigned* bar, volatile LAS unsigned* st) {
  XcdBarrier b; b.bar = bar; b.x = xb_xcc_id(); b.st = st;
  if (threadIdx.x == 0) (void)xb_add(&bar[XB_XCNT(b.x)], 1u);
  return b;
}
DI void xcd_barrier_complete(unsigned* bar, unsigned x, unsigned& nloc, unsigned& nx) {
  const unsigned G = gridDim.x * gridDim.y * gridDim.z;
  unsigned sum, cnt, mine, sp = 0u;
  for (;;) {
    sum = 0u; cnt = 0u; mine = 0u;
#pragma unroll
    for (unsigned j = 0; j < 16; ++j) { const unsigned c = xb_ld(&bar[XB_XCNT(j)]); sum += c; cnt += (c > 0u) ? 1u : 0u; mine = (j == x) ? c : mine; }
    if (sum == G) break;
    __builtin_amdgcn_s_sleep(1);
    if ((++sp & 255u) == 0u) { if (xb_ld(&bar[XB_TMO])) break; if (sp > XB_SPIN_CAP) { atomicAdd(&bar[XB_TMO], 1u); break; } }
  }
  nloc = mine > 0u ? mine : 1u; nx = cnt > 0u ? cnt : 1u;
}
DI void xcd_barrier(const XcdBarrier& b) {
  asm volatile("s_waitcnt vmcnt(0)" ::: "memory");
  __syncthreads();
  if (threadIdx.x == 0) {
    unsigned long long ba_ = (unsigned long long)b.bar; unsigned bx = b.x; asm volatile("" : "+v"(bx));
    unsigned* bar = (unsigned*)ba_;
    __builtin_amdgcn_s_waitcnt(0);
    unsigned nloc = b.st[0], nx = b.st[1];
    if (nloc == 0u) { xcd_barrier_complete(bar, bx, nloc, nx); b.st[0] = nloc; b.st[1] = nx; }
    const unsigned old = xb_add(&bar[XB_XSUB(bx)], 1u);
    const unsigned gen = old / nloc;
    if (old + 1u == (gen + 1u) * nloc) {
      __builtin_amdgcn_fence(__ATOMIC_RELEASE, "agent");
      asm volatile("s_waitcnt vmcnt(0)" ::: "memory");
      const unsigned og = xb_add(&bar[XB_TOP], 1u);
      const unsigned tg = og / nx;
      if (og + 1u == (tg + 1u) * nx) xb_add(&bar[XB_TOPGEN], 1u);
      else XB_SPIN(xb_ld(&bar[XB_TOPGEN]) == tg, bar);
      __builtin_amdgcn_fence(__ATOMIC_ACQUIRE, "agent");
      xb_add(&bar[XB_XGEN(bx)], 1u);
      asm volatile("s_waitcnt vmcnt(0)" ::: "memory");
    } else {
      XB_SPIN(xb_ld(&bar[XB_XGEN(bx)]) == gen, bar);
      __builtin_amdgcn_fence(__ATOMIC_ACQUIRE, "agent");
      asm volatile("s_waitcnt vmcnt(0)" ::: "memory");
    }
  }
  __syncthreads();
}

__global__ void __launch_bounds__(NTHR) fwd_megakernel(Params p) {
  extern __shared__ __attribute__((aligned(16))) unsigned char shm[];
  cg::grid_group grid = cg::this_grid();
  LAS unsigned char* ldsl = (LAS unsigned char*)shm;
  unsigned char* lds = shm;
  unsigned char* ws = p.ws;

  bf16_t* hbuf = (bf16_t*)(ws + O_H);
  float* modp = (float*)(ws + O_MODP);
  float* mod = (float*)(ws + O_MOD);
  float* ropeA = (float*)(ws + O_ROPA);
  float* ropeI = (float*)(ws + O_ROPI);
  float* scal = (float*)(ws + O_SCAL);
  unsigned* ctr = (unsigned*)(ws + O_CTR);
  bf16_t* ubuf = (bf16_t*)(ws + O_UBUF);
  float* xbuf = (float*)(ws + O_XBUF);
  int* slot = (int*)(lds + SLOT_OFF);

  { PHASE_VARS
  if (bid == 0) {
    if (tid < 16) ctr[tid] = 0u;
    if (tid < 256) ((unsigned*)(ws + O_LNC))[tid] = 0u;
    for (int i = tid; i < XCD_BAR_WORDS; i += NTHR) ((unsigned*)(ws + O_BAR))[i] = 0u;
    if (tid < 2) { const float* lm = p.lam + tid * 4 * 128; float s0 = 0, s1 = 0; for (int i = 0; i < 128; ++i) { s0 += lm[i] * lm[128 + i]; s1 += lm[256 + i] * lm[384 + i]; }
      const float lam_init = 0.8f - 0.6f * expf(-0.3f * (float)tid);
      scal[tid * 2] = expf(s0) - expf(s1) + lam_init; scal[tid * 2 + 1] = 1.f - lam_init; }
  }
  for (int i = gtid; i < 4096 * 24; i += gthreads) {
    const int pos = i / 24, f = i % 24;
    float inv; if (f < 16) inv = powf(500000.f, -((float)f * 2.f) / 32.f); else inv = powf(500000.f, -((float)(f - 16) * 2.f) / 16.f);
    const float ang = (float)pos * inv;
    const double kk = rint((double)ang * 0.15915494309189535); const float red = (float)((double)ang - kk * 6.283185307179586);
    const float cs = cosf(red), sn = sinf(red);
    if (f < 16) { ropeA[pos * 32 + f] = cs; ropeA[pos * 32 + 16 + f] = sn; } else { ropeI[pos * 16 + (f - 16)] = cs; ropeI[pos * 16 + 8 + (f - 16)] = sn; }
  }
  float* csl = (float*)lds;
  for (int i = tid; i < 4096; i += NTHR) csl[i] = silu(p.c[i]);
  __syncthreads();
  for (int i = gtid; i < 8 * 2 * 12288; i += gthreads) {
    const int col = i % 12288, l = (i / 12288) & 1, kc = i / (2 * 12288);
    const float* w = p.w_ada + (size_t)l * 2048 * 12288 + (size_t)(kc * 256) * 12288 + col;
    float a0 = 0, a1 = 0;
#pragma unroll 8
    for (int k = 0; k < 256; ++k) { const float wv = __builtin_nontemporal_load(&w[(size_t)k * 12288]); a0 += csl[kc * 256 + k] * wv; a1 += csl[2048 + kc * 256 + k] * wv; }
    modp[((size_t)(kc * 2 + l) * 2 + 0) * 12288 + col] = a0; modp[((size_t)(kc * 2 + l) * 2 + 1) * 12288 + col] = a1;
  }
  __syncthreads();
  }
  convert_layer(p, 0, (float*)lds);
  grid.sync();
  volatile LAS unsigned* xst = (volatile LAS unsigned*)(ldsl + XST_OFF);
  if (threadIdx.x == 0) { xst[0] = 0u; xst[1] = 0u; }
  __syncthreads();
  XcdBarrier xb = xcd_barrier_post((unsigned*)(ws + O_BAR), xst);

  { PHASE_VARS
  for (int i = gtid; i < 2 * 2 * 12288; i += gthreads) {
    const int col = i % 12288, lb = i / 12288, l = lb >> 1;
    float a = p.b_ada[l * 12288 + col];
    for (int kc = 0; kc < 8; ++kc) a += modp[((size_t)kc * 4 + lb) * 12288 + col];
    mod[i] = a;
  } }
  xcd_barrier(xb);
  ln_phase(p.x, nullptr, nullptr, nullptr, mod, 0, 1, ubuf);
  xcd_barrier(xb);

  for (int l = 0; l < 2; ++l) {
    const float* xin = l == 0 ? p.x : xbuf;
    float* xnext = l == 0 ? xbuf : p.out;
    const float* modl = mod + l * 2 * 12288;
    { PHASE_VARS Gemm g{ubuf, (const bf16_t*)(ws + O_WIN), T, NPHYS, 2048, 2048, 2048}; Sched S; S.init(T, NPHYS, nblk, bid);
      EpiIn E{hbuf, (bf16_t*)(ws + O_BVT), (bf16_t*)(ws + O_CVT), ropeA, ropeI};
      gemm_phase(ldsl, g, S, E); }
    { PHASE_VARS const int kc = bid >> 5;
      Gemm g{ubuf + kc * 256, (const bf16_t*)(ws + O_WMISC) + kc * 256, T, 256, 256, 2048, 2048}; Sched S; S.init(T, 256, 32, bid & 31);
      EpiHalfF32 E{(float*)(ws + O_MISCP) + (size_t)kc * T * 128};
      gemm_phase(ldsl, g, S, E); }
    xcd_barrier(xb);
    { PHASE_VARS const float* miscp = (const float*)(ws + O_MISCP); bf16_t* ikn = (bf16_t*)(ws + O_IKN); float* iwf = (float*)(ws + O_IWF); float* bgt = (float*)(ws + O_BG); float* srow = (float*)(ws + O_SROW);
      for (int row = gw; row < T; row += nw) {
        const int pos = row & (SL - 1);
        { const bf16x8 a = *(const bf16x8*)(hbuf + (size_t)row * NPHYS + H_ALAT + lane * 8); float s = 0;
          for (int j = 0; j < 8; ++j) { const float v = bf2f((bf16_t)a[j]); s += v * v; }
          s = wsum(s); if (lane == 0) srow[row] = rsqrtf(s * (1.f / 512.f) + 1e-6f); }
        { float v = 0.f; for (int k = 0; k < 8; ++k) v += miscp[((size_t)k * T + row) * 128 + lane]; const float mu = wsum(v) * (1.f / 64.f); const float d = v - mu; const float var = wsum(d * d) * (1.f / 64.f);
          const float y = d * rsqrtf(var + 1e-5f);
          const float y8 = __shfl_xor(y, 8);
          float o = y;
          if (lane < 16) { const int f = lane & 7; const float cs = ropeI[pos * 16 + f], sn = ropeI[pos * 16 + 8 + f]; o = lane < 8 ? y * cs - y8 * sn : y * cs + y8 * sn; }
          ikn[(size_t)row * 64 + lane] = f2bf(o); }
        { float v = 0.f; for (int k = 0; k < 8; ++k) v += miscp[((size_t)k * T + row) * 128 + 64 + lane];
          if (lane < 16) iwf[(size_t)row * 16 + lane] = v * (0.25f * 0.125f);
          else if (lane < 40) bgt[(size_t)row * 24 + (lane - 16)] = sigm(v); }
      }
      bf16_t* blk = (bf16_t*)(ws + O_BLK);
      for (int ch = gtid; ch < 2048 * 512; ch += gthreads) {
        const int row = ch >> 9, cc = ch & 511, j = cc >> 4, d8 = (cc & 15) * 8;
        const int kv = row >> 10, rr = row & 1023, b = rr >> 9, n = (rr & 511) >> 1, g = rr & 1, tok = 16 * n + j;
        u32x4 w = {0u, 0u, 0u, 0u};
        if (n < 255 && tok < SL) {
          const bf16x8 a = *(const bf16x8*)(hbuf + (size_t)(b * SL + tok) * NPHYS + H_BKV + kv * 256 + g * 128 + d8);
          const float* pe = p.cmp_pe + (size_t)((l * 2 + kv) * 32 + j) * 128 + d8;
          float v[8]; for (int q = 0; q < 8; ++q) v[q] = bf2f((bf16_t)a[q]) + pe[q];
          w = (u32x4){cvtpk(v[0], v[1]), cvtpk(v[2], v[3]), cvtpk(v[4], v[5]), cvtpk(v[6], v[7])};
        }
        *(u32x4*)(blk + (size_t)row * 4096 + cc * 8) = w;
      }
    }
    xcd_barrier(xb);
    { PHASE_VARS Gemm g{hbuf + H_ALAT, (const bf16_t*)(ws + O_WAUP), T, 2048, 512, NPHYS, 512}; Sched S; S.init(T, 2048, nblk, bid);
      EpiAup E{(bf16_t*)(ws + O_AK), (bf16_t*)(ws + O_AVT), (const float*)(ws + O_SROW), ropeA};
      gemm_phase(ldsl, g, S, E); }
    { PHASE_VARS if (bid < 64) { const int kc = bid >> 3;
      Gemm g{(const bf16_t*)(ws + O_BLK) + kc * 512, (const bf16_t*)(ws + O_WC1) + kc * 512, 2048, 256, 512, 4096, 4096}; Sched S; S.init(2048, 256, 8, bid & 7);
      EpiF32 E{(float*)(ws + O_CPART) + (size_t)kc * 2048 * 256, 256};
      gemm_phase(ldsl, g, S, E);
      asm volatile("s_waitcnt vmcnt(0)" ::: "memory"); __syncthreads();
      if (tid == 0) { __builtin_amdgcn_fence(__ATOMIC_RELEASE, "agent"); asm volatile("s_waitcnt vmcnt(0)" ::: "memory");
        __hip_atomic_fetch_add(ctr + l * 4 + 3, 1u, __ATOMIC_RELAXED, __HIP_MEMORY_SCOPE_AGENT); } } }
    idxsel_phase(lds, hbuf, (const bf16_t*)(ws + O_IKN), (const float*)(ws + O_IWF), (u64*)(ws + O_BITS), ctr + l * 4 + 0);
    { PHASE_VARS
      if (tid == 0) { unsigned sp_ = 0; while (__hip_atomic_load(ctr + l * 4 + 3, __ATOMIC_RELAXED, __HIP_MEMORY_SCOPE_AGENT) < 64u) { __builtin_amdgcn_s_sleep(1); if (++sp_ > (1u << 24)) break; }
        __builtin_amdgcn_fence(__ATOMIC_ACQUIRE, "agent"); asm volatile("s_waitcnt vmcnt(0)" ::: "memory"); }
      __syncthreads(); }
    { PHASE_VARS const float* cpart = (const float*)(ws + O_CPART); bf16_t* kc_ = (bf16_t*)(ws + O_KC); bf16_t* vct = (bf16_t*)(ws + O_VCT);
      float* hid = (float*)lds; float* red = (float*)lds + 128;
      for (int row = bid; row < 2048; row += nblk) {
        const int kv = row >> 10, rr = row & 1023, b = rr >> 9, n = (rr & 511) >> 1, g = rr & 1;
        __syncthreads();
        if (tid < 128) { float s = 0; for (int k = 0; k < 8; ++k) s += cpart[((size_t)k * 2048 + row) * 256 + kv * 128 + tid]; hid[tid] = silu(s); }
        __syncthreads();
        { const int cp = tid & 127, part = tid >> 7; const float* w2 = p.cmp_w2 + (size_t)(l * 2 + kv) * 128 * 128;
          float s = 0; for (int c = part * 32; c < part * 32 + 32; ++c) s += hid[c] * w2[c * 128 + cp];
          red[part * 128 + cp] = s; }
        __syncthreads();
        if (tid < 128) { const float s = red[tid] + red[128 + tid] + red[256 + tid] + red[384 + tid];
          if (kv == 0) kc_[(size_t)((b * 2 + g) * 256 + n) * 128 + tid] = f2bf(s); else vct[(size_t)((b * 2 + g) * 128 + tid) * 256 + n] = f2bf(s); }
      }
    }
    xcd_barrier(xb);
    { PHASE_VARS float* pcmp = (float*)(ws + O_PCMP); float* ml = (float*)(ws + O_ML);
      for (;;) {
        const int it = fetch_item(ctr + l * 4 + 1, slot);
        if (it >= 256) break;
        f32x16 o[4]; float mo, lo;
        const int r32 = lane & 31, hi = lane >> 5;
        const int qb = 15 - it / 16, r = it % 16, b = r >> 3, hh = r & 7, g = hh >> 2, rowg0 = b * SL + qb * 256;
        attn_core_skew<M_CMP>(ldsl, hbuf + (size_t)rowg0 * NPHYS + H_BQ + hh * 128, NPHYS, (const bf16_t*)(ws + O_KC) + (size_t)((b * 2 + g) * 256) * 128, 128,
                         (const bf16_t*)(ws + O_VCT) + (size_t)((b * 2 + g) * 128) * 256, 256, qb * 256, 0, 4, nullptr,
                         pcmp + ((size_t)(b * 8 + hh) * SL + qb * 256) * 256, o, mo, lo);
        store_o_bf16(ldsl, (bf16_t*)(ws + O_OCMP), rowg0, hh * 128, o);
        if (hi == 0) { float* mp = ml + ((size_t)(b * 8 + hh) * SL + qb * 256 + wid * 32 + r32) * 2; mp[0] = mo; mp[1] = lo; }
      }
    }
    xcd_barrier(xb);
    { PHASE_VARS const float* pcmp = (const float*)(ws + O_PCMP); const float* ml = (const float*)(ws + O_ML); u64* sel = (u64*)(ws + O_SEL);
      for (int it = gw; it < 2 * 2 * SL; it += nw) {
        const int t = it & (SL - 1), bg = it >> 12, b = bg >> 1, g = bg & 1, m = lane, tc = t >= 31 ? ((t - 31) >> 4) : -1;
        float imp = 0.f;
        for (int hh = 0; hh < 4; ++hh) { const size_t rb = (size_t)(b * 8 + g * 4 + hh) * SL + t; const float* base = pcmp + rb * 256;
          const float mm = ml[rb * 2], ll = ml[rb * 2 + 1]; const float inv = ll > 0.f ? 1.f / ll : 0.f;
          const float NI = -__builtin_inff();
          const f32x4 s4 = 4 * m <= tc ? *(const f32x4*)(base + 4 * m) : (f32x4){NI, NI, NI, NI}; const float sm1 = (m > 0 && 4 * m - 1 <= tc) ? base[4 * m - 1] : NI;
          float ps = __builtin_amdgcn_exp2f((sm1 - mm) * C2);
          for (int j = 0; j < 4; ++j) ps += __builtin_amdgcn_exp2f((s4[j] - mm) * C2);
          imp += ps * inv; }
        const int cur = t >> 6;
        const bool forced = (m == 0) | (m == cur) | (m == cur - 1), adm = m <= cur;
        const float v = forced ? 1e6f : (adm ? imp : -1e30f);
        int rank = 0;
#pragma unroll
        for (int jj = 0; jj < 64; ++jj) { const float vj = __int_as_float(__builtin_amdgcn_readlane(__float_as_int(v), jj)); rank += (vj > v || (vj == v && jj < m)) ? 1 : 0; }
        const u64 w = __ballot(rank < 16);
        if (lane == 0) sel[it] = w;
      }
    }
    xcd_barrier(xb);
    { PHASE_VARS const u64* sel = (const u64*)(ws + O_SEL); const float* bgt = (const float*)(ws + O_BG); const u64* bits = (const u64*)(ws + O_BITS);
      for (;;) {
        const int it = fetch_item(ctr + l * 4 + 2, slot);
        if (it >= 1024) break;
        f32x16 o[4]; float mo, lo;
        const int r32 = lane & 31, hi = lane >> 5;
        if (it >= 768) {
          const int i2 = it - 768, qb = 15 - i2 / 16, r = i2 % 16, b = r >> 3, hh = r & 7, g = hh >> 2, rowg0 = b * SL + qb * 256;
          const int jlo = 4 * qb - 8 > 0 ? 4 * qb - 8 : 0;
          attn_core_skew<M_WINDOW>(ldsl, hbuf + (size_t)rowg0 * NPHYS + H_BQ + hh * 128, NPHYS, hbuf + (size_t)(b * SL) * NPHYS + H_BKV + (8 + g) * 128, NPHYS,
                              (const bf16_t*)(ws + O_BVT) + (size_t)(((b * 2 + 1) * 2 + g) * 128) * SL, SL, qb * 256, jlo, 4 * qb + 4, nullptr, nullptr, o, mo, lo);
          store_o_bf16(ldsl, (bf16_t*)(ws + O_OWIN), rowg0, hh * 128, o);
          continue;
        }
        const int qb = 15 - it / 48, r = it % 48;
        if (r < 16) {
          f32x16 o8[8];
          const int b = r >> 3, vh = r & 7, head = vh >> 1, mp = vh & 1, rowg0 = b * SL + qb * 256;
          attn_core<M_CAUSAL, 256>(ldsl, hbuf + (size_t)rowg0 * NPHYS + H_CQ + (head * 2 + mp) * 128, NPHYS, hbuf + (size_t)(b * SL) * NPHYS + H_CK + (head * 2 + mp) * 128, NPHYS,
                              (const bf16_t*)(ws + O_CVT) + (size_t)((b * 4 + head) * 256) * SL, SL, qb * 256, 0, 4 * qb + 4, nullptr, nullptr, o8, mo, lo);
          __syncthreads();
          { const int t2 = ltid(), l2 = t2 & 63, w2 = t2 >> 6, r2_ = l2 & 31, h2 = l2 >> 5;
            LAS unsigned char* pw = ldsl + w2 * 17408;
#pragma unroll
            for (int rr = 0; rr < 16; ++rr)
#pragma unroll
              for (int d = 0; d < 8; ++d) *(LAS bf16_t*)(pw + ((rr & 3) + 8 * (rr >> 2) + 4 * h2) * 544 + (d * 32 + r2_) * 2) = f2bf(o8[d][rr]);
            asm volatile("s_waitcnt lgkmcnt(0)" ::: "memory");
            bf16_t* ocp = (bf16_t*)(ws + O_OC) + (size_t)(rowg0 + w2 * 32) * 2048 + head * 512 + mp * 256;
#pragma unroll
            for (int i = 0; i < 16; ++i) { const int c = i * 64 + l2, row = c >> 5, c16 = c & 31;
              *(u32x4*)(ocp + (size_t)row * 2048 + c16 * 8) = *(const LAS u32x4*)(pw + row * 544 + c16 * 16); }
            asm volatile("s_waitcnt lgkmcnt(0)" ::: "memory"); }
        } else if (r < 32) {
          const int r2 = r - 16, b = r2 >> 3, hh = r2 & 7, rowg0 = b * SL + qb * 256;
          attn_core_skew<M_BITS>(ldsl, hbuf + (size_t)rowg0 * NPHYS + H_AQ + hh * 128, NPHYS, (const bf16_t*)(ws + O_AK) + (size_t)(b * SL) * 1024 + hh * 128, 1024,
                            (const bf16_t*)(ws + O_AVT) + (size_t)((b * 8 + hh) * 128) * SL, SL, qb * 256, 0, 4 * qb + 4, bits + (size_t)rowg0 * 64, nullptr, o, mo, lo);
          store_o_bf16(ldsl, (bf16_t*)(ws + O_YA), rowg0, hh * 128, o);
        } else {
          const int r2 = r - 32, b = r2 >> 3, hh = r2 & 7, g = hh >> 2, rowg0 = b * SL + qb * 256;
          attn_core_skew<M_SLC>(ldsl, hbuf + (size_t)rowg0 * NPHYS + H_BQ + hh * 128, NPHYS, hbuf + (size_t)(b * SL) * NPHYS + H_BKV + (4 + g) * 128, NPHYS,
                           (const bf16_t*)(ws + O_BVT) + (size_t)(((b * 2 + 0) * 2 + g) * 128) * SL, SL, qb * 256, 0, 4 * qb + 4, sel + (size_t)(b * 2 + g) * SL + qb * 256, nullptr, o, mo, lo);
          store_o_bf16(ldsl, (bf16_t*)(ws + O_YB), rowg0, hh * 128, o);
        }
      }
      (void)bgt;
    }
    xcd_barrier(xb);
    { PHASE_VARS const bf16_t* ocmp = (const bf16_t*)(ws + O_OCMP); const bf16_t* owin = (const bf16_t*)(ws + O_OWIN); bf16_t* yb = (bf16_t*)(ws + O_YB); const float* bgt = (const float*)(ws + O_BG);
      for (int row = gw; row < T; row += nw) {
#pragma unroll
        for (int hq = 0; hq < 2; ++hq) { const int c0 = hq * 512 + lane * 8, hh = c0 >> 7; const float* gp = bgt + (size_t)row * 24 + hh * 3; const float g0 = gp[0], g1 = gp[1], g2 = gp[2];
          const size_t rw = (size_t)row * 1024 + c0;
          const bf16x8 a = *(const bf16x8*)(ocmp + rw), b8 = *(const bf16x8*)(yb + rw), c8 = *(const bf16x8*)(owin + rw);
          float v[8]; for (int q = 0; q < 8; ++q) v[q] = g0 * bf2f((bf16_t)a[q]) + g1 * bf2f((bf16_t)b8[q]) + g2 * bf2f((bf16_t)c8[q]);
          *(u32x4*)(yb + rw) = (u32x4){cvtpk(v[0], v[1]), cvtpk(v[2], v[3]), cvtpk(v[4], v[5]), cvtpk(v[6], v[7])}; }
      }
    }
    { PHASE_VARS const bf16_t* oc = (const bf16_t*)(ws + O_OC); bf16_t* yc = (bf16_t*)(ws + O_YC);
      const float lamv = scal[l * 2], omli = scal[l * 2 + 1];
      for (int it = gw; it < T * 4; it += nw) {
        const int row = it >> 2, head = it & 3;
        const s16x4 a = *(const s16x4*)(oc + (size_t)row * 2048 + head * 512 + lane * 4), b4 = *(const s16x4*)(oc + (size_t)row * 2048 + head * 512 + 256 + lane * 4);
        float v[4], s = 0; for (int j = 0; j < 4; ++j) { v[j] = bf2f((bf16_t)a[j]) - lamv * bf2f((bf16_t)b4[j]); s += v[j] * v[j]; }
        const float rs = rsqrtf(wsum(s) * (1.f / 256.f) + 1e-6f);
        const f32x4 gg = *(const f32x4*)(p.subln_g + l * 256 + lane * 4);
        float o4[4]; for (int j = 0; j < 4; ++j) o4[j] = v[j] * rs * gg[j] * omli;
        *(u32x2*)(yc + (size_t)row * 1024 + head * 256 + lane * 4) = (u32x2){cvtpk(o4[0], o4[1]), cvtpk(o4[2], o4[3])};
      }
    }
    xcd_barrier(xb);
    for (int r = 0; r < 3; ++r) { PHASE_VARS
      const bf16_t* yr = (const bf16_t*)(ws + (r == 0 ? O_YA : (r == 1 ? O_YB : O_YC)));
      Gemm g{yr, (const bf16_t*)(ws + O_WBR) + (size_t)r * 2048 * 1024, T, 2048, 1024, 1024, 1024}; Sched S; S.init(T, 2048, nblk, bid);
      EpiGate E{hbuf, (float*)(ws + O_TMP), (bf16_t*)(ws + O_MERG), r};
      gemm_phase(ldsl, g, S, E);
    }
    xcd_barrier(xb);
    { PHASE_VARS Gemm g{(const bf16_t*)(ws + O_MERG), (const bf16_t*)(ws + O_WO), T, 2048, 2048, 2048, 2048}; Sched S; S.init(T, 2048, nblk, bid);
      EpiLnFused E{xin, modl + 2 * 2048, p.ln_g + (size_t)(l * 2 + 0) * 2048, p.ln_b + (size_t)(l * 2 + 0) * 2048, (float*)(ws + O_X1), modl, 3, 4, ubuf,
                   (float*)(ws + O_LNS), (unsigned*)(ws + O_LNC) + (l * 2 + 0) * 64};
      gemm_phase(ldsl, g, S, E); }
    xcd_barrier(xb);
    { PHASE_VARS Gemm g{ubuf, (const bf16_t*)(ws + O_WF1), T, 2 * DFF, 2048, 2048, 2048}; Sched S; S.init(T, 2 * DFF, nblk, bid);
      EpiSwiglu E{(bf16_t*)(ws + O_HID)};
      gemm_phase(ldsl, g, S, E); }
    xcd_barrier(xb);
    { PHASE_VARS Gemm g{(const bf16_t*)(ws + O_HID), (const bf16_t*)(ws + O_WF2), T, 2048, DFF, DFF, DFF}; Sched S; S.init(T, 2048, nblk, bid);
      EpiLnFused E{(const float*)(ws + O_X1), modl + 5 * 2048, p.ln_g + (size_t)(l * 2 + 1) * 2048, p.ln_b + (size_t)(l * 2 + 1) * 2048, xnext, mod + 2 * 12288, 0, 1, l == 0 ? ubuf : nullptr,
                   (float*)(ws + O_LNS), (unsigned*)(ws + O_LNC) + (l * 2 + 1) * 64};
      gemm_phase(ldsl, g, S, E); }
    if (l == 0) { xcd_barrier(xb); convert_layer(p, 1, (float*)lds); xcd_barrier(xb); }
  }
}

extern "C" void kernel_launch(void* const* d_in, const int* in_sizes, int n_in, void* d_out, int out_size, void* d_ws, size_t ws_size, hipStream_t stream) {
  (void)in_sizes; (void)n_in; (void)out_size;
  static int grid_blocks = 0;
  if (!grid_blocks) {
    hipError_t e = hipFuncSetAttribute((const void*)fwd_megakernel, hipFuncAttributeMaxDynamicSharedMemorySize, LDS_BYTES);
    if (e != hipSuccess) fprintf(stderr, "hipFuncSetAttribute failed: %s\n", hipGetErrorString(e));
    int dev = 0, cus = 0, per_cu = 0;
    hipGetDevice(&dev);
    hipDeviceGetAttribute(&cus, hipDeviceAttributeMultiprocessorCount, dev);
    hipOccupancyMaxActiveBlocksPerMultiprocessor(&per_cu, fwd_megakernel, NTHR, LDS_BYTES);
    if (per_cu < 1) per_cu = 1;
    grid_blocks = cus;
    if (ws_size < WS_TOTAL) fprintf(stderr, "workspace too small: %zu < %zu\n", ws_size, (size_t)WS_TOTAL);
  }
  Params p{};
  p.x = (const float*)d_in[0]; p.c = (const float*)d_in[1]; p.w_ada = (const float*)d_in[2]; p.b_ada = (const float*)d_in[3]; p.w_in = (const float*)d_in[4];
  p.a_lat_g = (const float*)d_in[5]; p.a_up = (const float*)d_in[6]; p.cmp_w1 = (const float*)d_in[7]; p.cmp_w2 = (const float*)d_in[8]; p.cmp_pe = (const float*)d_in[9];
  p.lam = (const float*)d_in[10]; p.subln_g = (const float*)d_in[11]; p.w_br = (const float*)d_in[12]; p.w_o = (const float*)d_in[13]; p.w_f1 = (const float*)d_in[14];
  p.w_f2 = (const float*)d_in[15]; p.ln_g = (const float*)d_in[16]; p.ln_b = (const float*)d_in[17];
  p.out = (float*)d_out; p.ws = (unsigned char*)d_ws;
  void* args[] = {&p};
  hipError_t e = hipLaunchCooperativeKernel((const void*)fwd_megakernel, dim3(grid_blocks), dim3(NTHR), args, LDS_BYTES, stream);
  if (e != hipSuccess) fprintf(stderr, "cooperative launch failed: %s (grid %d)\n", hipGetErrorString(e), grid_blocks);
}
```

```cpp
#include <hip/hip_runtime.h>
#include <hip/hip_cooperative_groups.h>
#include <cstdio>
#include <cstdint>
namespace cg = cooperative_groups;

#define DI __device__ __forceinline__
#define LAS __attribute__((address_space(3)))
typedef unsigned short bf16_t;
typedef short bf16x8 __attribute__((ext_vector_type(8)));
typedef short s16x4 __attribute__((ext_vector_type(4)));
typedef float f32x4 __attribute__((ext_vector_type(4)));
typedef float f32x16 __attribute__((ext_vector_type(16)));
typedef unsigned u32x4 __attribute__((ext_vector_type(4)));
typedef unsigned u32x2 __attribute__((ext_vector_type(2)));
typedef unsigned long long u64;

constexpr int T = 8192, SL = 4096, DM = 2048, NPHYS = 14336, DFF = 5632, NIN = 14440;
constexpr int H_AQ = 0, H_ALAT = 1024, H_IQ = 1536, H_BQ = 2560, H_BKV = 3584, H_CQ = 5120, H_CK = 6144, H_GL = 8192;
constexpr float ALPHA = 1.4142135623730951f;
constexpr float C2 = 0.08838834764831845f * 1.4426950408889634f;
constexpr int NTHR = 512;
constexpr int LDS_BYTES = 147456, SLOT_OFF = 145408, XST_OFF = 146432, PD_OFF = 73728;

constexpr size_t al256(size_t x) { return (x + 255) & ~(size_t)255; }
constexpr size_t O_WIN = 0;
constexpr size_t O_WAUP = O_WIN + (size_t)NPHYS * 2048 * 2;
constexpr size_t O_WC1 = O_WAUP + (size_t)2048 * 512 * 2;
constexpr size_t O_WBR = O_WC1 + (size_t)256 * 4096 * 2;
constexpr size_t O_WO = O_WBR + (size_t)3 * 2048 * 1024 * 2;
constexpr size_t O_WF1 = O_WO + (size_t)2048 * 2048 * 2;
constexpr size_t O_WF2 = O_WF1 + (size_t)2 * DFF * 2048 * 2;
constexpr size_t O_WMISC = O_WF2 + (size_t)2048 * DFF * 2;
constexpr size_t O_H = O_WMISC + (size_t)256 * 2048 * 2;
constexpr size_t O_HID = O_H;
constexpr size_t O_X1 = O_H + (size_t)T * DFF * 2;
constexpr size_t O_S = O_H + (size_t)T * NPHYS * 2;
constexpr size_t O_MISCP = O_S;
constexpr size_t O_PCMP = O_S;
constexpr size_t O_OC = O_S + (size_t)T * 2048 * 4;
constexpr size_t O_TMP = O_S;
constexpr size_t O_Z = O_OC;
constexpr size_t O_XBUF = O_S + (size_t)T * 4096 * 4;
constexpr size_t O_UBUF = O_XBUF + (size_t)T * DM * 4;
constexpr size_t O_AVT = O_UBUF + (size_t)T * DM * 2;
constexpr size_t O_BVT = O_AVT + (size_t)2 * 8 * 128 * 4096 * 2;
constexpr size_t O_CVT = O_BVT + (size_t)2 * 2 * 2 * 128 * 4096 * 2;
constexpr size_t O_AK = O_CVT + (size_t)2 * 4 * 256 * 4096 * 2;
constexpr size_t O_MISC = O_AK + (size_t)T * 1024 * 2;
constexpr size_t O_IKN = O_MISC + (size_t)T * 128 * 4;
constexpr size_t O_IWF = O_IKN + (size_t)T * 64 * 2;
constexpr size_t O_BG = O_IWF + (size_t)T * 16 * 4;
constexpr size_t O_SROW = O_BG + (size_t)T * 24 * 4;
constexpr size_t O_BLK = O_SROW + (size_t)T * 4;
constexpr size_t O_CPART = O_BLK + (size_t)2048 * 4096 * 2;
constexpr size_t O_KC = O_CPART + (size_t)8 * 2048 * 256 * 4;
constexpr size_t O_VCT = O_KC + (size_t)2 * 2 * 256 * 128 * 2;
constexpr size_t O_BITS = O_VCT + (size_t)2 * 2 * 128 * 256 * 2;
constexpr size_t O_SEL = O_BITS + (size_t)T * 64 * 8;
constexpr size_t O_ML = O_SEL + (size_t)2 * 2 * 4096 * 8;
constexpr size_t O_YA = O_ML + (size_t)2 * 8 * 4096 * 2 * 4;
constexpr size_t O_YB = O_YA + (size_t)T * 1024 * 2;
constexpr size_t O_YC = O_YB + (size_t)T * 1024 * 2;
constexpr size_t O_OCMP = O_YC + (size_t)T * 1024 * 2;
constexpr size_t O_OWIN = O_OCMP + (size_t)T * 1024 * 2;
constexpr size_t O_MERG = O_OWIN + (size_t)T * 1024 * 2;
constexpr size_t O_MODP = O_MERG + (size_t)T * DM * 2;
constexpr size_t O_MOD = O_MODP + (size_t)8 * 2 * 2 * 12288 * 4;
constexpr size_t O_ROPA = O_MOD + (size_t)2 * 2 * 12288 * 4;
constexpr size_t O_ROPI = O_ROPA + (size_t)4096 * 32 * 4;
constexpr size_t O_SCAL = O_ROPI + (size_t)4096 * 16 * 4;
constexpr size_t O_CTR = O_SCAL + 256;
constexpr size_t O_LNC = O_CTR + 256;
constexpr size_t O_LNS = O_LNC + 1024;
constexpr size_t O_BAR = O_LNS + (size_t)2 * 32 * 256 * 16 * 4;
constexpr size_t WS_TOTAL = O_BAR + 3456 * 4;

struct Params {
  const float *x, *c, *w_ada, *b_ada, *w_in, *a_lat_g, *a_up, *cmp_w1, *cmp_w2, *cmp_pe, *lam, *subln_g, *w_br, *w_o, *w_f1, *w_f2, *ln_g, *ln_b;
  float* out;
  unsigned char* ws;
};

DI unsigned cvtpk(float lo, float hi) { unsigned r; asm volatile("v_cvt_pk_bf16_f32 %0, %1, %2" : "=v"(r) : "v"(lo), "v"(hi)); return r; }
DI float bf2f(bf16_t b) { return __uint_as_float(((unsigned)b) << 16); }
DI bf16_t f2bf(float f) { return (bf16_t)(cvtpk(f, 0.f) & 0xffffu); }
DI float wsum(float v) { for (int o = 32; o; o >>= 1) v += __shfl_xor(v, o); return v; }
DI float sigm(float x) { return __builtin_amdgcn_rcpf(1.f + __expf(-x)); }
DI float silu(float x) { return x * __builtin_amdgcn_rcpf(1.f + __expf(-x)); }
DI int crow(int r, int hi) { return (r & 3) + 8 * (r >> 2) + 4 * hi; }
DI float vmin_raw(float a, float b) { float r; asm("v_min_f32_e32 %0, %1, %2" : "=v"(r) : "v"(a), "v"(b)); return r; }
DI int ltid() { int t = threadIdx.x; asm volatile("" : "+v"(t)); return t; }
DI int lbid() { int b = blockIdx.x; asm volatile("" : "+s"(b)); return b; }
#define PHASE_VARS const int tid = ltid(), bid = lbid(), nblk = gridDim.x, gtid = bid * NTHR + tid, gthreads = nblk * NTHR, lane = tid & 63, wid = tid >> 6, gw = bid * 8 + wid, nw = nblk * 8; (void)gtid; (void)gthreads; (void)lane; (void)wid; (void)gw; (void)nw;

struct MapId { int off; DI int operator()(int n) const { return n + off; } };
struct MapIn { DI int operator()(int n) const {
    if (n < 2560) return n;
    if (n < 5120) return n + 80;
    return n + 104; } };
struct MapMisc { DI int operator()(int n) const { return n < 80 ? 2560 + n : (n < 104 ? 5200 + (n - 80) : -1); } };
struct MapF1 { DI int operator()(int n) const { const int q = n >> 5, r = n & 31; return r < 16 ? q * 16 + r : DFF + q * 16 + (r - 16); } };

template <class Map>
DI void conv_T(bf16_t* __restrict__ dst, const float* __restrict__ src, int K, int ldsrc, int nphys, Map map, const float* __restrict__ kscale, float* tile) {
  const int tid = ltid(), ntn = nphys >> 6, ntiles = (K >> 6) * ntn;
  for (int tl = lbid(); tl < ntiles; tl += gridDim.x) {
    const int k0 = (tl / ntn) << 6, n0 = (tl % ntn) << 6;
    const int nn = tid & 63, sc = map(n0 + nn);
#pragma unroll
    for (int i = 0; i < 8; ++i) { const int kk = i * 8 + (tid >> 6);
      float v = sc >= 0 ? __builtin_nontemporal_load(&src[(size_t)(k0 + kk) * ldsrc + sc]) : 0.f;
      if (kscale) v *= kscale[k0 + kk];
      tile[kk * 65 + nn] = v; }
    __syncthreads();
    const int np = tid >> 3, ks = tid & 7;
    float v[8];
#pragma unroll
    for (int j = 0; j < 8; ++j) v[j] = tile[(ks * 8 + j) * 65 + np];
    u32x4 w = {cvtpk(v[0], v[1]), cvtpk(v[2], v[3]), cvtpk(v[4], v[5]), cvtpk(v[6], v[7])};
    *(u32x4*)(dst + (size_t)(n0 + np) * K + k0 + ks * 8) = w;
    __syncthreads();
  }
}

DI void convert_layer(const Params& p, int l, float* tile) {
  unsigned char* ws = p.ws;
  conv_T((bf16_t*)(ws + O_WIN), p.w_in + (size_t)l * 2048 * NIN, 2048, NIN, NPHYS, MapIn{}, nullptr, tile);
  conv_T((bf16_t*)(ws + O_WMISC), p.w_in + (size_t)l * 2048 * NIN, 2048, NIN, 256, MapMisc{}, nullptr, tile);
  conv_T((bf16_t*)(ws + O_WAUP), p.a_up + (size_t)l * 512 * 2048, 512, 2048, 2048, MapId{0}, p.a_lat_g + l * 512, tile);
  conv_T((bf16_t*)(ws + O_WC1), p.cmp_w1 + (size_t)(l * 2 + 0) * 4096 * 128, 4096, 128, 128, MapId{0}, nullptr, tile);
  conv_T((bf16_t*)(ws + O_WC1) + (size_t)128 * 4096, p.cmp_w1 + (size_t)(l * 2 + 1) * 4096 * 128, 4096, 128, 128, MapId{0}, nullptr, tile);
  for (int r = 0; r < 3; ++r)
    conv_T((bf16_t*)(ws + O_WBR) + (size_t)r * 2048 * 1024, p.w_br + (size_t)(l * 3 + r) * 1024 * 2048, 1024, 2048, 2048, MapId{0}, nullptr, tile);
  conv_T((bf16_t*)(ws + O_WO), p.w_o + (size_t)l * 2048 * 2048, 2048, 2048, 2048, MapId{0}, nullptr, tile);
  conv_T((bf16_t*)(ws + O_WF1), p.w_f1 + (size_t)l * 2048 * 2 * DFF, 2048, 2 * DFF, 2 * DFF, MapF1{}, nullptr, tile);
  conv_T((bf16_t*)(ws + O_WF2), p.w_f2 + (size_t)l * DFF * 2048, DFF, 2048, 2048, MapId{0}, nullptr, tile);
}

DI void ln_phase(const float* __restrict__ zin, const float* __restrict__ gam, const float* __restrict__ bet, float* __restrict__ xout,
                 const float* __restrict__ modl  , int sh_idx, int sc_idx, bf16_t* __restrict__ uout) {
  const int tid_ = ltid(), lane = tid_ & 63, gw = lbid() * 8 + (tid_ >> 6), nw = gridDim.x * 8;
  for (int row = gw; row < T; row += nw) {
    f32x4 v[8];
    const float* zr = zin + (size_t)row * DM;
#pragma unroll
    for (int i = 0; i < 8; ++i) v[i] = *(const f32x4*)(zr + i * 256 + lane * 4);
    if (gam) {
      float s = 0; for (int i = 0; i < 8; ++i) s += v[i][0] + v[i][1] + v[i][2] + v[i][3];
      const float mu = wsum(s) * (1.f / DM);
      float q = 0; for (int i = 0; i < 8; ++i) for (int j = 0; j < 4; ++j) { const float d = v[i][j] - mu; q += d * d; }
      const float rstd = rsqrtf(wsum(q) * (1.f / DM) + 1e-5f);
#pragma unroll
      for (int i = 0; i < 8; ++i) { const f32x4 g = *(const f32x4*)(gam + i * 256 + lane * 4), b = *(const f32x4*)(bet + i * 256 + lane * 4);
        for (int j = 0; j < 4; ++j) v[i][j] = (v[i][j] - mu) * rstd * g[j] + b[j];
        *(f32x4*)(xout + (size_t)row * DM + i * 256 + lane * 4) = v[i]; }
    }
    if (uout) {
      const float* mb = modl + (row >> 12) * 12288;
      float s = 0; for (int i = 0; i < 8; ++i) s += v[i][0] + v[i][1] + v[i][2] + v[i][3];
      const float mu = wsum(s) * (1.f / DM);
      float q = 0; for (int i = 0; i < 8; ++i) for (int j = 0; j < 4; ++j) { const float d = v[i][j] - mu; q += d * d; }
      const float rstd = rsqrtf(wsum(q) * (1.f / DM) + 1e-5f);
#pragma unroll
      for (int i = 0; i < 8; ++i) { const int c = i * 256 + lane * 4;
        const f32x4 sc = *(const f32x4*)(mb + sc_idx * 2048 + c), sh = *(const f32x4*)(mb + sh_idx * 2048 + c);
        float o[4]; for (int j = 0; j < 4; ++j) o[j] = (v[i][j] - mu) * rstd * (1.f + sc[j]) + sh[j];
        u32x2 w = {cvtpk(o[0], o[1]), cvtpk(o[2], o[3])};
        *(u32x2*)(uout + (size_t)row * DM + c) = w; }
    }
  }
}

constexpr int BM = 256, BK = 64, HALF = 128, HTB = HALF * BK * 2, NXCD = 8, WGM = 8;
DI int lds_byte(int r, int c) { const int st = (r >> 4) * 2 + (c >> 5), rr = r & 15, cc = c & 31, ob = rr * 64 + cc * 2; return st * 1024 + (ob ^ (((ob >> 9) & 1) << 5)); }
DI void stage_rc(int b, int& R, int& C) { const int st = b / 1024, sb = b % 1024, swz = sb ^ (((sb >> 9) & 1) << 5); R = (st >> 1) * 16 + swz / 64; C = (st & 1) * 32 + (swz % 64) / 2; }
DI int perm32(int rho) { const int n = rho >> 4, i = rho & 15; return 8 * (i >> 2) + 4 * n + (i & 3); }
struct Unit { int pm, pn; };
struct Gemm { const bf16_t* A; const bf16_t* Bt; int M, N, K, lda, ldb; };
struct Sched {
  int nM, nN, nwg, G, c;
  DI void init(int M, int N, int G_, int c_) { nM = M / BM; nN = N / BM; nwg = nM * nN; G = G_; c = c_; }
  DI bool next(int i, Unit& u) const {
    const long L = (long)i * G + c; if (L >= nwg) return false;
    int wgid = (int)L; { const int q = nwg / NXCD, r = nwg % NXCD, xcd = wgid % NXCD, off = wgid / NXCD; wgid = (xcd < r ? xcd * (q + 1) : r * (q + 1) + (xcd - r) * q) + off; }
    const int nig = WGM * nN, gid = wgid / nig, fm = gid * WGM, gsz = (nM - fm) < WGM ? (nM - fm) : WGM;
    u.pm = fm + ((wgid % nig) % gsz); u.pn = (wgid % nig) / gsz; return true;
  }
};

template <class Epi>
DI void gemm_phase(LAS unsigned char* lds, const Gemm g, const Sched& S, const Epi& E) {
  const int tid = ltid(), wid = __builtin_amdgcn_readfirstlane(tid >> 6), lane = tid & 63, wr = wid >> 2, wc = wid & 3, fr = lane & 15, fq = lane >> 4;
  const int K = g.K, nt = K / BK;
  unsigned voffA[2], voffB[2];
#pragma unroll
  for (int i = 0; i < 2; ++i) { int R, C; stage_rc(tid * 16 + i * 8192, R, C); const int Rb = Epi::PERM ? ((R & ~31) + perm32(R & 31)) : R;
    voffA[i] = (unsigned)(R * g.lda + C) * 2u; voffB[i] = (unsigned)(Rb * g.ldb + C) * 2u; }
  const size_t kstep = (size_t)(BK * 2);
  const size_t hstepA = (size_t)HALF * g.lda * 2, hstepB = (size_t)HALF * g.ldb * 2;
  const size_t tstepA = 2 * hstepA, tstepB = 2 * hstepB;
  const unsigned ldsw = (unsigned)wid * 1024u;
  const int aoff = lds_byte(wr * 64 + fr, fq * 8), boff = lds_byte(wc * 32 + fr, fq * 8);
#define PG8_SA(b, h) (((b) * 2 + (h)) * HTB)
#define PG8_SB(b, h) ((4 + (b) * 2 + (h)) * HTB)
#define PG8_STAGE(bufoff, gbase, voff) do { _Pragma("unroll") for (int _i = 0; _i < 2; ++_i) \
        __builtin_amdgcn_global_load_lds((const unsigned*)((const char*)(gbase) + (voff)[_i]), (LAS unsigned*)(lds + (bufoff) + ldsw + _i * 8192), 16, 0, 0); } while (0)
#define PG8_LDA(dst, b, h) do { _Pragma("unroll") for (int m = 0; m < 4; ++m) _Pragma("unroll") for (int k = 0; k < 2; ++k) dst[m][k] = *(const LAS bf16x8*)(lds + PG8_SA(b, h) + aoff + m * 2048 + k * 1024); } while (0)
#define PG8_LDB(dst, b, h) do { _Pragma("unroll") for (int n = 0; n < 2; ++n) _Pragma("unroll") for (int k = 0; k < 2; ++k) dst[n][k] = *(const LAS bf16x8*)(lds + PG8_SB(b, h) + boff + n * 2048 + k * 1024); } while (0)
#define PG8_MMA(ai, bj, At, Bt) do { __builtin_amdgcn_s_setprio(1); _Pragma("unroll") for (int m = 0; m < 4; ++m) _Pragma("unroll") for (int n = 0; n < 2; ++n) _Pragma("unroll") for (int k = 0; k < 2; ++k) \
        acc[ai][bj][m][n] = __builtin_amdgcn_mfma_f32_16x16x32_bf16(Bt[n][k], At[m][k], acc[ai][bj][m][n], 0, 0, 0); __builtin_amdgcn_s_setprio(0); } while (0)
#define PG8_WAIT_V(n) asm volatile("s_waitcnt vmcnt(" #n ")" ::: "memory")
#define PG8_WAIT_L(n) asm volatile("s_waitcnt lgkmcnt(" #n ")" ::: "memory")
#define PG8_BAR __builtin_amdgcn_s_barrier()
#define PG8_SCHED __builtin_amdgcn_sched_barrier(0)
  Unit cur, nxt; int ui = 0;
  if (!S.next(0, cur)) return;
  f32x4 acc[2][2][4][2];
#pragma unroll
  for (int a = 0; a < 2; ++a)
#pragma unroll
    for (int b = 0; b < 2; ++b)
#pragma unroll
      for (int m = 0; m < 4; ++m)
#pragma unroll
        for (int n = 0; n < 2; ++n) acc[a][b][m][n] = (f32x4){0.f, 0.f, 0.f, 0.f};
  bf16x8 At[4][2], B0[2][2], B1[2][2];
  const char* cA = (const char*)g.A + (size_t)cur.pm * tstepA; const char* cB = (const char*)g.Bt + (size_t)cur.pn * tstepB;
  PG8_STAGE(PG8_SB(0, 0), cB, voffB); PG8_STAGE(PG8_SB(0, 1), cB + hstepB, voffB); PG8_STAGE(PG8_SA(0, 0), cA, voffA); PG8_STAGE(PG8_SA(0, 1), cA + hstepA, voffA);
  if (wr == 1) PG8_BAR;
  PG8_WAIT_V(2); PG8_BAR;
  PG8_STAGE(PG8_SB(1, 0), cB + kstep, voffB); PG8_STAGE(PG8_SA(1, 0), cA + kstep, voffA); PG8_STAGE(PG8_SB(1, 1), cB + hstepB + kstep, voffB);
  PG8_WAIT_V(6); PG8_BAR;
  for (;;) {
    const bool has_next = S.next(ui + 1, nxt);
    const char* nA = has_next ? (const char*)g.A + (size_t)nxt.pm * tstepA : cA; const char* nB = has_next ? (const char*)g.Bt + (size_t)nxt.pn * tstepB : cB;
    for (int t = 0; t < nt; t += 2) {
      const bool last = (t == nt - 2);
      const char* a1 = cA + (size_t)(t + 1) * kstep;
      const char* a2 = last ? nA : cA + (size_t)(t + 2) * kstep; const char* b2 = last ? nB : cB + (size_t)(t + 2) * kstep;
      const char* a3 = a2 + kstep; const char* b3 = b2 + kstep;
      PG8_LDB(B0, 0, 0); PG8_LDB(B1, 0, 1); PG8_SCHED; PG8_LDA(At, 0, 0); PG8_STAGE(PG8_SA(1, 1), a1 + hstepA, voffA);
      PG8_WAIT_V(8); PG8_WAIT_L(0); PG8_BAR; PG8_MMA(0, 0, At, B0); PG8_MMA(0, 1, At, B1); PG8_BAR; PG8_SCHED;
      PG8_LDA(At, 0, 1); PG8_STAGE(PG8_SB(0, 0), b2, voffB); PG8_STAGE(PG8_SB(0, 1), b2 + hstepB, voffB); PG8_STAGE(PG8_SA(0, 0), a2, voffA);
      PG8_WAIT_V(8); PG8_WAIT_L(0); PG8_BAR; PG8_MMA(1, 0, At, B0); PG8_MMA(1, 1, At, B1); PG8_BAR; PG8_SCHED;
      PG8_LDB(B0, 1, 0); PG8_LDB(B1, 1, 1); PG8_SCHED; PG8_LDA(At, 1, 0); PG8_STAGE(PG8_SA(0, 1), a2 + hstepA, voffA);
      PG8_WAIT_V(8); PG8_WAIT_L(0); PG8_BAR; PG8_MMA(0, 0, At, B0); PG8_MMA(0, 1, At, B1); PG8_BAR; PG8_SCHED;
      PG8_LDA(At, 1, 1); PG8_STAGE(PG8_SB(1, 0), b3, voffB); PG8_STAGE(PG8_SB(1, 1), b3 + hstepB, voffB); PG8_STAGE(PG8_SA(1, 0), a3, voffA);
      PG8_WAIT_V(8); PG8_WAIT_L(0); PG8_BAR; PG8_MMA(1, 0, At, B0); PG8_MMA(1, 1, At, B1); PG8_BAR; PG8_SCHED;
    }
    if constexpr (!Epi::AFTER_DRAIN) { if (wr == 0) PG8_BAR;
      E(acc, cur, wr, wc, fr, fq); }
    if (!has_next) break;
#pragma unroll
    for (int a = 0; a < 2; ++a)
#pragma unroll
      for (int b = 0; b < 2; ++b)
#pragma unroll
        for (int m = 0; m < 4; ++m)
#pragma unroll
          for (int n = 0; n < 2; ++n) acc[a][b][m][n] = (f32x4){0.f, 0.f, 0.f, 0.f};
    cur = nxt; cA = nA; cB = nB; ++ui;
    if constexpr (!Epi::AFTER_DRAIN) { if (wr == 1) PG8_BAR; }
  }
  PG8_WAIT_V(0);
  if constexpr (Epi::AFTER_DRAIN) { if (wr == 0) PG8_BAR; }
  PG8_BAR;
  if constexpr (Epi::AFTER_DRAIN) E.fused(acc, cur, lds, tid, wr, wc, fr, fq);
#undef PG8_SA
#undef PG8_SB
#undef PG8_STAGE
#undef PG8_LDA
#undef PG8_LDB
#undef PG8_MMA
#undef PG8_WAIT_V
#undef PG8_WAIT_L
#undef PG8_BAR
#undef PG8_SCHED
}

typedef f32x4 AccT[2][2][4][2];

DI void rope128(f32x4& v0, f32x4& v1, const float* ropeA, int pos, int fq) {
  const f32x4 cs = *(const f32x4*)(ropeA + pos * 32 + 4 * fq), sn = *(const f32x4*)(ropeA + pos * 32 + 16 + 4 * fq);
#pragma unroll
  for (int j = 0; j < 4; ++j) { const float x1 = v0[j], x2 = v1[j]; v0[j] = x1 * cs[j] - x2 * sn[j]; v1[j] = x2 * cs[j] + x1 * sn[j]; }
}
DI void store_vt(bf16_t* base  , int d0, int pos, const f32x4& v) {
#pragma unroll
  for (int j = 0; j < 4; ++j) base[(size_t)(d0 + j) * SL + pos] = f2bf(v[j]);
}

struct EpiIn {
  static constexpr bool PERM = false, AFTER_DRAIN = false;
  bf16_t* h; bf16_t* bvT; bf16_t* cvT; const float* ropeA; const float* ropeI;
  DI void operator()(const AccT& acc, const Unit& u, int wr, int wc, int fr, int fq) const {
#pragma unroll
    for (int bj = 0; bj < 2; ++bj) {
      const int cb = u.pn * 2 + bj;
      int type;
      if (cb < 8) type = 1; else if (cb < 12) type = 0; else if (cb < 20) type = 2; else if (cb < 28) type = 1;
      else if (cb < 40) { const int idx = cb - 28, br = idx >> 2, kv = (idx >> 1) & 1; type = kv == 0 ? 1 : (br == 0 ? 0 : 4); }
      else if (cb < 56) type = 1; else if (cb < 64) type = 5; else type = 6;
#pragma unroll
      for (int ai = 0; ai < 2; ++ai)
#pragma unroll
        for (int m = 0; m < 4; ++m) {
          const int row = u.pm * BM + ai * HALF + wr * 64 + m * 16 + fr, pos = row & (SL - 1), b = row >> 12;
          f32x4 v0 = acc[ai][bj][m][0], v1 = acc[ai][bj][m][1];
          const int cin = wc * 32 + 4 * fq;
          if (type == 1) { if (wc == 0) rope128(v0, v1, ropeA, pos, fq); }
          else if (type == 2) { if ((wc & 1) == 0) {
              const f32x4 cs = *(const f32x4*)(ropeI + pos * 16 + 4 * (fq & 1)), sn = *(const f32x4*)(ropeI + pos * 16 + 8 + 4 * (fq & 1));
#pragma unroll
              for (int j = 0; j < 4; ++j) { const float mine = v0[j], oth = __shfl_xor(mine, 32);
                v0[j] = fq < 2 ? mine * cs[j] - oth * sn[j] : mine * cs[j] + oth * sn[j]; } } }
          else if (type == 6) { for (int j = 0; j < 4; ++j) { v0[j] = sigm(v0[j]); v1[j] = sigm(v1[j]); } }
          if (type == 4) { const int idx = cb - 28, br = idx >> 2, gg = idx & 1; bf16_t* base = bvT + (size_t)(((b * 2 + (br - 1)) * 2 + gg) * 128) * SL;
            store_vt(base, cin, pos, v0); store_vt(base, cin + 16, pos, v1); }
          else if (type == 5) { const int idx = cb - 56; bf16_t* base = cvT + (size_t)((b * 4 + (idx >> 1)) * 256 + (idx & 1) * 128) * SL;
            store_vt(base, cin, pos, v0); store_vt(base, cin + 16, pos, v1); }
          else { bf16_t* dp = h + (size_t)row * NPHYS + cb * 128 + cin;
            *(u32x2*)dp = (u32x2){cvtpk(v0[0], v0[1]), cvtpk(v0[2], v0[3])}; *(u32x2*)(dp + 16) = (u32x2){cvtpk(v1[0], v1[1]), cvtpk(v1[2], v1[3])}; }
        }
    }
  }
};

struct EpiAup {
  static constexpr bool PERM = false, AFTER_DRAIN = false;
  bf16_t* ak; bf16_t* avT; const float* srow; const float* ropeA;
  DI void operator()(const AccT& acc, const Unit& u, int wr, int wc, int fr, int fq) const {
#pragma unroll
    for (int bj = 0; bj < 2; ++bj) {
      const int cb = u.pn * 2 + bj;
#pragma unroll
      for (int ai = 0; ai < 2; ++ai)
#pragma unroll
        for (int m = 0; m < 4; ++m) {
          const int row = u.pm * BM + ai * HALF + wr * 64 + m * 16 + fr, pos = row & (SL - 1), b = row >> 12;
          const float s = srow[row];
          f32x4 v0 = acc[ai][bj][m][0] * s, v1 = acc[ai][bj][m][1] * s;
          const int cin = wc * 32 + 4 * fq;
          if (cb < 8) { if (wc == 0) rope128(v0, v1, ropeA, pos, fq);
            bf16_t* dp = ak + (size_t)row * 1024 + cb * 128 + cin;
            *(u32x2*)dp = (u32x2){cvtpk(v0[0], v0[1]), cvtpk(v0[2], v0[3])}; *(u32x2*)(dp + 16) = (u32x2){cvtpk(v1[0], v1[1]), cvtpk(v1[2], v1[3])}; }
          else { bf16_t* base = avT + (size_t)((b * 8 + (cb - 8)) * 128) * SL; store_vt(base, cin, pos, v0); store_vt(base, cin + 16, pos, v1); }
        }
    }
  }
};

struct EpiF32 {
  static constexpr bool PERM = false, AFTER_DRAIN = false;
  float* C; int ldc;
  DI void operator()(const AccT& acc, const Unit& u, int wr, int wc, int fr, int fq) const {
#pragma unroll
    for (int ai = 0; ai < 2; ++ai)
#pragma unroll
      for (int m = 0; m < 4; ++m) { float* rowp = C + (size_t)(u.pm * BM + ai * HALF + wr * 64 + m * 16 + fr) * ldc + u.pn * BM + wc * 32 + 4 * fq;
#pragma unroll
        for (int bj = 0; bj < 2; ++bj)
#pragma unroll
          for (int n = 0; n < 2; ++n) *(f32x4*)(rowp + bj * HALF + n * 16) = acc[ai][bj][m][n]; }
  }
};

struct EpiHalfF32 {
  static constexpr bool PERM = false, AFTER_DRAIN = false;
  float* C;
  DI void operator()(const AccT& acc, const Unit& u, int wr, int wc, int fr, int fq) const {
#pragma unroll
    for (int ai = 0; ai < 2; ++ai)
#pragma unroll
      for (int m = 0; m < 4; ++m) { float* rowp = C + (size_t)(u.pm * BM + ai * HALF + wr * 64 + m * 16 + fr) * 128 + wc * 32 + 4 * fq;
#pragma unroll
        for (int n = 0; n < 2; ++n) *(f32x4*)(rowp + n * 16) = acc[ai][0][m][n]; }
  }
};

struct EpiGate {
  static constexpr bool PERM = true, AFTER_DRAIN = false;
  const bf16_t* h; float* tmp; bf16_t* merged; int r;
  DI void operator()(const AccT& acc, const Unit& u, int wr, int wc, int fr, int fq) const {
#pragma unroll
    for (int ai = 0; ai < 2; ++ai)
#pragma unroll
      for (int m = 0; m < 4; ++m) {
        const int row = u.pm * BM + ai * HALF + wr * 64 + m * 16 + fr;
#pragma unroll
        for (int bj = 0; bj < 2; ++bj) {
          const int c8 = u.pn * BM + bj * HALF + wc * 32 + 8 * fq;
          const bf16x8 gt = __builtin_nontemporal_load((const bf16x8*)(h + (size_t)row * NPHYS + H_GL + r * 2048 + c8));
          bf16_t* mp = merged + (size_t)row * DM + c8;
          f32x4 a0 = acc[ai][bj][m][0], a1 = acc[ai][bj][m][1];
#pragma unroll
          for (int j = 0; j < 4; ++j) { a0[j] *= bf2f((bf16_t)gt[j]); a1[j] *= bf2f((bf16_t)gt[4 + j]); }
          if (r > 0) { const bf16x8 pv = *(const bf16x8*)mp;
#pragma unroll
            for (int j = 0; j < 4; ++j) { a0[j] += bf2f((bf16_t)pv[j]); a1[j] += bf2f((bf16_t)pv[4 + j]); } }
          { u32x4 w = {cvtpk(a0[0], a0[1]), cvtpk(a0[2], a0[3]), cvtpk(a1[0], a1[1]), cvtpk(a1[2], a1[3])}; *(u32x4*)mp = w; }
        }
      }
  }
};

struct EpiRes {
  static constexpr bool PERM = false, AFTER_DRAIN = false;
  const float* xin; const float* gv  ; float* z;
  DI void operator()(const AccT& acc, const Unit& u, int wr, int wc, int fr, int fq) const {
#pragma unroll
    for (int ai = 0; ai < 2; ++ai)
#pragma unroll
      for (int m = 0; m < 4; ++m) {
        const int row = u.pm * BM + ai * HALF + wr * 64 + m * 16 + fr, b = row >> 12;
#pragma unroll
        for (int bj = 0; bj < 2; ++bj)
#pragma unroll
          for (int n = 0; n < 2; ++n) { const int c = u.pn * BM + bj * HALF + wc * 32 + n * 16 + 4 * fq;
            const f32x4 xv = *(const f32x4*)(xin + (size_t)row * DM + c), g = *(const f32x4*)(gv + b * 12288 + c);
            f32x4 o; for (int j = 0; j < 4; ++j) o[j] = ALPHA * xv[j] + g[j] * acc[ai][bj][m][n][j];
            *(f32x4*)(z + (size_t)row * DM + c) = o; }
      }
  }
};


DI void ln_exchange(const AccT& acc, LAS float* red, float* stats, unsigned* cnt, int pm, int pn, int tid, int wr, int wc, int fr, int fq) {
#pragma unroll
  for (int ai = 0; ai < 2; ++ai)
#pragma unroll
    for (int m = 0; m < 4; ++m) {
      float s1 = 0.f, s2 = 0.f;
#pragma unroll
      for (int bj = 0; bj < 2; ++bj)
#pragma unroll
        for (int n = 0; n < 2; ++n)
#pragma unroll
          for (int j = 0; j < 4; ++j) { const float x = acc[ai][bj][m][n][j]; s1 += x; s2 += x * x; }
      s1 += __shfl_xor(s1, 16); s2 += __shfl_xor(s2, 16); s1 += __shfl_xor(s1, 32); s2 += __shfl_xor(s2, 32);
      if (fq == 0) { const int rl = ai * 128 + wr * 64 + m * 16 + fr; red[(rl * 4 + wc) * 2] = s1; red[(rl * 4 + wc) * 2 + 1] = s2; }
    }
  __syncthreads();
  if (tid < 256) { float a = 0.f, b = 0.f;
#pragma unroll
    for (int w = 0; w < 4; ++w) { a += red[(tid * 4 + w) * 2]; b += red[(tid * 4 + w) * 2 + 1]; }
    float* sp = stats + ((size_t)(pm * 256 + tid) * 8 + pn) * 2;
    __hip_atomic_store(sp, a, __ATOMIC_RELAXED, __HIP_MEMORY_SCOPE_AGENT); __hip_atomic_store(sp + 1, b, __ATOMIC_RELAXED, __HIP_MEMORY_SCOPE_AGENT); }
  asm volatile("s_waitcnt vmcnt(0)" ::: "memory");
  __syncthreads();
  if (tid == 0) {
    __builtin_amdgcn_fence(__ATOMIC_RELEASE, "agent");
    asm volatile("s_waitcnt vmcnt(0)" ::: "memory");
    __hip_atomic_fetch_add(cnt + pm, 1u, __ATOMIC_RELAXED, __HIP_MEMORY_SCOPE_AGENT);
    unsigned sp_ = 0;
    while (__hip_atomic_load(cnt + pm, __ATOMIC_RELAXED, __HIP_MEMORY_SCOPE_AGENT) < 8u) { __builtin_amdgcn_s_sleep(1); if (++sp_ > (1u << 24)) break; }
    __builtin_amdgcn_fence(__ATOMIC_ACQUIRE, "agent");
    asm volatile("s_waitcnt vmcnt(0)" ::: "memory");
  }
  __syncthreads();
  if (tid < 256) { float a = 0.f, b = 0.f; const float* sp = stats + (size_t)(pm * 256 + tid) * 16;
#pragma unroll
    for (int w = 0; w < 8; ++w) { a += __hip_atomic_load(sp + 2 * w, __ATOMIC_RELAXED, __HIP_MEMORY_SCOPE_AGENT); b += __hip_atomic_load(sp + 2 * w + 1, __ATOMIC_RELAXED, __HIP_MEMORY_SCOPE_AGENT); }
    const float mean = a * (1.f / DM), var = fmaxf(b * (1.f / DM) - mean * mean, 0.f);
    red[2048 + tid * 2] = mean; red[2048 + tid * 2 + 1] = rsqrtf(var + 1e-5f); }
  __syncthreads();
}

struct EpiLnFused {
  static constexpr bool PERM = false, AFTER_DRAIN = true;
  const float* xin; const float* gv; const float* gam; const float* bet; float* xout;
  const float* modn; int sh_idx, sc_idx; bf16_t* uout;
  float* stats; unsigned* cnt;
  DI void operator()(const AccT&, const Unit&, int, int, int, int) const {}
  DI void fused(AccT& acc, const Unit& u, LAS unsigned char* lds, int tid, int wr, int wc, int fr, int fq) const {
    LAS float* red = (LAS float*)lds;
    const int row0 = u.pm * BM + wr * 64 + fr, col0 = u.pn * BM + wc * 32 + 4 * fq, b = (u.pm * BM) >> 12;
    { f32x4 g[2][2], xc[2][2], xn[2][2];
#pragma unroll
      for (int bj = 0; bj < 2; ++bj)
#pragma unroll
        for (int n = 0; n < 2; ++n) g[bj][n] = *(const f32x4*)(gv + b * 12288 + col0 + bj * HALF + n * 16);
      { const float* xr = xin + (size_t)row0 * DM + col0;
#pragma unroll
        for (int bj = 0; bj < 2; ++bj)
#pragma unroll
          for (int n = 0; n < 2; ++n) xc[bj][n] = __builtin_nontemporal_load((const f32x4*)(xr + bj * HALF + n * 16)); }
#pragma unroll
      for (int k = 0; k < 8; ++k) { const int ai = k >> 2, m = k & 3;
        if (k < 7) { const int k1 = k + 1; const float* xr = xin + (size_t)(row0 + (k1 >> 2) * HALF + (k1 & 3) * 16) * DM + col0; asm volatile("" : "+v"(xr));
#pragma unroll
          for (int bj = 0; bj < 2; ++bj)
#pragma unroll
            for (int n = 0; n < 2; ++n) xn[bj][n] = __builtin_nontemporal_load((const f32x4*)(xr + bj * HALF + n * 16)); }
#pragma unroll
        for (int bj = 0; bj < 2; ++bj)
#pragma unroll
          for (int n = 0; n < 2; ++n)
#pragma unroll
            for (int j = 0; j < 4; ++j) acc[ai][bj][m][n][j] = ALPHA * xc[bj][n][j] + g[bj][n][j] * acc[ai][bj][m][n][j];
        asm volatile("" :: "v"(acc[ai][0][m][0]), "v"(acc[ai][0][m][1]), "v"(acc[ai][1][m][0]), "v"(acc[ai][1][m][1]));
#pragma unroll
        for (int bj = 0; bj < 2; ++bj)
#pragma unroll
          for (int n = 0; n < 2; ++n) xc[bj][n] = xn[bj][n]; } }
    ln_exchange(acc, red, stats, cnt, u.pm, u.pn, tid, wr, wc, fr, fq);
    { f32x4 g[2][2], bb[2][2];
#pragma unroll
      for (int bj = 0; bj < 2; ++bj)
#pragma unroll
        for (int n = 0; n < 2; ++n) { g[bj][n] = *(const f32x4*)(gam + col0 + bj * HALF + n * 16); bb[bj][n] = *(const f32x4*)(bet + col0 + bj * HALF + n * 16); }
#pragma unroll
      for (int ai = 0; ai < 2; ++ai)
#pragma unroll
        for (int m = 0; m < 4; ++m) { const int rl = ai * 128 + wr * 64 + m * 16 + fr; const float mean = red[2048 + rl * 2], rstd = red[2048 + rl * 2 + 1];
          float* xo = xout + (size_t)(u.pm * BM + rl) * DM + col0;
#pragma unroll
          for (int bj = 0; bj < 2; ++bj)
#pragma unroll
            for (int n = 0; n < 2; ++n) { f32x4 o;
#pragma unroll
              for (int j = 0; j < 4; ++j) { o[j] = (acc[ai][bj][m][n][j] - mean) * rstd * g[bj][n][j] + bb[bj][n][j]; acc[ai][bj][m][n][j] = o[j]; }
              *(f32x4*)(xo + bj * HALF + n * 16) = o; } } }
    if (uout) {
      __syncthreads();
      ln_exchange(acc, red, stats + (size_t)32 * 256 * 16, cnt + 32, u.pm, u.pn, tid, wr, wc, fr, fq);
      f32x4 sc[2][2], sh[2][2];
#pragma unroll
      for (int bj = 0; bj < 2; ++bj)
#pragma unroll
        for (int n = 0; n < 2; ++n) { sc[bj][n] = *(const f32x4*)(modn + b * 12288 + sc_idx * 2048 + col0 + bj * HALF + n * 16); sh[bj][n] = *(const f32x4*)(modn + b * 12288 + sh_idx * 2048 + col0 + bj * HALF + n * 16); }
#pragma unroll
      for (int ai = 0; ai < 2; ++ai)
#pragma unroll
        for (int m = 0; m < 4; ++m) { const int rl = ai * 128 + wr * 64 + m * 16 + fr; const float mean = red[2048 + rl * 2], rstd = red[2048 + rl * 2 + 1];
          bf16_t* uo = uout + (size_t)(u.pm * BM + rl) * DM + col0;
#pragma unroll
          for (int bj = 0; bj < 2; ++bj)
#pragma unroll
            for (int n = 0; n < 2; ++n) { float o[4];
#pragma unroll
              for (int j = 0; j < 4; ++j) o[j] = (acc[ai][bj][m][n][j] - mean) * rstd * (1.f + sc[bj][n][j]) + sh[bj][n][j];
              *(u32x2*)(uo + bj * HALF + n * 16) = (u32x2){cvtpk(o[0], o[1]), cvtpk(o[2], o[3])}; } }
    }
    __syncthreads();
  }
};

struct EpiSwiglu {
  static constexpr bool PERM = false, AFTER_DRAIN = false;
  bf16_t* hid;
  DI void operator()(const AccT& acc, const Unit& u, int wr, int wc, int fr, int fq) const {
#pragma unroll
    for (int ai = 0; ai < 2; ++ai)
#pragma unroll
      for (int m = 0; m < 4; ++m) {
        const int row = u.pm * BM + ai * HALF + wr * 64 + m * 16 + fr;
#pragma unroll
        for (int bj = 0; bj < 2; ++bj) { const int hc = (u.pn * BM + bj * HALF + wc * 32) / 2 + 4 * fq;
          const f32x4 g = acc[ai][bj][m][0], up = acc[ai][bj][m][1];
          float o[4]; for (int j = 0; j < 4; ++j) o[j] = silu(g[j]) * up[j];
          *(u32x2*)(hid + (size_t)row * DFF + hc) = (u32x2){cvtpk(o[0], o[1]), cvtpk(o[2], o[3])}; }
      }
  }
};

DI int fetch_item(unsigned* ctr0, int* slot) {
  __syncthreads();
  unsigned long long ca = (unsigned long long)ctr0; asm volatile("" : "+s"(ca));
  unsigned* ctr = (unsigned*)ca;
  if (ltid() == 0) *slot = (int)atomicAdd(ctr, 1u);
  __syncthreads();
  return *slot;
}

DI void idxsel_phase(unsigned char* lds, const bf16_t* __restrict__ hbuf, const bf16_t* __restrict__ ikn, const float* __restrict__ iwf, u64* __restrict__ bits, unsigned* ctr) {
  const int tid = ltid(), wid = tid >> 6, lane = tid & 63, i32 = lane & 31, kh = lane >> 5;
  int* slot = (int*)(lds + SLOT_OFF);
  LAS float* sc_l = (LAS float*)(LAS unsigned char*)lds;
  const int qi = (i32 >> 2) & 1, hd = (i32 & 3) + 4 * (i32 >> 3);
  for (;;) {
    const int it = fetch_item(ctr, slot);
    if (it >= 1024) break;
    const int b = it & 1, jq = 511 - (it >> 1), t0 = b * SL + 8 * jq, ntile = (8 * jq + 8 + 31) >> 5;
    { bf16x8 a[4][4]; f32x4 w[4][4];
#pragma unroll
      for (int u = 0; u < 4; ++u) {
        const bf16_t* ap = hbuf + (size_t)(t0 + 2 * u + qi) * NPHYS + H_IQ + hd * 64 + kh * 8;
        const float* wp = iwf + (size_t)(t0 + 2 * u + kh) * 16;
#pragma unroll
        for (int ks = 0; ks < 4; ++ks) { a[u][ks] = *(const bf16x8*)(ap + ks * 16); w[u][ks] = *(const f32x4*)(wp + 4 * ks); }
      }
      if (wid < ntile) {
        const bf16_t* kp = ikn + (size_t)(b * SL + 32 * wid + i32) * 64 + kh * 8;
        bf16x8 nb[4];
#pragma unroll
        for (int ks = 0; ks < 4; ++ks) nb[ks] = *(const bf16x8*)(kp + ks * 16);
        for (int kt = wid; kt < ntile; kt += 8) {
          bf16x8 bfr[4];
#pragma unroll
          for (int ks = 0; ks < 4; ++ks) bfr[ks] = nb[ks];
          if (kt + 8 < ntile) { kp += 8 * 32 * 64;
#pragma unroll
            for (int ks = 0; ks < 4; ++ks) nb[ks] = *(const bf16x8*)(kp + ks * 16); }
#pragma unroll
          for (int u = 0; u < 4; ++u) {
            f32x16 acc = {};
#pragma unroll
            for (int ks = 0; ks < 4; ++ks) acc = __builtin_amdgcn_mfma_f32_32x32x16_bf16(a[u][ks], bfr[ks], acc, 0, 0, 0);
            float sc = 0.f;
#pragma unroll
            for (int r4 = 0; r4 < 4; ++r4)
#pragma unroll
              for (int jj = 0; jj < 4; ++jj) sc += fmaxf(acc[4 * r4 + jj], 0.f) * w[u][r4][jj];
            sc_l[(2 * u + kh) * 4096 + 32 * kt + i32] = sc;
          }
        }
      }
    }
    __syncthreads();
    { const int t = 8 * jq + wid, row = t0 + wid;
      const LAS float* sr = sc_l + wid * 4096;
      unsigned key[64];
#pragma unroll
      for (int i = 0; i < 64; ++i) { const int sidx = 64 * i + lane; unsigned k = 0;
        if (sidx <= t) { const unsigned uu = __float_as_uint(sr[sidx]); k = (uu & 0x80000000u) ? ~uu : (uu | 0x80000000u); }
        key[i] = k; }
      unsigned thr = 0;
      if (t + 1 > 256) {
        for (int bit = 31; bit >= 0; --bit) {
          const unsigned cand = thr | (1u << bit);
          int cnt = 0;
#pragma unroll
          for (int i = 0; i < 64; ++i) cnt += __popcll(__ballot(key[i] >= cand));
          if (cnt >= 256) thr = cand;
          if (cnt == 256) break;
        }
      }
      u64 mine = 0;
#pragma unroll
      for (int i = 0; i < 64; ++i) { const int sidx = 64 * i + lane; const u64 wv = __ballot(sidx <= t && key[i] >= thr); if (lane == i) mine = wv; }
      bits[(size_t)row * 64 + lane] = mine;
    }
  }
}

enum { M_CAUSAL = 0, M_WINDOW = 1, M_BITS = 2, M_SLC = 3, M_CMP = 4 };
DI u64 cmask(int n) { return n >= 64 ? ~0ull : (n <= 0 ? 0ull : ((1ull << n) - 1ull)); }

template <int MODE, int DV>
DI void attn_core(LAS unsigned char* lds, const bf16_t* __restrict__ Qp, int ldq, const bf16_t* __restrict__ Kp, int ldk, const bf16_t* __restrict__ Vtp, int ldv,
                  int tq0, int jt_lo, int jt_hi, const u64* __restrict__ mk, float* __restrict__ pdump, f32x16 (&o)[DV / 32], float& m_out, float& l_out) {
  constexpr int ND = DV / 32, VBYTES = DV * 136, KBAT = DV == 256 ? 1 : 4, VBAT = DV == 256 ? 1 : 2;
  const int tid = ltid(), wid = tid >> 6, lane = tid & 63, r32 = lane & 31, hi = lane >> 5;
  const int tq = tq0 + wid * 32 + r32;
  constexpr int NQR = DV == 256 ? 4 : 8;
  const bf16_t* qlane = Qp + (size_t)(wid * 32 + r32) * ldq + hi * 8;
  bf16x8 qr[NQR];
#pragma unroll
  for (int d0 = 0; d0 < NQR; ++d0) qr[d0] = *(const bf16x8*)(qlane + d0 * 16);
  LAS float* wsc = (LAS float*)(lds + 34816 + 2 * VBYTES) + wid * 64;
  const int krow = tid >> 3, kc16 = tid & 7, vrow = tid >> 2, vc = tid & 3;
  bf16x8 sk0, sk1, sv0, sv1;
#define AT_LOAD_K(jt) do { const bf16_t* kp_ = Kp + (size_t)((jt) * 64 + krow) * ldk + kc16 * 8; sk0 = *(const bf16x8*)kp_; sk1 = *(const bf16x8*)(kp_ + 64); } while (0)
#define AT_LOAD_V(jt, half) do { const bf16_t* vp_ = Vtp + (size_t)(vrow + 128 * (half)) * ldv + (jt) * 64 + vc * 8; sv0 = *(const bf16x8*)vp_; sv1 = *(const bf16x8*)(vp_ + 32); } while (0)
#define AT_WRITE_K(buf) do { LAS unsigned char* kb_ = lds + (buf) * 17408 + krow * 272 + kc16 * 16; *(LAS bf16x8*)kb_ = sk0; *(LAS bf16x8*)(kb_ + 128) = sk1; } while (0)
#define AT_WRITE_V(buf, half) do { LAS unsigned char* vb_ = lds + 34816 + (buf) * VBYTES + (vrow + 128 * (half)) * 136 + vc * 16; \
    *(LAS s16x4*)vb_ = __builtin_shufflevector(sv0, sv0, 0, 1, 2, 3); *(LAS s16x4*)(vb_ + 8) = __builtin_shufflevector(sv0, sv0, 4, 5, 6, 7); \
    *(LAS s16x4*)(vb_ + 64) = __builtin_shufflevector(sv1, sv1, 0, 1, 2, 3); *(LAS s16x4*)(vb_ + 72) = __builtin_shufflevector(sv1, sv1, 4, 5, 6, 7); } while (0)
  float m_reg = -1e30f, l_reg = 0.f;
#pragma unroll
  for (int d = 0; d < ND; ++d) o[d] = (f32x16){};
  u64 selw = 0;
  if (MODE == M_SLC) selw = mk[wid * 32 + r32];
  const int tcmp = tq >= 31 ? ((tq - 31) >> 4) : -1;
  const bool trail_ = __builtin_amdgcn_readfirstlane(wid) >= 4;
  if (trail_) __builtin_amdgcn_s_setprio(1);
  AT_LOAD_K(jt_lo); AT_LOAD_V(jt_lo, 0); AT_WRITE_K(0); AT_WRITE_V(0, 0);
  if (DV == 256) { AT_LOAD_V(jt_lo, 1); AT_WRITE_V(0, 1); }
  __syncthreads();
  int cur = 0;
  for (int jt = jt_lo; jt < jt_hi; ++jt) {
    const bool pre = jt + 1 < jt_hi;
    bf16x8 qx[4];
    if (DV == 256) { const bf16_t* q2 = qlane; asm volatile("" : "+v"(q2));
#pragma unroll
      for (int u = 0; u < 4; ++u) qx[u] = *(const bf16x8*)(q2 + (4 + u) * 16); }
    if (pre) { AT_LOAD_K(jt + 1); AT_LOAD_V(jt + 1, 0); }
    const int kb = jt * 64;
    u64 allow;
    if (MODE == M_CAUSAL) allow = cmask(tq - kb + 1);
    else if (MODE == M_WINDOW) allow = cmask(tq - kb + 1) & ~cmask(tq - 512 - kb + 1);
    else if (MODE == M_BITS) allow = mk[(size_t)(wid * 32 + r32) * 64 + jt] & cmask(tq - kb + 1);
    else if (MODE == M_SLC) allow = ((selw >> jt) & 1ull) ? cmask(tq - kb + 1) : 0ull;
    else allow = cmask(tcmp - kb + 1);
    const bool act = MODE == M_CMP || __any(allow != 0ull);
    bf16x8 pa[4];
    if (act) {
      const LAS unsigned char* Kb = lds + cur * 17408 + r32 * 272 + hi * 16;
      f32x16 p0 = {}, p1 = {};
#pragma unroll
      for (int db = 0; db < 8; db += KBAT) { bf16x8 ka[KBAT], kc[KBAT];
#pragma unroll
        for (int u = 0; u < KBAT; ++u) { ka[u] = *(const LAS bf16x8*)(Kb + (db + u) * 32); kc[u] = *(const LAS bf16x8*)(Kb + 32 * 272 + (db + u) * 32); }
        __builtin_amdgcn_sched_barrier(0);
#pragma unroll
        for (int u = 0; u < KBAT; ++u) { const int d0 = db + u; const bf16x8 qf = d0 < NQR ? qr[d0 < NQR ? d0 : 0] : qx[d0 >= NQR ? d0 - NQR : 0];
          p0 = __builtin_amdgcn_mfma_f32_32x32x16_bf16(ka[u], qf, p0, 0, 0, 0);
          p1 = __builtin_amdgcn_mfma_f32_32x32x16_bf16(kc[u], qf, p1, 0, 0, 0); }
        __builtin_amdgcn_sched_barrier(0); }
      if (pre) AT_WRITE_K(cur ^ 1);
      if (!__all(allow == ~0ull)) {
        const u64 a = ~(allow >> (4 * hi)); const int nlo = (int)(unsigned)a, nhw = (int)(unsigned)(a >> 32);
#pragma unroll
        for (int r = 0; r < 16; ++r) { const int cp = (r & 3) + 8 * (r >> 2);
          const unsigned b0 = ((unsigned)((nlo << (31 - cp)) >> 31) & 0x80000000u) | 0x7f800000u, b1 = ((unsigned)((nhw << (31 - cp)) >> 31) & 0x80000000u) | 0x7f800000u;
          p0[r] = vmin_raw(p0[r], __uint_as_float(b0)); p1[r] = vmin_raw(p1[r], __uint_as_float(b1)); }
      }
      if (MODE == M_CMP) {
        float* pr = pdump + (size_t)(wid * 32 + r32) * 256 + kb + 4 * hi;
#pragma unroll
        for (int g4 = 0; g4 < 4; ++g4) { *(f32x4*)(pr + 8 * g4) = (f32x4){p0[4 * g4], p0[4 * g4 + 1], p0[4 * g4 + 2], p0[4 * g4 + 3]};
          *(f32x4*)(pr + 32 + 8 * g4) = (f32x4){p1[4 * g4], p1[4 * g4 + 1], p1[4 * g4 + 2], p1[4 * g4 + 3]}; }
      }
      float mx = p0[0];
#pragma unroll
      for (int r = 1; r < 16; ++r) mx = fmaxf(mx, p0[r]);
#pragma unroll
      for (int r = 0; r < 16; ++r) mx = fmaxf(mx, p1[r]);
      mx = fmaxf(mx, __shfl_xor(mx, 32));
      float mn = m_reg, alpha = 1.f;
      if (!__all((mx - m_reg) * C2 <= 8.f)) { mn = fmaxf(m_reg, mx); alpha = __builtin_amdgcn_exp2f((m_reg - mn) * C2); m_reg = mn; }
      const float nm = -mn * C2;
      float ps = 0.f;
#pragma unroll
      for (int r = 0; r < 16; ++r) { p0[r] = __builtin_amdgcn_exp2f(fmaf(p0[r], C2, nm)); p1[r] = __builtin_amdgcn_exp2f(fmaf(p1[r], C2, nm)); ps += p0[r] + p1[r]; }
      ps += __shfl_xor(ps, 32);
      l_reg = l_reg * alpha + ps;
      if (__any(alpha < 1.f)) {
        if (hi == 0) wsc[r32] = alpha;
        asm volatile("s_waitcnt lgkmcnt(0)" ::: "memory");
#pragma unroll
        for (int r = 0; r < 16; ++r) { const float al = wsc[crow(r, hi)];
#pragma unroll
          for (int d = 0; d < ND; ++d) o[d][r] *= al; }
        asm volatile("s_waitcnt lgkmcnt(0)" ::: "memory");
      }
      { u32x4 w;
        w = (u32x4){cvtpk(p0[0], p0[1]), cvtpk(p0[2], p0[3]), cvtpk(p0[4], p0[5]), cvtpk(p0[6], p0[7])}; pa[0] = *reinterpret_cast<bf16x8*>(&w);
        w = (u32x4){cvtpk(p0[8], p0[9]), cvtpk(p0[10], p0[11]), cvtpk(p0[12], p0[13]), cvtpk(p0[14], p0[15])}; pa[1] = *reinterpret_cast<bf16x8*>(&w);
        w = (u32x4){cvtpk(p1[0], p1[1]), cvtpk(p1[2], p1[3]), cvtpk(p1[4], p1[5]), cvtpk(p1[6], p1[7])}; pa[2] = *reinterpret_cast<bf16x8*>(&w);
        w = (u32x4){cvtpk(p1[8], p1[9]), cvtpk(p1[10], p1[11]), cvtpk(p1[12], p1[13]), cvtpk(p1[14], p1[15])}; pa[3] = *reinterpret_cast<bf16x8*>(&w); }
    }
    if (pre && !act) AT_WRITE_K(cur ^ 1);
    if (DV == 256 && pre) { AT_WRITE_V(cur ^ 1, 0); AT_LOAD_V(jt + 1, 1); }
    if (act) {
      const LAS unsigned char* Vb = lds + 34816 + cur * VBYTES + r32 * 136 + hi * 8;
#pragma unroll
      for (int dbb = 0; dbb < ND; dbb += VBAT) { bf16x8 vf[VBAT * 4];
#pragma unroll
        for (int u = 0; u < VBAT; ++u)
#pragma unroll
          for (int s = 0; s < 4; ++s) { const int d = dbb + u; const s16x4 lo4 = *(const LAS s16x4*)(Vb + d * 32 * 136 + s * 32), hi4 = *(const LAS s16x4*)(Vb + d * 32 * 136 + s * 32 + 16);
            vf[u * 4 + s] = __builtin_shufflevector(lo4, hi4, 0, 1, 2, 3, 4, 5, 6, 7); }
        __builtin_amdgcn_sched_barrier(0);
#pragma unroll
        for (int u = 0; u < VBAT; ++u)
#pragma unroll
          for (int s = 0; s < 4; ++s) o[dbb + u] = __builtin_amdgcn_mfma_f32_32x32x16_bf16(pa[s], vf[u * 4 + s], o[dbb + u], 0, 0, 0);
        __builtin_amdgcn_sched_barrier(0); }
    }
    if (pre) { AT_WRITE_V(cur ^ 1, DV == 256 ? 1 : 0); }
    __syncthreads();
    cur ^= 1;
  }
  if (trail_) __builtin_amdgcn_s_setprio(0);
  if (hi == 0) wsc[r32] = l_reg;
  asm volatile("s_waitcnt lgkmcnt(0)" ::: "memory");
#pragma unroll
  for (int r = 0; r < 16; ++r) { const float lr = wsc[crow(r, hi)]; const float inv = lr > 0.f ? 1.f / lr : 0.f;
#pragma unroll
    for (int d = 0; d < ND; ++d) o[d][r] *= inv; }
  asm volatile("s_waitcnt lgkmcnt(0)" ::: "memory");
  m_out = m_reg; l_out = l_reg;
#undef AT_LOAD_K
#undef AT_LOAD_V
#undef AT_WRITE_K
#undef AT_WRITE_V
}


template <int MODE>
DI void attn_core_skew(LAS unsigned char* lds, const bf16_t* __restrict__ Qp, int ldq, const bf16_t* __restrict__ Kp, int ldk, const bf16_t* __restrict__ Vtp, int ldv,
                       int tq0, int jt_lo, int jt_hi, const u64* __restrict__ mk, float* __restrict__ pdump, f32x16 (&o)[4], float& m_out, float& l_out) {
  const int tid = ltid(), wid = tid >> 6, lane = tid & 63, r32 = lane & 31, hi = lane >> 5;
  const bool lead = __builtin_amdgcn_readfirstlane(wid) < 4;
  if (!lead) __builtin_amdgcn_s_setprio(1);
  const int tq = tq0 + wid * 32 + r32;
  const bf16_t* qlane = Qp + (size_t)(wid * 32 + r32) * ldq + hi * 8;
  bf16x8 qr[8];
#pragma unroll
  for (int d0 = 0; d0 < 8; ++d0) qr[d0] = *(const bf16x8*)(qlane + d0 * 16);
  LAS float* wsc = (LAS float*)(lds + 34816 + 2 * 17408) + wid * 64;
  const int st = tid & 255, krow = st >> 4, kch = st & 15, vrow = st >> 3, vch = st & 7;
  bf16x8 sgc[4], sgn[4];
#define SK_BAR() do { asm volatile("s_waitcnt lgkmcnt(0)" ::: "memory"); __builtin_amdgcn_s_barrier(); asm volatile("" ::: "memory"); } while (0)
#define SK_LOAD(sg, jt) do { if (lead) { const bf16_t* kp_ = Kp + (size_t)((jt) * 64 + krow) * ldk + kch * 8; \
      _Pragma("unroll") for (int i_ = 0; i_ < 4; ++i_) sg[i_] = *(const bf16x8*)(kp_ + (size_t)(16 * i_) * ldk); } \
    else { const bf16_t* vp_ = Vtp + (size_t)vrow * ldv + (jt) * 64 + vch * 8; \
      _Pragma("unroll") for (int i_ = 0; i_ < 4; ++i_) sg[i_] = *(const bf16x8*)(vp_ + (size_t)(32 * i_) * ldv); } } while (0)
#define SK_WRITE(sg, buf) do { if (lead) { LAS unsigned char* kb_ = lds + (buf) * 17408 + krow * 272 + kch * 16; \
      _Pragma("unroll") for (int i_ = 0; i_ < 4; ++i_) *(LAS bf16x8*)(kb_ + i_ * 16 * 272) = sg[i_]; } \
    else { LAS unsigned char* vb_ = lds + 34816 + (buf) * 17408 + vrow * 136 + vch * 16; \
      _Pragma("unroll") for (int i_ = 0; i_ < 4; ++i_) { *(LAS s16x4*)(vb_ + i_ * 32 * 136) = __builtin_shufflevector(sg[i_], sg[i_], 0, 1, 2, 3); \
        *(LAS s16x4*)(vb_ + i_ * 32 * 136 + 8) = __builtin_shufflevector(sg[i_], sg[i_], 4, 5, 6, 7); } } } while (0)
  float m_reg = -1e30f, l_reg = 0.f;
#pragma unroll
  for (int d = 0; d < 4; ++d) o[d] = (f32x16){};
  u64 selw = 0;
  if (MODE == M_SLC) selw = mk[wid * 32 + r32];
  const int tcmp = tq >= 31 ? ((tq - 31) >> 4) : -1;
  const u64* mrow = mk + (size_t)(wid * 32 + r32) * 64;
  u64 bw = 0; if (MODE == M_BITS) bw = mrow[jt_lo];
  SK_LOAD(sgc, jt_lo); SK_WRITE(sgc, 0);
  if (jt_lo + 1 < jt_hi) SK_LOAD(sgc, jt_lo + 1);
  SK_BAR();
  if (!lead) SK_BAR();
  int cur = 0;
  for (int jt = jt_lo; jt < jt_hi; ++jt) {
    const bool pre = jt + 1 < jt_hi;
    if (jt + 2 < jt_hi) SK_LOAD(sgn, jt + 2);
    u64 bwn = 0; if (MODE == M_BITS && pre) bwn = mrow[jt + 1];
    const int kb = jt * 64;
    u64 allow;
    if (MODE == M_CAUSAL) allow = cmask(tq - kb + 1);
    else if (MODE == M_WINDOW) allow = cmask(tq - kb + 1) & ~cmask(tq - 512 - kb + 1);
    else if (MODE == M_BITS) allow = bw & cmask(tq - kb + 1);
    else if (MODE == M_SLC) allow = ((selw >> jt) & 1ull) ? cmask(tq - kb + 1) : 0ull;
    else allow = cmask(tcmp - kb + 1);
    const bool act = MODE == M_CMP || __any(allow != 0ull);
    f32x16 p0, p1;
    float alpha;
    if (act) {
      alpha = 1.f;
      const LAS unsigned char* Kb = lds + cur * 17408 + r32 * 272 + hi * 16;
#pragma unroll
      for (int db = 0; db < 8; db += 4) { bf16x8 ka[4], kc[4];
#pragma unroll
        for (int u = 0; u < 4; ++u) { ka[u] = *(const LAS bf16x8*)(Kb + (db + u) * 32); kc[u] = *(const LAS bf16x8*)(Kb + 32 * 272 + (db + u) * 32); }
        __builtin_amdgcn_sched_barrier(0);
#pragma unroll
        for (int u = 0; u < 4; ++u) { const f32x16 z = {};
          p0 = __builtin_amdgcn_mfma_f32_32x32x16_bf16(ka[u], qr[db + u], (db + u == 0) ? z : p0, 0, 0, 0);
          p1 = __builtin_amdgcn_mfma_f32_32x32x16_bf16(kc[u], qr[db + u], (db + u == 0) ? z : p1, 0, 0, 0); }
        __builtin_amdgcn_sched_barrier(0); }
      if (!__all(allow == ~0ull)) {
        const u64 a = ~(allow >> (4 * hi)); const int nlo = (int)(unsigned)a, nhw = (int)(unsigned)(a >> 32);
#pragma unroll
        for (int r = 0; r < 16; ++r) { const int cp = (r & 3) + 8 * (r >> 2);
          const unsigned b0 = ((unsigned)((nlo << (31 - cp)) >> 31) & 0x80000000u) | 0x7f800000u, b1 = ((unsigned)((nhw << (31 - cp)) >> 31) & 0x80000000u) | 0x7f800000u;
          p0[r] = vmin_raw(p0[r], __uint_as_float(b0)); p1[r] = vmin_raw(p1[r], __uint_as_float(b1)); }
      }
      if (MODE == M_CMP && __any(allow != 0ull)) {
        LAS float* pw = (LAS float*)(lds + PD_OFF + wid * 8704);
#pragma unroll
        for (int g4 = 0; g4 < 4; ++g4) { *(LAS f32x4*)(pw + r32 * 68 + 8 * g4 + 4 * hi) = (f32x4){p0[4 * g4], p0[4 * g4 + 1], p0[4 * g4 + 2], p0[4 * g4 + 3]};
          *(LAS f32x4*)(pw + r32 * 68 + 32 + 8 * g4 + 4 * hi) = (f32x4){p1[4 * g4], p1[4 * g4 + 1], p1[4 * g4 + 2], p1[4 * g4 + 3]}; }
        asm volatile("s_waitcnt lgkmcnt(0)" ::: "memory");
#pragma unroll
        for (int i = 0; i < 8; ++i) { const int c = i * 64 + lane, row = c >> 4, c16 = c & 15;
          *(f32x4*)(pdump + (size_t)(wid * 32 + row) * 256 + kb + c16 * 4) = *(const LAS f32x4*)(pw + row * 68 + c16 * 4);
        }
      }
      float mx = p0[0];
#pragma unroll
      for (int r = 1; r < 16; ++r) mx = fmaxf(mx, p0[r]);
#pragma unroll
      for (int r = 0; r < 16; ++r) mx = fmaxf(mx, p1[r]);
      mx = fmaxf(mx, __shfl_xor(mx, 32));
      float mn = m_reg;
      if (!__all((mx - m_reg) * C2 <= 8.f)) { mn = fmaxf(m_reg, mx); alpha = __builtin_amdgcn_exp2f((m_reg - mn) * C2); m_reg = mn; }
      const float nm = -mn * C2;
#pragma unroll
      for (int r = 0; r < 16; ++r) { p0[r] = __builtin_amdgcn_exp2f(fmaf(p0[r], C2, nm)); p1[r] = __builtin_amdgcn_exp2f(fmaf(p1[r], C2, nm)); }
    }
    SK_BAR();
    if (act) {
      float ps = 0.f;
#pragma unroll
      for (int r = 0; r < 16; ++r) ps += p0[r] + p1[r];
      ps += __shfl_xor(ps, 32);
      l_reg = l_reg * alpha + ps;
      if (__any(alpha < 1.f)) {
        if (hi == 0) wsc[r32] = alpha;
        asm volatile("s_waitcnt lgkmcnt(0)" ::: "memory");
#pragma unroll
        for (int r = 0; r < 16; ++r) { const float al = wsc[crow(r, hi)];
#pragma unroll
          for (int d = 0; d < 4; ++d) o[d][r] *= al; }
        asm volatile("s_waitcnt lgkmcnt(0)" ::: "memory");
      }
      bf16x8 pa[4];
      { u32x4 w;
        w = (u32x4){cvtpk(p0[0], p0[1]), cvtpk(p0[2], p0[3]), cvtpk(p0[4], p0[5]), cvtpk(p0[6], p0[7])}; pa[0] = *reinterpret_cast<bf16x8*>(&w);
        w = (u32x4){cvtpk(p0[8], p0[9]), cvtpk(p0[10], p0[11]), cvtpk(p0[12], p0[13]), cvtpk(p0[14], p0[15])}; pa[1] = *reinterpret_cast<bf16x8*>(&w);
        w = (u32x4){cvtpk(p1[0], p1[1]), cvtpk(p1[2], p1[3]), cvtpk(p1[4], p1[5]), cvtpk(p1[6], p1[7])}; pa[2] = *reinterpret_cast<bf16x8*>(&w);
        w = (u32x4){cvtpk(p1[8], p1[9]), cvtpk(p1[10], p1[11]), cvtpk(p1[12], p1[13]), cvtpk(p1[14], p1[15])}; pa[3] = *reinterpret_cast<bf16x8*>(&w); }
      const LAS unsigned char* Vb = lds + 34816 + cur * 17408 + r32 * 136 + hi * 8;
#pragma unroll
      for (int dbb = 0; dbb < 4; dbb += 2) { bf16x8 vf[8];
#pragma unroll
        for (int u = 0; u < 2; ++u)
#pragma unroll
          for (int s4 = 0; s4 < 4; ++s4) { const int d = dbb + u; const s16x4 lo4 = *(const LAS s16x4*)(Vb + d * 32 * 136 + s4 * 32), hi4 = *(const LAS s16x4*)(Vb + d * 32 * 136 + s4 * 32 + 16);
            vf[u * 4 + s4] = __builtin_shufflevector(lo4, hi4, 0, 1, 2, 3, 4, 5, 6, 7); }
        __builtin_amdgcn_sched_barrier(0);
#pragma unroll
        for (int u = 0; u < 2; ++u)
#pragma unroll
          for (int s4 = 0; s4 < 4; ++s4) o[dbb + u] = __builtin_amdgcn_mfma_f32_32x32x16_bf16(pa[s4], vf[u * 4 + s4], o[dbb + u], 0, 0, 0);
        __builtin_amdgcn_sched_barrier(0); }
    }
    if (pre) SK_WRITE(sgc, cur ^ 1);
    SK_BAR();
    cur ^= 1; bw = bwn;
#pragma unroll
    for (int i_ = 0; i_ < 4; ++i_) sgc[i_] = sgn[i_];
  }
  if (lead) SK_BAR();
  if (!lead) __builtin_amdgcn_s_setprio(0);
  if (hi == 0) wsc[r32] = l_reg;
  asm volatile("s_waitcnt lgkmcnt(0)" ::: "memory");
#pragma unroll
  for (int r = 0; r < 16; ++r) { const float lr = wsc[crow(r, hi)]; const float inv = lr > 0.f ? 1.f / lr : 0.f;
#pragma unroll
    for (int d = 0; d < 4; ++d) o[d][r] *= inv; }
  asm volatile("s_waitcnt lgkmcnt(0)" ::: "memory");
  m_out = m_reg; l_out = l_reg;
#undef SK_BAR
#undef SK_LOAD
#undef SK_WRITE
}

DI void store_o_bf16(LAS unsigned char* lds, bf16_t* dst, int rowg0, int hcol, const f32x16 (&o)[4]) {
  const int tid_ = ltid(), lane = tid_ & 63, wid = tid_ >> 6, r32 = lane & 31, hi = lane >> 5;
  LAS unsigned char* pw = lds + wid * 8704;
#pragma unroll
  for (int r = 0; r < 16; ++r)
#pragma unroll
    for (int d = 0; d < 4; ++d) *(LAS bf16_t*)(pw + crow(r, hi) * 272 + (d * 32 + r32) * 2) = f2bf(o[d][r]);
  asm volatile("s_waitcnt lgkmcnt(0)" ::: "memory");
#pragma unroll
  for (int i = 0; i < 8; ++i) { const int c = i * 64 + lane, row = c >> 4, c16 = c & 15;
    *(u32x4*)(dst + (size_t)(rowg0 + wid * 32 + row) * 1024 + hcol + c16 * 8) = *(const LAS u32x4*)(pw + row * 272 + c16 * 16); }
  asm volatile("s_waitcnt lgkmcnt(0)" ::: "memory");
}

#define XB_TMO      128
#define XB_XCNT(j)  (256  + 64 * (j))
#define XB_XSUB(j)  (1280 + 64 * (j))
#define XB_XGEN(j)  (2304 + 64 * (j))
#define XB_TOP      3328
#define XB_TOPGEN   3392
#define XCD_BAR_WORDS 3456
#define XB_SPIN_CAP (1u << 22)
DI unsigned xb_ld(unsigned* p)              { return __hip_atomic_load(p, __ATOMIC_RELAXED, __HIP_MEMORY_SCOPE_AGENT); }
DI unsigned xb_add(unsigned* p, unsigned v) { return __hip_atomic_fetch_add(p, v, __ATOMIC_RELAXED, __HIP_MEMORY_SCOPE_AGENT); }
DI unsigned xb_xcc_id() { return (unsigned)__builtin_amdgcn_s_getreg((3 << 11) | 20) & 0xFu; }
#define XB_SPIN(cond, bar) do { unsigned _sp = 0; while (cond) { __builtin_amdgcn_s_sleep(1); \
    if ((++_sp & 255u) == 0u) { if (xb_ld(&(bar)[XB_TMO])) break; if (_sp > XB_SPIN_CAP) { atomicAdd(&(bar)[XB_TMO], 1u); break; } } } } while (0)
struct XcdBarrier { unsigned* bar; unsigned x; volatile LAS unsigned* st; };
DI XcdBarrier xcd_barrier_post(unsigned* bar, volatile LAS unsigned* st) {
  XcdBarrier b; b.bar = bar; b.x = xb_xcc_id(); b.st = st;
  if (threadIdx.x == 0) (void)xb_add(&bar[XB_XCNT(b.x)], 1u);
  return b;
}
DI void xcd_barrier_complete(unsigned* bar, unsigned x, unsigned& nloc, unsigned& nx) {
  const unsigned G = gridDim.x * gridDim.y * gridDim.z;
  unsigned sum, cnt, mine, sp = 0u;
  for (;;) {
    sum = 0u; cnt = 0u; mine = 0u;
#pragma unroll
    for (unsigned j = 0; j < 16; ++j) { const unsigned c = xb_ld(&bar[XB_XCNT(j)]); sum += c; cnt += (c > 0u) ? 1u : 0u; mine = (j == x) ? c : mine; }
    if (sum == G) break;
    __builtin_amdgcn_s_sleep(1);
    if ((++sp & 255u) == 0u) { if (xb_ld(&bar[XB_TMO])) break; if (sp > XB_SPIN_CAP) { atomicAdd(&bar[XB_TMO], 1u); break; } }
  }
  nloc = mine > 0u ? mine : 1u; nx = cnt > 0u ? cnt : 1u;
}
DI void xcd_barrier(const XcdBarrier& b) {
  asm volatile("s_waitcnt vmcnt(0)" ::: "memory");
  __syncthreads();
  if (threadIdx.x == 0) {
    unsigned long long ba_ = (unsigned long long)b.bar; unsigned bx = b.x; asm volatile("" : "+v"(bx));
    unsigned* bar = (unsigned*)ba_;
    __builtin_amdgcn_s_waitcnt(0);
    unsigned nloc = b.st[0], nx = b.st[1];
    if (nloc == 0u) { xcd_barrier_complete(bar, bx, nloc, nx); b.st[0] = nloc; b.st[1] = nx; }
    const unsigned old = xb_add(&bar[XB_XSUB(bx)], 1u);
    const unsigned gen = old / nloc;
    if (old + 1u == (gen + 1u) * nloc) {
      __builtin_amdgcn_fence(__ATOMIC_RELEASE, "agent");
      asm volatile("s_waitcnt vmcnt(0)" ::: "memory");
      const unsigned og = xb_add(&bar[XB_TOP], 1u);
      const unsigned tg = og / nx;
      if (og + 1u == (tg + 1u) * nx) xb_add(&bar[XB_TOPGEN], 1u);
      else XB_SPIN(xb_ld(&bar[XB_TOPGEN]) == tg, bar);
      __builtin_amdgcn_fence(__ATOMIC_ACQUIRE, "agent");
      xb_add(&bar[XB_XGEN(bx)], 1u);
      asm volatile("s_waitcnt vmcnt(0)" ::: "memory");
    } else {
      XB_SPIN(xb_ld(&bar[XB_XGEN(bx)]) == gen, bar);
      __builtin_amdgcn_fence(__ATOMIC_ACQUIRE, "agent");
      asm volatile("s_waitcnt vmcnt(0)" ::: "memory");
    }
  }
  __syncthreads();
}

__global__ void __launch_bounds__(NTHR) fwd_megakernel(Params p) {
  extern __shared__ __attribute__((aligned(16))) unsigned char shm[];
  cg::grid_group grid = cg::this_grid();
  LAS unsigned char* ldsl = (LAS unsigned char*)shm;
  unsigned char* lds = shm;
  unsigned char* ws = p.ws;

  bf16_t* hbuf = (bf16_t*)(ws + O_H);
  float* modp = (float*)(ws + O_MODP);
  float* mod = (float*)(ws + O_MOD);
  float* ropeA = (float*)(ws + O_ROPA);
  float* ropeI = (float*)(ws + O_ROPI);
  float* scal = (float*)(ws + O_SCAL);
  unsigned* ctr = (unsigned*)(ws + O_CTR);
  bf16_t* ubuf = (bf16_t*)(ws + O_UBUF);
  float* xbuf = (float*)(ws + O_XBUF);
  int* slot = (int*)(lds + SLOT_OFF);

  { PHASE_VARS
  if (bid == 0) {
    if (tid < 16) ctr[tid] = 0u;
    if (tid < 256) ((unsigned*)(ws + O_LNC))[tid] = 0u;
    for (int i = tid; i < XCD_BAR_WORDS; i += NTHR) ((unsigned*)(ws + O_BAR))[i] = 0u;
    if (tid < 2) { const float* lm = p.lam + tid * 4 * 128; float s0 = 0, s1 = 0; for (int i = 0; i < 128; ++i) { s0 += lm[i] * lm[128 + i]; s1 += lm[256 + i] * lm[384 + i]; }
      const float lam_init = 0.8f - 0.6f * expf(-0.3f * (float)tid);
      scal[tid * 2] = expf(s0) - expf(s1) + lam_init; scal[tid * 2 + 1] = 1.f - lam_init; }
  }
  for (int i = gtid; i < 4096 * 24; i += gthreads) {
    const int pos = i / 24, f = i % 24;
    float inv; if (f < 16) inv = powf(500000.f, -((float)f * 2.f) / 32.f); else inv = powf(500000.f, -((float)(f - 16) * 2.f) / 16.f);
    const float ang = (float)pos * inv;
    const double kk = rint((double)ang * 0.15915494309189535); const float red = (float)((double)ang - kk * 6.283185307179586);
    const float cs = cosf(red), sn = sinf(red);
    if (f < 16) { ropeA[pos * 32 + f] = cs; ropeA[pos * 32 + 16 + f] = sn; } else { ropeI[pos * 16 + (f - 16)] = cs; ropeI[pos * 16 + 8 + (f - 16)] = sn; }
  }
  float* csl = (float*)lds;
  for (int i = tid; i < 4096; i += NTHR) csl[i] = silu(p.c[i]);
  __syncthreads();
  for (int i = gtid; i < 8 * 2 * 12288; i += gthreads) {
    const int col = i % 12288, l = (i / 12288) & 1, kc = i / (2 * 12288);
    const float* w = p.w_ada + (size_t)l * 2048 * 12288 + (size_t)(kc * 256) * 12288 + col;
    float a0 = 0, a1 = 0;
#pragma unroll 8
    for (int k = 0; k < 256; ++k) { const float wv = __builtin_nontemporal_load(&w[(size_t)k * 12288]); a0 += csl[kc * 256 + k] * wv; a1 += csl[2048 + kc * 256 + k] * wv; }
    modp[((size_t)(kc * 2 + l) * 2 + 0) * 12288 + col] = a0; modp[((size_t)(kc * 2 + l) * 2 + 1) * 12288 + col] = a1;
  }
  __syncthreads();
  }
  convert_layer(p, 0, (float*)lds);
  grid.sync();
  volatile LAS unsigned* xst = (volatile LAS unsigned*)(ldsl + XST_OFF);
  if (threadIdx.x == 0) { xst[0] = 0u; xst[1] = 0u; }
  __syncthreads();
  XcdBarrier xb = xcd_barrier_post((unsigned*)(ws + O_BAR), xst);

  { PHASE_VARS
  for (int i = gtid; i < 2 * 2 * 12288; i += gthreads) {
    const int col = i % 12288, lb = i / 12288, l = lb >> 1;
    float a = p.b_ada[l * 12288 + col];
    for (int kc = 0; kc < 8; ++kc) a += modp[((size_t)kc * 4 + lb) * 12288 + col];
    mod[i] = a;
  } }
  xcd_barrier(xb);
  ln_phase(p.x, nullptr, nullptr, nullptr, mod, 0, 1, ubuf);
  xcd_barrier(xb);

  for (int l = 0; l < 2; ++l) {
    const float* xin = l == 0 ? p.x : xbuf;
    float* xnext = l == 0 ? xbuf : p.out;
    const float* modl = mod + l * 2 * 12288;
    { PHASE_VARS Gemm g{ubuf, (const bf16_t*)(ws + O_WIN), T, NPHYS, 2048, 2048, 2048}; Sched S; S.init(T, NPHYS, nblk, bid);
      EpiIn E{hbuf, (bf16_t*)(ws + O_BVT), (bf16_t*)(ws + O_CVT), ropeA, ropeI};
      gemm_phase(ldsl, g, S, E); }
    { PHASE_VARS const int kc = bid >> 5;
      Gemm g{ubuf + kc * 256, (const bf16_t*)(ws + O_WMISC) + kc * 256, T, 256, 256, 2048, 2048}; Sched S; S.init(T, 256, 32, bid & 31);
      EpiHalfF32 E{(float*)(ws + O_MISCP) + (size_t)kc * T * 128};
      gemm_phase(ldsl, g, S, E); }
    xcd_barrier(xb);
    { PHASE_VARS const float* miscp = (const float*)(ws + O_MISCP); bf16_t* ikn = (bf16_t*)(ws + O_IKN); float* iwf = (float*)(ws + O_IWF); float* bgt = (float*)(ws + O_BG); float* srow = (float*)(ws + O_SROW);
      for (int row = gw; row < T; row += nw) {
        const int pos = row & (SL - 1);
        { const bf16x8 a = *(const bf16x8*)(hbuf + (size_t)row * NPHYS + H_ALAT + lane * 8); float s = 0;
          for (int j = 0; j < 8; ++j) { const float v = bf2f((bf16_t)a[j]); s += v * v; }
          s = wsum(s); if (lane == 0) srow[row] = rsqrtf(s * (1.f / 512.f) + 1e-6f); }
        { float v = 0.f; for (int k = 0; k < 8; ++k) v += __builtin_nontemporal_load(&miscp[((size_t)k * T + row) * 128 + lane]); const float mu = wsum(v) * (1.f / 64.f); const float d = v - mu; const float var = wsum(d * d) * (1.f / 64.f);
          const float y = d * rsqrtf(var + 1e-5f);
          const float y8 = __shfl_xor(y, 8);
          float o = y;
          if (lane < 16) { const int f = lane & 7; const float cs = ropeI[pos * 16 + f], sn = ropeI[pos * 16 + 8 + f]; o = lane < 8 ? y * cs - y8 * sn : y * cs + y8 * sn; }
          ikn[(size_t)row * 64 + lane] = f2bf(o); }
        { float v = 0.f; for (int k = 0; k < 8; ++k) v += __builtin_nontemporal_load(&miscp[((size_t)k * T + row) * 128 + 64 + lane]);
          if (lane < 16) iwf[(size_t)row * 16 + lane] = v * (0.25f * 0.125f);
          else if (lane < 40) bgt[(size_t)row * 24 + (lane - 16)] = sigm(v); }
      }
      bf16_t* blk = (bf16_t*)(ws + O_BLK);
      for (int ch = gtid; ch < 2048 * 512; ch += gthreads) {
        const int row = ch >> 9, cc = ch & 511, j = cc >> 4, d8 = (cc & 15) * 8;
        const int kv = row >> 10, rr = row & 1023, b = rr >> 9, n = (rr & 511) >> 1, g = rr & 1, tok = 16 * n + j;
        u32x4 w = {0u, 0u, 0u, 0u};
        if (n < 255 && tok < SL) {
          const bf16x8 a = *(const bf16x8*)(hbuf + (size_t)(b * SL + tok) * NPHYS + H_BKV + kv * 256 + g * 128 + d8);
          const float* pe = p.cmp_pe + (size_t)((l * 2 + kv) * 32 + j) * 128 + d8;
          float v[8]; for (int q = 0; q < 8; ++q) v[q] = bf2f((bf16_t)a[q]) + pe[q];
          w = (u32x4){cvtpk(v[0], v[1]), cvtpk(v[2], v[3]), cvtpk(v[4], v[5]), cvtpk(v[6], v[7])};
        }
        *(u32x4*)(blk + (size_t)row * 4096 + cc * 8) = w;
      }
    }
    xcd_barrier(xb);
    { PHASE_VARS Gemm g{hbuf + H_ALAT, (const bf16_t*)(ws + O_WAUP), T, 2048, 512, NPHYS, 512}; Sched S; S.init(T, 2048, nblk, bid);
      EpiAup E{(bf16_t*)(ws + O_AK), (bf16_t*)(ws + O_AVT), (const float*)(ws + O_SROW), ropeA};
      gemm_phase(ldsl, g, S, E); }
    { PHASE_VARS if (bid < 64) { const int kc = bid >> 3;
      Gemm g{(const bf16_t*)(ws + O_BLK) + kc * 512, (const bf16_t*)(ws + O_WC1) + kc * 512, 2048, 256, 512, 4096, 4096}; Sched S; S.init(2048, 256, 8, bid & 7);
      EpiF32 E{(float*)(ws + O_CPART) + (size_t)kc * 2048 * 256, 256};
      gemm_phase(ldsl, g, S, E);
      asm volatile("s_waitcnt vmcnt(0)" ::: "memory"); __syncthreads();
      if (tid == 0) { __builtin_amdgcn_fence(__ATOMIC_RELEASE, "agent"); asm volatile("s_waitcnt vmcnt(0)" ::: "memory");
        __hip_atomic_fetch_add(ctr + l * 4 + 3, 1u, __ATOMIC_RELAXED, __HIP_MEMORY_SCOPE_AGENT); } } }
    idxsel_phase(lds, hbuf, (const bf16_t*)(ws + O_IKN), (const float*)(ws + O_IWF), (u64*)(ws + O_BITS), ctr + l * 4 + 0);
    { PHASE_VARS
      if (tid == 0) { unsigned sp_ = 0; while (__hip_atomic_load(ctr + l * 4 + 3, __ATOMIC_RELAXED, __HIP_MEMORY_SCOPE_AGENT) < 64u) { __builtin_amdgcn_s_sleep(1); if (++sp_ > (1u << 24)) break; }
        __builtin_amdgcn_fence(__ATOMIC_ACQUIRE, "agent"); asm volatile("s_waitcnt vmcnt(0)" ::: "memory"); }
      __syncthreads(); }
    { PHASE_VARS const float* cpart = (const float*)(ws + O_CPART); bf16_t* kc_ = (bf16_t*)(ws + O_KC); bf16_t* vct = (bf16_t*)(ws + O_VCT);
      float* hid = (float*)lds; float* red = (float*)lds + 128;
      for (int row = bid; row < 2048; row += nblk) {
        const int kv = row >> 10, rr = row & 1023, b = rr >> 9, n = (rr & 511) >> 1, g = rr & 1;
        __syncthreads();
        if (tid < 128) { float s = 0; for (int k = 0; k < 8; ++k) s += cpart[((size_t)k * 2048 + row) * 256 + kv * 128 + tid]; hid[tid] = silu(s); }
        __syncthreads();
        { const int cp = tid & 127, part = tid >> 7; const float* w2 = p.cmp_w2 + (size_t)(l * 2 + kv) * 128 * 128;
          float s = 0; for (int c = part * 32; c < part * 32 + 32; ++c) s += hid[c] * w2[c * 128 + cp];
          red[part * 128 + cp] = s; }
        __syncthreads();
        if (tid < 128) { const float s = red[tid] + red[128 + tid] + red[256 + tid] + red[384 + tid];
          if (kv == 0) kc_[(size_t)((b * 2 + g) * 256 + n) * 128 + tid] = f2bf(s); else vct[(size_t)((b * 2 + g) * 128 + tid) * 256 + n] = f2bf(s); }
      }
    }
    xcd_barrier(xb);
    { PHASE_VARS float* pcmp = (float*)(ws + O_PCMP); float* ml = (float*)(ws + O_ML);
      for (;;) {
        const int it = fetch_item(ctr + l * 4 + 1, slot);
        if (it >= 256) break;
        f32x16 o[4]; float mo, lo;
        const int r32 = lane & 31, hi = lane >> 5;
        const int qb = 15 - it / 16, r = it % 16, b = r >> 3, hh = r & 7, g = hh >> 2, rowg0 = b * SL + qb * 256;
        attn_core_skew<M_CMP>(ldsl, hbuf + (size_t)rowg0 * NPHYS + H_BQ + hh * 128, NPHYS, (const bf16_t*)(ws + O_KC) + (size_t)((b * 2 + g) * 256) * 128, 128,
                         (const bf16_t*)(ws + O_VCT) + (size_t)((b * 2 + g) * 128) * 256, 256, qb * 256, 0, 4, nullptr,
                         pcmp + ((size_t)(b * 8 + hh) * SL + qb * 256) * 256, o, mo, lo);
        store_o_bf16(ldsl, (bf16_t*)(ws + O_OCMP), rowg0, hh * 128, o);
        if (hi == 0) { float* mp = ml + ((size_t)(b * 8 + hh) * SL + qb * 256 + wid * 32 + r32) * 2; mp[0] = mo; mp[1] = lo; }
      }
    }
    xcd_barrier(xb);
    { PHASE_VARS const float* pcmp = (const float*)(ws + O_PCMP); const float* ml = (const float*)(ws + O_ML); u64* sel = (u64*)(ws + O_SEL);
      for (int it = gw; it < 2 * 2 * SL; it += nw) {
        const int t = it & (SL - 1), bg = it >> 12, b = bg >> 1, g = bg & 1, m = lane, tc = t >= 31 ? ((t - 31) >> 4) : -1;
        float imp = 0.f;
        for (int hh = 0; hh < 4; ++hh) { const size_t rb = (size_t)(b * 8 + g * 4 + hh) * SL + t; const float* base = pcmp + rb * 256;
          const float mm = ml[rb * 2], ll = ml[rb * 2 + 1]; const float inv = ll > 0.f ? 1.f / ll : 0.f;
          const float NI = -__builtin_inff();
          const f32x4 s4 = 4 * m <= tc ? __builtin_nontemporal_load((const f32x4*)(base + 4 * m)) : (f32x4){NI, NI, NI, NI}; const float sm1 = (m > 0 && 4 * m - 1 <= tc) ? base[4 * m - 1] : NI;
          float ps = __builtin_amdgcn_exp2f((sm1 - mm) * C2);
          for (int j = 0; j < 4; ++j) ps += __builtin_amdgcn_exp2f((s4[j] - mm) * C2);
          imp += ps * inv; }
        const int cur = t >> 6;
        const bool forced = (m == 0) | (m == cur) | (m == cur - 1), adm = m <= cur;
        const float v = forced ? 1e6f : (adm ? imp : -1e30f);
        int rank = 0;
#pragma unroll
        for (int jj = 0; jj < 64; ++jj) { const float vj = __int_as_float(__builtin_amdgcn_readlane(__float_as_int(v), jj)); rank += (vj > v || (vj == v && jj < m)) ? 1 : 0; }
        const u64 w = __ballot(rank < 16);
        if (lane == 0) sel[it] = w;
      }
    }
    xcd_barrier(xb);
    { PHASE_VARS const u64* sel = (const u64*)(ws + O_SEL); const float* bgt = (const float*)(ws + O_BG); const u64* bits = (const u64*)(ws + O_BITS);
      for (;;) {
        const int it = fetch_item(ctr + l * 4 + 2, slot);
        if (it >= 1024) break;
        f32x16 o[4]; float mo, lo;
        const int r32 = lane & 31, hi = lane >> 5;
        if (it >= 768) {
          const int i2 = it - 768, qb = 15 - i2 / 16, r = i2 % 16, b = r >> 3, hh = r & 7, g = hh >> 2, rowg0 = b * SL + qb * 256;
          const int jlo = 4 * qb - 8 > 0 ? 4 * qb - 8 : 0;
          attn_core_skew<M_WINDOW>(ldsl, hbuf + (size_t)rowg0 * NPHYS + H_BQ + hh * 128, NPHYS, hbuf + (size_t)(b * SL) * NPHYS + H_BKV + (8 + g) * 128, NPHYS,
                              (const bf16_t*)(ws + O_BVT) + (size_t)(((b * 2 + 1) * 2 + g) * 128) * SL, SL, qb * 256, jlo, 4 * qb + 4, nullptr, nullptr, o, mo, lo);
          store_o_bf16(ldsl, (bf16_t*)(ws + O_OWIN), rowg0, hh * 128, o);
          continue;
        }
        const int qb = 15 - it / 48, r = it % 48;
        if (r < 16) {
          f32x16 o8[8];
          const int b = r >> 3, vh = r & 7, head = vh >> 1, mp = vh & 1, rowg0 = b * SL + qb * 256;
          attn_core<M_CAUSAL, 256>(ldsl, hbuf + (size_t)rowg0 * NPHYS + H_CQ + (head * 2 + mp) * 128, NPHYS, hbuf + (size_t)(b * SL) * NPHYS + H_CK + (head * 2 + mp) * 128, NPHYS,
                              (const bf16_t*)(ws + O_CVT) + (size_t)((b * 4 + head) * 256) * SL, SL, qb * 256, 0, 4 * qb + 4, nullptr, nullptr, o8, mo, lo);
          __syncthreads();
          { const int t2 = ltid(), l2 = t2 & 63, w2 = t2 >> 6, r2_ = l2 & 31, h2 = l2 >> 5;
            LAS unsigned char* pw = ldsl + w2 * 17408;
#pragma unroll
            for (int rr = 0; rr < 16; ++rr)
#pragma unroll
              for (int d = 0; d < 8; ++d) *(LAS bf16_t*)(pw + ((rr & 3) + 8 * (rr >> 2) + 4 * h2) * 544 + (d * 32 + r2_) * 2) = f2bf(o8[d][rr]);
            asm volatile("s_waitcnt lgkmcnt(0)" ::: "memory");
            bf16_t* ocp = (bf16_t*)(ws + O_OC) + (size_t)(rowg0 + w2 * 32) * 2048 + head * 512 + mp * 256;
#pragma unroll
            for (int i = 0; i < 16; ++i) { const int c = i * 64 + l2, row = c >> 5, c16 = c & 31;
              *(u32x4*)(ocp + (size_t)row * 2048 + c16 * 8) = *(const LAS u32x4*)(pw + row * 544 + c16 * 16); }
            asm volatile("s_waitcnt lgkmcnt(0)" ::: "memory"); }
        } else if (r < 32) {
          const int r2 = r - 16, b = r2 >> 3, hh = r2 & 7, rowg0 = b * SL + qb * 256;
          attn_core_skew<M_BITS>(ldsl, hbuf + (size_t)rowg0 * NPHYS + H_AQ + hh * 128, NPHYS, (const bf16_t*)(ws + O_AK) + (size_t)(b * SL) * 1024 + hh * 128, 1024,
                            (const bf16_t*)(ws + O_AVT) + (size_t)((b * 8 + hh) * 128) * SL, SL, qb * 256, 0, 4 * qb + 4, bits + (size_t)rowg0 * 64, nullptr, o, mo, lo);
          store_o_bf16(ldsl, (bf16_t*)(ws + O_YA), rowg0, hh * 128, o);
        } else {
          const int r2 = r - 32, b = r2 >> 3, hh = r2 & 7, g = hh >> 2, rowg0 = b * SL + qb * 256;
          attn_core_skew<M_SLC>(ldsl, hbuf + (size_t)rowg0 * NPHYS + H_BQ + hh * 128, NPHYS, hbuf + (size_t)(b * SL) * NPHYS + H_BKV + (4 + g) * 128, NPHYS,
                           (const bf16_t*)(ws + O_BVT) + (size_t)(((b * 2 + 0) * 2 + g) * 128) * SL, SL, qb * 256, 0, 4 * qb + 4, sel + (size_t)(b * 2 + g) * SL + qb * 256, nullptr, o, mo, lo);
          store_o_bf16(ldsl, (bf16_t*)(ws + O_YB), rowg0, hh * 128, o);
        }
      }
      (void)bgt;
    }
    xcd_barrier(xb);
    { PHASE_VARS const bf16_t* ocmp = (const bf16_t*)(ws + O_OCMP); const bf16_t* owin = (const bf16_t*)(ws + O_OWIN); bf16_t* yb = (bf16_t*)(ws + O_YB); const float* bgt = (const float*)(ws + O_BG);
      for (int row = gw; row < T; row += nw) {
#pragma unroll
        for (int hq = 0; hq < 2; ++hq) { const int c0 = hq * 512 + lane * 8, hh = c0 >> 7; const float* gp = bgt + (size_t)row * 24 + hh * 3; const float g0 = gp[0], g1 = gp[1], g2 = gp[2];
          const size_t rw = (size_t)row * 1024 + c0;
          const bf16x8 a = __builtin_nontemporal_load((const bf16x8*)(ocmp + rw)), b8 = __builtin_nontemporal_load((const bf16x8*)(yb + rw)), c8 = __builtin_nontemporal_load((const bf16x8*)(owin + rw));
          float v[8]; for (int q = 0; q < 8; ++q) v[q] = g0 * bf2f((bf16_t)a[q]) + g1 * bf2f((bf16_t)b8[q]) + g2 * bf2f((bf16_t)c8[q]);
          *(u32x4*)(yb + rw) = (u32x4){cvtpk(v[0], v[1]), cvtpk(v[2], v[3]), cvtpk(v[4], v[5]), cvtpk(v[6], v[7])}; }
      }
    }
    { PHASE_VARS const bf16_t* oc = (const bf16_t*)(ws + O_OC); bf16_t* yc = (bf16_t*)(ws + O_YC);
      const float lamv = scal[l * 2], omli = scal[l * 2 + 1];
      for (int it = gw; it < T * 4; it += nw) {
        const int row = it >> 2, head = it & 3;
        const s16x4 a = __builtin_nontemporal_load((const s16x4*)(oc + (size_t)row * 2048 + head * 512 + lane * 4)), b4 = __builtin_nontemporal_load((const s16x4*)(oc + (size_t)row * 2048 + head * 512 + 256 + lane * 4));
        float v[4], s = 0; for (int j = 0; j < 4; ++j) { v[j] = bf2f((bf16_t)a[j]) - lamv * bf2f((bf16_t)b4[j]); s += v[j] * v[j]; }
        const float rs = rsqrtf(wsum(s) * (1.f / 256.f) + 1e-6f);
        const f32x4 gg = *(const f32x4*)(p.subln_g + l * 256 + lane * 4);
        float o4[4]; for (int j = 0; j < 4; ++j) o4[j] = v[j] * rs * gg[j] * omli;
        *(u32x2*)(yc + (size_t)row * 1024 + head * 256 + lane * 4) = (u32x2){cvtpk(o4[0], o4[1]), cvtpk(o4[2], o4[3])};
      }
    }
    xcd_barrier(xb);
    for (int r = 0; r < 3; ++r) { PHASE_VARS
      const bf16_t* yr = (const bf16_t*)(ws + (r == 0 ? O_YA : (r == 1 ? O_YB : O_YC)));
      Gemm g{yr, (const bf16_t*)(ws + O_WBR) + (size_t)r * 2048 * 1024, T, 2048, 1024, 1024, 1024}; Sched S; S.init(T, 2048, nblk, bid);
      EpiGate E{hbuf, (float*)(ws + O_TMP), (bf16_t*)(ws + O_MERG), r};
      gemm_phase(ldsl, g, S, E);
    }
    xcd_barrier(xb);
    { PHASE_VARS Gemm g{(const bf16_t*)(ws + O_MERG), (const bf16_t*)(ws + O_WO), T, 2048, 2048, 2048, 2048}; Sched S; S.init(T, 2048, nblk, bid);
      EpiLnFused E{xin, modl + 2 * 2048, p.ln_g + (size_t)(l * 2 + 0) * 2048, p.ln_b + (size_t)(l * 2 + 0) * 2048, (float*)(ws + O_X1), modl, 3, 4, ubuf,
                   (float*)(ws + O_LNS), (unsigned*)(ws + O_LNC) + (l * 2 + 0) * 64};
      gemm_phase(ldsl, g, S, E); }
    xcd_barrier(xb);
    { PHASE_VARS Gemm g{ubuf, (const bf16_t*)(ws + O_WF1), T, 2 * DFF, 2048, 2048, 2048}; Sched S; S.init(T, 2 * DFF, nblk, bid);
      EpiSwiglu E{(bf16_t*)(ws + O_HID)};
      gemm_phase(ldsl, g, S, E); }
    xcd_barrier(xb);
    { PHASE_VARS Gemm g{(const bf16_t*)(ws + O_HID), (const bf16_t*)(ws + O_WF2), T, 2048, DFF, DFF, DFF}; Sched S; S.init(T, 2048, nblk, bid);
      EpiLnFused E{(const float*)(ws + O_X1), modl + 5 * 2048, p.ln_g + (size_t)(l * 2 + 1) * 2048, p.ln_b + (size_t)(l * 2 + 1) * 2048, xnext, mod + 2 * 12288, 0, 1, l == 0 ? ubuf : nullptr,
                   (float*)(ws + O_LNS), (unsigned*)(ws + O_LNC) + (l * 2 + 1) * 64};
      gemm_phase(ldsl, g, S, E); }
    if (l == 0) { xcd_barrier(xb); convert_layer(p, 1, (float*)lds); xcd_barrier(xb); }
  }
}

extern "C" void kernel_launch(void* const* d_in, const int* in_sizes, int n_in, void* d_out, int out_size, void* d_ws, size_t ws_size, hipStream_t stream) {
  (void)in_sizes; (void)n_in; (void)out_size;
  static int grid_blocks = 0;
  if (!grid_blocks) {
    hipError_t e = hipFuncSetAttribute((const void*)fwd_megakernel, hipFuncAttributeMaxDynamicSharedMemorySize, LDS_BYTES);
    if (e != hipSuccess) fprintf(stderr, "hipFuncSetAttribute failed: %s\n", hipGetErrorString(e));
    int dev = 0, cus = 0, per_cu = 0;
    hipGetDevice(&dev);
    hipDeviceGetAttribute(&cus, hipDeviceAttributeMultiprocessorCount, dev);
    hipOccupancyMaxActiveBlocksPerMultiprocessor(&per_cu, fwd_megakernel, NTHR, LDS_BYTES);
    if (per_cu < 1) per_cu = 1;
    grid_blocks = cus;
    if (ws_size < WS_TOTAL) fprintf(stderr, "workspace too small: %zu < %zu\n", ws_size, (size_t)WS_TOTAL);
  }
  Params p{};
  p.x = (const float*)d_in[0]; p.c = (const float*)d_in[1]; p.w_ada = (const float*)d_in[2]; p.b_ada = (const float*)d_in[3]; p.w_in = (const float*)d_in[4];
  p.a_lat_g = (const float*)d_in[5]; p.a_up = (const float*)d_in[6]; p.cmp_w1 = (const float*)d_in[7]; p.cmp_w2 = (const float*)d_in[8]; p.cmp_pe = (const float*)d_in[9];
  p.lam = (const float*)d_in[10]; p.subln_g = (const float*)d_in[11]; p.w_br = (const float*)d_in[12]; p.w_o = (const float*)d_in[13]; p.w_f1 = (const float*)d_in[14];
  p.w_f2 = (const float*)d_in[15]; p.ln_g = (const float*)d_in[16]; p.ln_b = (const float*)d_in[17];
  p.out = (float*)d_out; p.ws = (unsigned char*)d_ws;
  void* args[] = {&p};
  hipError_t e = hipLaunchCooperativeKernel((const void*)fwd_megakernel, dim3(grid_blocks), dim3(NTHR), args, LDS_BYTES, stream);
  if (e != hipSuccess) fprintf(stderr, "cooperative launch failed: %s (grid %d)\n", hipGetErrorString(e), grid_blocks);
}
```
